# Optimizing an MI355X kernel written in HIP

```python
import jax, jax.numpy as jnp
from jax import lax
import numpy as np

D_MODEL = 1024
BATCH = 4
SEQ = 8192
DEPTH = 1

CTX_LEN = 256
GRID_W = 64
HG_DK = 128
HG_DV = 128
HG_HEADS = (D_MODEL // 2) // HG_DV
ML_DK = 128
ML_DV = 128
ML_HEADS = (D_MODEL // 2) // ML_DV
HG_KW = HG_HEADS * HG_DK
HG_VW = HG_HEADS * HG_DV
ML_KW = ML_HEADS * ML_DK
ML_VW = ML_HEADS * ML_DV
MIX_WIDTH = HG_VW + ML_VW
HG_CHUNK = 32
ML_CHUNK = 64
CONV_K = 3
N_EXPERTS = 16
EC_CAPACITY = 2
EXPERT_FF = 1024
NORM_EPS = 1e-6

HG_Q = 0
HG_I = HG_Q + HG_KW
HG_G = HG_I + HG_VW
HG_FF = HG_G + HG_VW
ML_Q = HG_FF + 2 * HG_KW
ML_V = ML_Q + 2 * ML_KW
ML_O = ML_V + ML_VW
ML_GATES = ML_O + ML_VW
PROJ_OUT = ML_GATES + 4 * ML_HEADS

kernel_name = "hgrn2_mlstm_ec_moe_diffusion_block"


def rms_norm(x, w):
    xf = x.astype(jnp.float32)
    y = xf * lax.rsqrt(jnp.mean(xf * xf, axis=-1, keepdims=True) + NORM_EPS)
    return (y * w).astype(x.dtype)


def _head_rms_norm(t, w, n_heads):
    B, T, W = t.shape
    tf = t.astype(jnp.float32).reshape(B, T, n_heads, -1)
    tf = tf * lax.rsqrt(jnp.mean(tf * tf, axis=-1, keepdims=True) + NORM_EPS)
    return (tf.reshape(B, T, W) * w).astype(t.dtype)


def _head_layer_norm(t, w, n_heads):
    B, T, W = t.shape
    tf = t.astype(jnp.float32).reshape(B, T, n_heads, -1)
    tf = tf - jnp.mean(tf, axis=-1, keepdims=True)
    tf = tf * lax.rsqrt(jnp.mean(tf * tf, axis=-1, keepdims=True) + NORM_EPS)
    return (tf.reshape(B, T, W) * w).astype(t.dtype)


def _to_heads(t, n_heads):
    B, T, _ = t.shape
    return t.reshape(B, T, n_heads, -1).transpose(0, 2, 1, 3)


def _from_heads(t):
    B, H, T, d = t.shape
    return t.transpose(0, 2, 1, 3).reshape(B, T, H * d)


def _to_chunks(t, L):
    B, H, T = t.shape[:3]
    return jnp.moveaxis(t.reshape(B, H, T // L, L, *t.shape[3:]), 2, 0)


def _from_chunks(t):
    N, B, H, L = t.shape[:4]
    return jnp.moveaxis(t, 0, 2).reshape(B, H, N * L, *t.shape[4:])


def hgrn2_scan(q, k, v, log_f, s0):
    L = HG_CHUNK
    mask = jnp.tril(jnp.ones((L, L), dtype=bool))
    f32 = jnp.float32

    def step(s, inp):
        qc, kc, vc, gc = inp
        a = jnp.cumsum(gc, axis=2)
        diff = a[:, :, :, None, :] - a[:, :, None, :, :]
        decay = jnp.exp(jnp.where(mask[:, :, None], diff, -jnp.inf))
        scores = jnp.einsum('bhid,bhjd,bhijd->bhij', qc, kc, decay)
        o = jnp.einsum('bhij,bhjv->bhiv', scores, vc) + jnp.einsum('bhid,bhdv->bhiv', qc * jnp.exp(a), s)
        a_last = a[:, :, -1:, :]
        s_new = jnp.exp(a_last[:, :, 0, :])[..., None] * s + jnp.einsum('bhjd,bhjv->bhdv', kc * jnp.exp(a_last - a), vc)
        return s_new, o

    xs = (_to_chunks(q.astype(f32), L), _to_chunks(k.astype(f32), L), _to_chunks(v.astype(f32), L), _to_chunks(log_f.astype(f32), L))
    s_fin, o = lax.scan(step, s0, xs)
    return _from_chunks(o).astype(v.dtype), s_fin


def mlstm_scan(q, k, v, log_i, log_f, state):
    L = ML_CHUNK
    mask = jnp.tril(jnp.ones((L, L), dtype=bool))
    f32 = jnp.float32

    def step(carry, inp):
        c, n, m = carry
        qc, kc, vc, ic, fc = inp
        b = jnp.cumsum(fc, axis=-1)
        d = jnp.where(mask, b[..., :, None] - b[..., None, :] + ic[..., None, :], -jnp.inf)
        inter = b + m[..., None]
        m_row = jnp.maximum(inter, jnp.max(d, axis=-1))
        w_inter = jnp.exp(inter - m_row)
        qk = jnp.einsum('bhid,bhjd->bhij', qc, kc) * jnp.exp(d - m_row[..., None])
        num = jnp.einsum('bhij,bhjv->bhiv', qk, vc) + w_inter[..., None] * jnp.einsum('bhid,bhdv->bhiv', qc, c)
        den = jnp.sum(qk, axis=-1) + w_inter * jnp.einsum('bhid,bhd->bhi', qc, n)
        h = num / jnp.maximum(jnp.abs(den), jnp.exp(-m_row))[..., None]
        m_new = m_row[..., -1]
        wk = jnp.exp(b[..., -1:] - b + ic - m_new[..., None])
        ws = jnp.exp(b[..., -1] + m - m_new)
        c_new = ws[..., None, None] * c + jnp.einsum('bhj,bhjd,bhjv->bhdv', wk, kc, vc)
        n_new = ws[..., None] * n + jnp.einsum('bhj,bhjd->bhd', wk, kc)
        return (c_new, n_new, m_new), h

    xs = (_to_chunks(q.astype(f32), L), _to_chunks(k.astype(f32), L), _to_chunks(v.astype(f32), L),
          _to_chunks(log_i.astype(f32), L), _to_chunks(log_f.astype(f32), L))
    st, h = lax.scan(step, state, xs)
    return _from_chunks(h).astype(v.dtype), st


def _short_conv(t, conv_w, conv_b, on_grid):
    B, T, C = t.shape
    w = conv_w.astype(t.dtype)
    if on_grid:
        rows = T // GRID_W
        y = lax.conv_general_dilated(t.reshape(B, rows, GRID_W, C), w[:, :, None, :], (1, 1), 'SAME',
                                     dimension_numbers=('NHWC', 'HWIO', 'NHWC'), feature_group_count=C)
        y = y.reshape(B, T, C)
    else:
        y = lax.conv_general_dilated(t, w[CONV_K // 2][:, None, :], (1,), 'SAME',
                                     dimension_numbers=('NWC', 'WIO', 'NWC'), feature_group_count=C)
    return jax.nn.silu(y + conv_b)


def _prep(u, w_in, conv_w, conv_b, lb, ml_gate_b, on_grid):
    B, T, _ = u.shape
    p = jnp.einsum('btd,dk->btk', u, w_in)
    f_logit = p[..., HG_FF:ML_Q].astype(jnp.float32).reshape(B, T, 2, HG_KW)
    f = lb + (1.0 - lb) * jax.nn.sigmoid(f_logit)
    qk = _short_conv(p[..., ML_Q:ML_V], conv_w, conv_b, on_grid)
    gates = (p[..., ML_GATES:].astype(jnp.float32) + ml_gate_b).reshape(B, T, 2, 2, ML_HEADS)
    gates = jnp.transpose(gates, (2, 3, 0, 4, 1))
    return dict(
        hg_q=_to_heads(jax.nn.silu(p[..., HG_Q:HG_I]), HG_HEADS),
        hg_v=_to_heads(p[..., HG_I:HG_G], HG_HEADS),
        hg_g=p[..., HG_G:HG_FF],
        hg_k=[_to_heads(1.0 - f[:, :, d], HG_HEADS) for d in range(2)],
        hg_logf=[_to_heads(jnp.log(f[:, :, d]), HG_HEADS) for d in range(2)],
        ml_q=_to_heads(qk[..., :ML_KW], ML_HEADS),
        ml_k=_to_heads(qk[..., ML_KW:], ML_HEADS) * (ML_DK ** -0.5),
        ml_v=_to_heads(p[..., ML_V:ML_O], ML_HEADS),
        ml_o=p[..., ML_O:ML_GATES],
        ml_logi=gates[:, 0],
        ml_logf=jax.nn.log_sigmoid(gates[:, 1]),
    )


def _scan_direction(pr, d, hg_s0, ml_s0):
    fl = (lambda a: jnp.flip(a, axis=2)) if d == 1 else (lambda a: a)
    hg_o, hg_s = hgrn2_scan(fl(pr['hg_q']), fl(pr['hg_k'][d]), fl(pr['hg_v']), fl(pr['hg_logf'][d]), hg_s0)
    ml_h, ml_s = mlstm_scan(fl(pr['ml_q']), fl(pr['ml_k']), fl(pr['ml_v']), fl(pr['ml_logi'][d]), fl(pr['ml_logf'][d]), ml_s0)
    return fl(hg_o), hg_s, fl(ml_h), ml_s


def _zero_states(B):
    f32 = jnp.float32
    hg = jnp.zeros((B, HG_HEADS, HG_DK, HG_DV), f32)
    ml = (jnp.zeros((B, ML_HEADS, ML_DK, ML_DV), f32), jnp.zeros((B, ML_HEADS, ML_DK), f32), jnp.zeros((B, ML_HEADS), f32))
    return hg, ml


def _mixer_out(pr, hg_o, ml_h, hg_norm_w, ml_norm_w, w_out):
    hg = _head_rms_norm(_from_heads(hg_o), hg_norm_w, HG_HEADS) * jax.nn.silu(pr['hg_g'])
    ml = _head_layer_norm(_from_heads(ml_h), ml_norm_w, ML_HEADS) * jax.nn.sigmoid(pr['ml_o'])
    return jnp.einsum('btk,kd->btd', jnp.concatenate([hg, ml], axis=-1), w_out)


def ec_moe(u, router_w, w_gate, w_up, w_down):
    B, n, D = u.shape
    cap = EC_CAPACITY * n // N_EXPERTS
    aff = jax.nn.softmax(jnp.einsum('bnd,de->bne', u, router_w).astype(jnp.float32), axis=-1)
    gate, idx = lax.top_k(jnp.swapaxes(aff, 1, 2), cap)
    xs = jax.vmap(lambda t, i: t[i])(u, idx)
    h = jax.nn.silu(jnp.einsum('becd,edf->becf', xs, w_gate)) * jnp.einsum('becd,edf->becf', xs, w_up)
    y = jnp.einsum('becf,efd->becd', h, w_down) * gate[..., None].astype(u.dtype)
    return jax.vmap(lambda ye, i: jnp.zeros((n, D), ye.dtype).at[i.reshape(-1)].add(ye.reshape(-1, D)))(y, idx)


def setup_inputs(seed: int = 0) -> dict:
    key = jax.random.key(seed)
    ks = jax.random.split(key, 24)
    f32 = jnp.float32
    nrm = lambda k, shape, s: s * jax.random.normal(k, shape, f32)
    D = D_MODEL
    gate_base = jnp.stack([jnp.zeros((ML_HEADS,), f32), jnp.linspace(3.0, 6.0, ML_HEADS, dtype=f32)])
    ml_gate_b = (jnp.broadcast_to(gate_base, (DEPTH, 2, 2, ML_HEADS)) + nrm(ks[10], (DEPTH, 2, 2, ML_HEADS), 0.1)).reshape(DEPTH, 4 * ML_HEADS)
    return {
        "x": nrm(ks[0], (BATCH, SEQ, D), 1.0),
        "c": nrm(ks[1], (BATCH, D), 1.0),
        "ctx": nrm(ks[2], (BATCH, CTX_LEN, D), 1.0),
        "c_ctx": nrm(ks[3], (D,), 1.0),
        "ada_w": nrm(ks[4], (DEPTH, D, 6 * D), 0.5 * D ** -0.5),
        "ada_b": nrm(ks[5], (DEPTH, 6 * D), 0.02),
        "norm1_w": 1.0 + nrm(ks[6], (DEPTH, D), 0.02),
        "w_in": nrm(ks[7], (DEPTH, D, PROJ_OUT), D ** -0.5),
        "conv_w": nrm(ks[8], (DEPTH, CONV_K, CONV_K, 2 * ML_KW), 1.0 / CONV_K),
        "conv_b": nrm(ks[9], (DEPTH, 2 * ML_KW), 0.02),
        "hg_lb_logits": nrm(ks[11], (DEPTH + 1, 2, HG_KW), 0.5),
        "ml_gate_b": ml_gate_b,
        "hg_norm_w": 1.0 + nrm(ks[12], (DEPTH, HG_VW), 0.02),
        "ml_norm_w": 1.0 + nrm(ks[13], (DEPTH, ML_VW), 0.02),
        "w_out": nrm(ks[14], (DEPTH, MIX_WIDTH, D), MIX_WIDTH ** -0.5),
        "norm2_w": 1.0 + nrm(ks[15], (DEPTH, D), 0.02),
        "router_w": nrm(ks[16], (DEPTH, D, N_EXPERTS), D ** -0.5),
        "exp_w_gate": nrm(ks[17], (DEPTH, N_EXPERTS, D, EXPERT_FF), D ** -0.5),
        "exp_w_up": nrm(ks[18], (DEPTH, N_EXPERTS, D, EXPERT_FF), D ** -0.5),
        "exp_w_down": nrm(ks[19], (DEPTH, N_EXPERTS, EXPERT_FF, D), EXPERT_FF ** -0.5),
        "final_norm_w": 1.0 + nrm(ks[20], (D,), 0.02),
    }


def reference(x, c, ctx, c_ctx, ada_w, ada_b, norm1_w, w_in, conv_w, conv_b, hg_lb_logits, ml_gate_b,
              hg_norm_w, ml_norm_w, w_out, norm2_w, router_w, exp_w_gate, exp_w_up, exp_w_down, final_norm_w):
    B = x.shape[0]
    lb_all = jnp.cumsum(jax.nn.softmax(hg_lb_logits.astype(jnp.float32), axis=0), axis=0)
    silu_c = jax.nn.silu(c)
    silu_cc = jax.nn.silu(c_ctx)
    for l in range(DEPTH):
        last = l == DEPTH - 1
        mod_x = jnp.split(silu_c @ ada_w[l] + ada_b[l], 6, axis=-1)
        mod_c = jnp.split(silu_cc @ ada_w[l] + ada_b[l], 6, axis=-1)
        sh1, sc1, g1, sh2, sc2, g2 = [m[:, None, :] for m in mod_x]
        csh1, csc1, cg1, csh2, csc2, cg2 = mod_c
        lb = lb_all[l]
        u_x = rms_norm(x, norm1_w[l]) * (1.0 + sc1) + sh1
        u_c = rms_norm(ctx, norm1_w[l]) * (1.0 + csc1) + csh1
        pr_c = _prep(u_c, w_in[l], conv_w[l], conv_b[l], lb, ml_gate_b[l], False)
        pr_x = _prep(u_x, w_in[l], conv_w[l], conv_b[l], lb, ml_gate_b[l], True)
        hg0, ml0 = _zero_states(B)
        c_hg_f, c_hs_f, c_ml_f, c_ms_f = _scan_direction(pr_c, 0, hg0, ml0)
        c_hg_b, c_hs_b, c_ml_b, c_ms_b = _scan_direction(pr_c, 1, hg0, ml0)
        x_hg_f, _, x_ml_f, _ = _scan_direction(pr_x, 0, c_hs_f, c_ms_f)
        x_hg_b, _, x_ml_b, _ = _scan_direction(pr_x, 1, c_hs_b, c_ms_b)
        x = x + g1 * _mixer_out(pr_x, x_hg_f + x_hg_b, x_ml_f + x_ml_b, hg_norm_w[l], ml_norm_w[l], w_out[l])
        if not last:
            ctx = ctx + cg1 * _mixer_out(pr_c, c_hg_f + c_hg_b, c_ml_f + c_ml_b, hg_norm_w[l], ml_norm_w[l], w_out[l])
        v_x = rms_norm(x, norm2_w[l]) * (1.0 + sc2) + sh2
        x = x + g2 * ec_moe(v_x, router_w[l], exp_w_gate[l], exp_w_up[l], exp_w_down[l])
        if not last:
            v_c = rms_norm(ctx, norm2_w[l]) * (1.0 + csc2) + csh2
            ctx = ctx + cg2 * ec_moe(v_c, router_w[l], exp_w_gate[l], exp_w_up[l], exp_w_down[l])
    return rms_norm(x, final_norm_w)
```

```cpp
#include <hip/hip_runtime.h>
#include <cstdio>
#include <cstdint>

#define GAS __attribute__((address_space(1)))
#define LAS __attribute__((address_space(3)))
typedef unsigned short bf16;
typedef float f32x4 __attribute__((ext_vector_type(4)));
typedef float f32x2 __attribute__((ext_vector_type(2)));
typedef unsigned u32x4 __attribute__((ext_vector_type(4)));
typedef unsigned u32x2 __attribute__((ext_vector_type(2)));
typedef short bf16x8 __attribute__((ext_vector_type(8)));
typedef __bf16 bf16x2_t __attribute__((ext_vector_type(2)));
typedef _Float16 f16x2_t __attribute__((ext_vector_type(2)));

constexpr int D = 1024, NB = 4, SEQ = 8192, CTX = 256, SROW = SEQ + CTX, R_ALL = NB * SROW, R_X = NB * SEQ;
constexpr int PROJ = 4624, NPROJ = 4608;
constexpr int NE = 16, CAP = 1024, FF = 1024, R_MOE = NE * NB * CAP;
constexpr float EPS = 1e-6f;
constexpr int NTHR = 512, NWAVES = 8;
constexpr int LDS_BYTES = 147456;

constexpr size_t MiB = 1u << 20;
constexpr size_t WS_CTL = 0;
constexpr size_t WS_MODP = 1 * MiB;
constexpr size_t WS_MOD = 3 * MiB;
constexpr size_t WS_LB = WS_MOD + 128 * 1024;
constexpr size_t WS_WGT = WS_LB + 4096;
constexpr size_t WS_RWT = WS_WGT + 65536;
constexpr size_t WS_WIN_T = 4 * MiB;
constexpr size_t WS_WOUT_T = 13 * MiB;
constexpr size_t WS_GATES = 15 * MiB;
constexpr size_t WS_WGU_T = 18 * MiB;
constexpr size_t WS_WD_T = 82 * MiB;
constexpr size_t WS_U = 114 * MiB;
constexpr size_t WS_HQ = 180 * MiB;
constexpr size_t WS_HV = 213 * MiB;
constexpr size_t WS_HG = 246 * MiB;
constexpr size_t WS_LF = 279 * MiB;
constexpr size_t WS_QK = 345 * MiB;
constexpr size_t WS_MV = 411 * MiB;
constexpr size_t WS_MO = 444 * MiB;
constexpr size_t WS_AFF = 477 * MiB;
constexpr size_t WS_ROWMAP = 479 * MiB;
constexpr size_t WS_GATEV = WS_ROWMAP + 262144;
constexpr size_t WS_SLOT = 480 * MiB;
constexpr size_t WS_END = 512 * MiB;
constexpr size_t WS_QKC = WS_U;
constexpr size_t WS_AMIX2 = WS_LF;
constexpr size_t WS_VX = WS_U;
constexpr size_t WS_H = WS_HQ;
constexpr size_t WS_Y = 308 * MiB;

struct Params {
    const float *x, *c, *ctx, *c_ctx, *ada_w, *ada_b, *norm1_w, *w_in, *conv_w, *conv_b, *lb_logits, *ml_gate_b, *hg_norm_w, *ml_norm_w, *w_out, *norm2_w,
        *router_w, *wg, *wu, *wd, *final_w;
    float* out; unsigned char* ws;
};

__device__ __forceinline__ unsigned pk2(float lo, float hi) { f32x2 v = {lo, hi}; bf16x2_t b = __builtin_convertvector(v, bf16x2_t); return __builtin_bit_cast(unsigned, b); }
__device__ __forceinline__ unsigned pkh2(float lo, float hi) { f32x2 v = {lo, hi}; f16x2_t b = __builtin_convertvector(v, f16x2_t); return __builtin_bit_cast(unsigned, b); }
__device__ __forceinline__ float bf2f(unsigned short b) { return __uint_as_float((unsigned)b << 16); }
__device__ __forceinline__ float bflo(unsigned w) { return __uint_as_float(w << 16); }
__device__ __forceinline__ float bfhi(unsigned w) { return __uint_as_float(w & 0xffff0000u); }
__device__ __forceinline__ float h2f(unsigned short h) { return (float)__builtin_bit_cast(_Float16, h); }
__device__ __forceinline__ float sigmoid_(float x) { return 1.0f / (1.0f + __expf(-x)); }
__device__ __forceinline__ float silu_(float x) { return x * sigmoid_(x); }
__device__ __forceinline__ float wave_sum(float v) {
#pragma unroll
    for (int o = 1; o < 64; o <<= 1) v += __shfl_xor(v, o);
    return v;
}
#define LDS_WAIT() asm volatile("s_waitcnt lgkmcnt(0)" ::: "memory")
#define VM_WAIT() asm volatile("s_waitcnt vmcnt(0)" ::: "memory")

namespace pg8 {
constexpr int BM = 256, BK = 64, HALF = 128, HTB = HALF * BK * 2, STAGE_BYTES = 8 * HTB, NXCD = 8, WGM = 8;
__host__ __device__ __forceinline__ int lds_byte(int r, int c) { const int st = (r >> 4) * 2 + (c >> 5), rr = r & 15, cc = c & 31, ob = rr * 64 + cc * 2; return st * 1024 + (ob ^ (((ob >> 9) & 1) << 5)); }
__host__ __device__ __forceinline__ void stage_rc(int b, int& R, int& C) { const int st = b / 1024, sb = b % 1024, swz = sb ^ (((sb >> 9) & 1) << 5); R = (st >> 1) * 16 + swz / 64; C = (st & 1) * 32 + (swz % 64) / 2; }
__host__ __device__ __forceinline__ int perm32(int rho) { const int n = rho >> 4, i = rho & 15; return 8 * (i >> 2) + 4 * n + (i & 3); }

struct Unit { int pm, pn; size_t boff; };
struct Gemm { const bf16* A; const bf16* Bt; int K; const int* rowmap; };

struct StaticOrder {
    int nM, nN, nwg, G, c;
    __device__ void init(int M, int N, int G_, int c_) { nM = M / BM; nN = N / BM; nwg = nM * nN; G = G_; c = c_; }
    __device__ bool next(int i, Unit& u) const {
        const long L = (long)i * G + c; if (L >= nwg) return false;
        int wgid = (int)L; { const int q = nwg / NXCD, r = nwg % NXCD, xcd = wgid % NXCD, off = wgid / NXCD; wgid = (xcd < r ? xcd * (q + 1) : r * (q + 1) + (xcd - r) * q) + off; }
        const int nig = WGM * nN, gid = wgid / nig, fm = gid * WGM, gsz = (nM - fm) < WGM ? (nM - fm) : WGM;
        u.pm = fm + ((wgid % nig) % gsz); u.pn = (wgid % nig) / gsz; u.boff = 0; return true;
    }
};
struct PanelOrder {
    int pm, npn; size_t boff;
    __device__ bool next(int i, Unit& u) const { if (i >= npn) return false; u.pm = pm; u.pn = i; u.boff = boff; return true; }
};

template <class Epi, class Sched, bool ALIGN_EPI, bool GATHER>
__device__ __forceinline__ void gemm_phase(LAS unsigned char* lds, const Gemm g, const Sched& S, const Epi& E) {
    const int tid = threadIdx.x, wid = __builtin_amdgcn_readfirstlane(tid >> 6), lane = tid & 63, wr = wid >> 2, wc = wid & 3, fr = lane & 15, fq = lane >> 4;
    const int K = g.K, nt = K / BK;
    Unit cur, nxt; int ui = 0;
    if (!S.next(0, cur)) return;
    const size_t kstep = (size_t)(BK * 2);
    const size_t hstep = (size_t)HALF * K * 2;
    const size_t tstep = 2 * hstep;
    unsigned voffA[2][2], voffB[2];
#pragma unroll
    for (int i = 0; i < 2; ++i) { int R, C; stage_rc(tid * 16 + i * 8192, R, C); const int Rb = Epi::PERM ? ((R & ~31) + perm32(R & 31)) : R;
        voffB[i] = (unsigned)(Rb * K + C) * 2u;
#pragma unroll
        for (int h = 0; h < 2; ++h) {
            if (GATHER) voffA[h][i] = (unsigned)g.rowmap[cur.pm * BM + h * HALF + R] * (unsigned)(K * 2) + (unsigned)C * 2u;
            else voffA[h][i] = (unsigned)(R * K + C) * 2u + (unsigned)(h * hstep);
        } }
    const unsigned ldsw = (unsigned)wid * 1024u;
    const int aoff = lds_byte(wr * 64 + fr, fq * 8), boff = lds_byte(wc * 32 + fr, fq * 8);
#define PG8_SA(b, h) (((b) * 2 + (h)) * HTB)
#define PG8_SB(b, h) ((4 + (b) * 2 + (h)) * HTB)
#define PG8_STAGE_A(bufoff, gbase, h) do { _Pragma("unroll") for (int _i = 0; _i < 2; ++_i) \
        __builtin_amdgcn_global_load_lds((const unsigned*)((const char*)(gbase) + voffA[h][_i]), (LAS unsigned*)(lds + (bufoff) + ldsw + _i * 8192), 16, 0, 0); } while (0)
#define PG8_STAGE_B(bufoff, gbase) do { _Pragma("unroll") for (int _i = 0; _i < 2; ++_i) \
        __builtin_amdgcn_global_load_lds((const unsigned*)((const char*)(gbase) + voffB[_i]), (LAS unsigned*)(lds + (bufoff) + ldsw + _i * 8192), 16, 0, 0); } while (0)
#define PG8_LDA(dst, b, h) do { _Pragma("unroll") for (int m = 0; m < 4; ++m) _Pragma("unroll") for (int k = 0; k < 2; ++k) dst[m][k] = *(const LAS bf16x8*)(lds + PG8_SA(b, h) + aoff + m * 2048 + k * 1024); } while (0)
#define PG8_LDB(dst, b, h) do { _Pragma("unroll") for (int n = 0; n < 2; ++n) _Pragma("unroll") for (int k = 0; k < 2; ++k) dst[n][k] = *(const LAS bf16x8*)(lds + PG8_SB(b, h) + boff + n * 2048 + k * 1024); } while (0)
#define PG8_MMA(ai, bj, At, Bt) do { __builtin_amdgcn_s_setprio(1); _Pragma("unroll") for (int m = 0; m < 4; ++m) _Pragma("unroll") for (int n = 0; n < 2; ++n) _Pragma("unroll") for (int k = 0; k < 2; ++k) \
        acc[ai][bj][m][n] = __builtin_amdgcn_mfma_f32_16x16x32_bf16(Bt[n][k], At[m][k], acc[ai][bj][m][n], 0, 0, 0); __builtin_amdgcn_s_setprio(0); } while (0)
#define PG8_WAIT_V(n) asm volatile("s_waitcnt vmcnt(" #n ")" ::: "memory")
#define PG8_WAIT_L(n) asm volatile("s_waitcnt lgkmcnt(" #n ")" ::: "memory")
#define PG8_BAR __builtin_amdgcn_s_barrier()
#define PG8_SCHED __builtin_amdgcn_sched_barrier(0)
    f32x4 acc[2][2][4][2];
#pragma unroll
    for (int a = 0; a < 2; ++a)
#pragma unroll
        for (int b = 0; b < 2; ++b)
#pragma unroll
            for (int m = 0; m < 4; ++m)
#pragma unroll
                for (int n = 0; n < 2; ++n) acc[a][b][m][n] = (f32x4){0.f, 0.f, 0.f, 0.f};
    bf16x8 At[4][2], B0[2][2], B1[2][2];
    const char* cA = GATHER ? (const char*)g.A : (const char*)g.A + (size_t)cur.pm * tstep;
    const char* cB = (const char*)g.Bt + cur.boff + (size_t)cur.pn * tstep;
    if (GATHER) VM_WAIT();
    PG8_STAGE_B(PG8_SB(0, 0), cB); PG8_STAGE_B(PG8_SB(0, 1), cB + hstep); PG8_STAGE_A(PG8_SA(0, 0), cA, 0); PG8_STAGE_A(PG8_SA(0, 1), cA, 1);
    if (wr == 1) PG8_BAR;
    PG8_WAIT_V(2); PG8_BAR;
    PG8_STAGE_B(PG8_SB(1, 0), cB + kstep); PG8_STAGE_A(PG8_SA(1, 0), cA + kstep, 0); PG8_STAGE_B(PG8_SB(1, 1), cB + hstep + kstep);
    PG8_WAIT_V(6); PG8_BAR;
    for (;;) {
        const bool has_next = S.next(ui + 1, nxt);
        const char* nA = has_next ? (GATHER ? (const char*)g.A : (const char*)g.A + (size_t)nxt.pm * tstep) : cA;
        const char* nB = has_next ? (const char*)g.Bt + nxt.boff + (size_t)nxt.pn * tstep : cB;
        for (int t = 0; t < nt; t += 2) {
            const bool last = (t == nt - 2);
            const char* a1 = cA + (size_t)(t + 1) * kstep;
            const char* a2 = last ? nA : cA + (size_t)(t + 2) * kstep; const char* b2 = last ? nB : cB + (size_t)(t + 2) * kstep;
            const char* a3 = a2 + kstep; const char* b3 = b2 + kstep;
            PG8_LDB(B0, 0, 0); PG8_LDB(B1, 0, 1); PG8_SCHED; PG8_LDA(At, 0, 0); PG8_STAGE_A(PG8_SA(1, 1), a1, 1);
            PG8_WAIT_V(8); PG8_WAIT_L(0); PG8_BAR; PG8_MMA(0, 0, At, B0); PG8_MMA(0, 1, At, B1); PG8_BAR; PG8_SCHED;
            PG8_LDA(At, 0, 1); PG8_STAGE_B(PG8_SB(0, 0), b2); PG8_STAGE_B(PG8_SB(0, 1), b2 + hstep); PG8_STAGE_A(PG8_SA(0, 0), a2, 0);
            PG8_WAIT_V(8); PG8_WAIT_L(0); PG8_BAR; PG8_MMA(1, 0, At, B0); PG8_MMA(1, 1, At, B1); PG8_BAR; PG8_SCHED;
            PG8_LDB(B0, 1, 0); PG8_LDB(B1, 1, 1); PG8_SCHED; PG8_LDA(At, 1, 0); PG8_STAGE_A(PG8_SA(0, 1), a2, 1);
            PG8_WAIT_V(8); PG8_WAIT_L(0); PG8_BAR; PG8_MMA(0, 0, At, B0); PG8_MMA(0, 1, At, B1); PG8_BAR; PG8_SCHED;
            PG8_LDA(At, 1, 1); PG8_STAGE_B(PG8_SB(1, 0), b3); PG8_STAGE_B(PG8_SB(1, 1), b3 + hstep); PG8_STAGE_A(PG8_SA(1, 0), a3, 0);
            PG8_WAIT_V(8); PG8_WAIT_L(0); PG8_BAR; PG8_MMA(1, 0, At, B0); PG8_MMA(1, 1, At, B1); PG8_BAR; PG8_SCHED;
        }
        if constexpr (ALIGN_EPI) { if (wr == 0) PG8_BAR; }
        E(acc, cur, wr, wc, fr, fq);
        if (!has_next) break;
#pragma unroll
        for (int a = 0; a < 2; ++a)
#pragma unroll
            for (int b = 0; b < 2; ++b)
#pragma unroll
                for (int m = 0; m < 4; ++m)
#pragma unroll
                    for (int n = 0; n < 2; ++n) acc[a][b][m][n] = (f32x4){0.f, 0.f, 0.f, 0.f};
        cur = nxt; cA = nA; cB = nB; ++ui;
        if constexpr (ALIGN_EPI) { if (wr == 1) PG8_BAR; }
    }
    PG8_WAIT_V(0);
    if constexpr (!ALIGN_EPI) { if (wr == 0) PG8_BAR; }
    PG8_BAR;
#undef PG8_SA
#undef PG8_SB
#undef PG8_STAGE_A
#undef PG8_STAGE_B
#undef PG8_LDA
#undef PG8_LDB
#undef PG8_MMA
#undef PG8_WAIT_V
#undef PG8_WAIT_L
#undef PG8_BAR
#undef PG8_SCHED
}

struct EpiInProj {
    static constexpr bool PERM = true;
    unsigned char* ws; const float* lb;
    __device__ __forceinline__ void operator()(const f32x4 (&acc)[2][2][4][2], const Unit& u, int wr, int wc, int fr, int fq) const {
        const int pn = u.pn; size_t base; int ld, colbase, act;
        if (pn < 2) { base = WS_HQ; ld = 512; colbase = pn * 256; act = 1; }
        else if (pn < 4) { base = WS_HV; ld = 512; colbase = (pn - 2) * 256; act = 0; }
        else if (pn < 6) { base = WS_HG; ld = 512; colbase = (pn - 4) * 256; act = 1; }
        else if (pn < 10) { base = WS_LF; ld = 1024; colbase = (pn - 6) * 256; act = 3; }
        else if (pn < 14) { base = WS_QK; ld = 1024; colbase = (pn - 10) * 256; act = 0; }
        else if (pn < 16) { base = WS_MV; ld = 512; colbase = (pn - 14) * 256; act = 0; }
        else { base = WS_MO; ld = 512; colbase = (pn - 16) * 256; act = 2; }
        bf16* O = (bf16*)(ws + base);
        const int row0 = u.pm * BM + wr * 64 + fr, col0 = colbase + wc * 32 + 8 * fq;
#pragma unroll
        for (int bj = 0; bj < 2; ++bj) {
            float lbv[8];
            if (act == 3) {
#pragma unroll
                for (int e = 0; e < 8; ++e) lbv[e] = lb[col0 + bj * HALF + e];
            }
#pragma unroll
            for (int ai = 0; ai < 2; ++ai)
#pragma unroll
                for (int m = 0; m < 4; ++m) {
                    float v[8];
#pragma unroll
                    for (int e = 0; e < 4; ++e) { v[e] = acc[ai][bj][m][0][e]; v[4 + e] = acc[ai][bj][m][1][e]; }
                    u32x4 w;
                    if (act == 3) {
#pragma unroll
                        for (int e = 0; e < 8; ++e) v[e] = __logf(lbv[e] + (1.0f - lbv[e]) * sigmoid_(v[e]));
                        w.x = pkh2(v[0], v[1]); w.y = pkh2(v[2], v[3]); w.z = pkh2(v[4], v[5]); w.w = pkh2(v[6], v[7]);
                    } else {
                        if (act == 1) {
#pragma unroll
                            for (int e = 0; e < 8; ++e) v[e] = silu_(v[e]);
                        } else if (act == 2) {
#pragma unroll
                            for (int e = 0; e < 8; ++e) v[e] = sigmoid_(v[e]);
                        }
                        w.x = pk2(v[0], v[1]); w.y = pk2(v[2], v[3]); w.z = pk2(v[4], v[5]); w.w = pk2(v[6], v[7]);
                    }
                    *(u32x4*)(O + (size_t)(row0 + ai * HALF + m * 16) * ld + col0 + bj * HALF) = w;
                }
        }
    }
};
struct EpiOutProj {
    static constexpr bool PERM = false;
    const float* x; float* out; const float* mod;
    __device__ __forceinline__ void operator()(const f32x4 (&acc)[2][2][4][2], const Unit& u, int wr, int wc, int fr, int fq) const {
        const int row0 = u.pm * BM + wr * 64 + fr, col0 = u.pn * BM + wc * 32 + 4 * fq;
        const float* g1 = mod + (size_t)(u.pm / 32) * 6144 + 2048;
#pragma unroll
        for (int bj = 0; bj < 2; ++bj)
#pragma unroll
            for (int n = 0; n < 2; ++n) {
                const int c = col0 + bj * HALF + n * 16; const f32x4 gv = *(const f32x4*)(g1 + c);
#pragma unroll
                for (int ai = 0; ai < 2; ++ai)
#pragma unroll
                    for (int m = 0; m < 4; ++m) { const size_t off = (size_t)(row0 + ai * HALF + m * 16) * D + c;
                        *(f32x4*)(out + off) = *(const f32x4*)(x + off) + gv * acc[ai][bj][m][n]; }
            }
    }
};
struct EpiMoE1 {
    static constexpr bool PERM = true;
    bf16* H;
    __device__ __forceinline__ void operator()(const f32x4 (&acc)[2][2][4][2], const Unit& u, int wr, int wc, int fr, int fq) const {
        const int row0 = u.pm * BM + wr * 64 + fr, col0 = u.pn * HALF + wc * 32 + 8 * fq;
#pragma unroll
        for (int ai = 0; ai < 2; ++ai)
#pragma unroll
            for (int m = 0; m < 4; ++m) {
                float v[8];
#pragma unroll
                for (int e = 0; e < 4; ++e) { v[e] = silu_(acc[ai][0][m][0][e]) * acc[ai][1][m][0][e]; v[4 + e] = silu_(acc[ai][0][m][1][e]) * acc[ai][1][m][1][e]; }
                u32x4 w; w.x = pk2(v[0], v[1]); w.y = pk2(v[2], v[3]); w.z = pk2(v[4], v[5]); w.w = pk2(v[6], v[7]);
                *(u32x4*)(H + (size_t)(row0 + ai * HALF + m * 16) * FF + col0) = w;
            }
    }
};
struct EpiMoE2 {
    static constexpr bool PERM = true;
    bf16* Y; const float* gatev;
    __device__ __forceinline__ void operator()(const f32x4 (&acc)[2][2][4][2], const Unit& u, int wr, int wc, int fr, int fq) const {
        const int row0 = u.pm * BM + wr * 64 + fr, col0 = u.pn * BM + wc * 32 + 8 * fq;
#pragma unroll
        for (int ai = 0; ai < 2; ++ai)
#pragma unroll
            for (int m = 0; m < 4; ++m) { const int row = row0 + ai * HALF + m * 16; const float gt = gatev[row];
#pragma unroll
                for (int bj = 0; bj < 2; ++bj) { const f32x4 a = acc[ai][bj][m][0] * gt, b = acc[ai][bj][m][1] * gt;
                    u32x4 w; w.x = pk2(a[0], a[1]); w.y = pk2(a[2], a[3]); w.z = pk2(b[0], b[1]); w.w = pk2(b[2], b[3]);
                    *(u32x4*)(Y + (size_t)row * D + col0 + bj * HALF) = w; } }
    }
};
}

__device__ __forceinline__ void transpose_item(const float* W, int ldw, int k0, int n0, bf16* dst_row0, LAS float* scr, int lane) {
#pragma unroll 8
    for (int i = 0; i < 32; ++i) { const int kk = 2 * i + (lane >> 5); scr[kk * 33 + (lane & 31)] = W[(size_t)(k0 + kk) * ldw + n0 + (lane & 31)]; }
    LDS_WAIT(); asm volatile("" ::: "memory");
    const int c = lane & 7;
#pragma unroll
    for (int j = 0; j < 4; ++j) { const int n = (lane >> 3) + 8 * j; const LAS float* s = scr + (8 * c) * 33 + n;
        u32x4 o; o.x = pk2(s[0 * 33], s[1 * 33]); o.y = pk2(s[2 * 33], s[3 * 33]); o.z = pk2(s[4 * 33], s[5 * 33]); o.w = pk2(s[6 * 33], s[7 * 33]);
        *(u32x4*)(dst_row0 + (size_t)n * 1024 + k0 + 8 * c) = o; }
    LDS_WAIT(); asm volatile("" ::: "memory");
}
__device__ __forceinline__ void phase_prologue(const Params& p, LAS unsigned char* lds) {
    const int tid = threadIdx.x, lane = tid & 63, wave = tid >> 6;
    const int gw = blockIdx.x * NWAVES + wave, NGW = gridDim.x * NWAVES;
    LAS float* scr = (LAS float*)(lds + wave * 16384);
    constexpr int I_IN = 16 * 144, I_OUT = 16 * 32, I_E = 16 * 512, I_MOD = 24 * 16;
    constexpr int NITEMS = I_IN + I_OUT + 3 * I_E + I_MOD;
    unsigned char* ws = p.ws;
    for (int it = gw; it < NITEMS; it += NGW) {
        int r = it;
        if (r < I_IN) { const int kb = r / 144, nb = r % 144; transpose_item(p.w_in, PROJ, kb * 64, nb * 32, (bf16*)(ws + WS_WIN_T) + (size_t)(nb * 32) * 1024, scr, lane); continue; } r -= I_IN;
        if (r < I_OUT) { const int kb = r / 32, nb = r % 32; transpose_item(p.w_out, D, kb * 64, nb * 32, (bf16*)(ws + WS_WOUT_T) + (size_t)(nb * 32) * 1024, scr, lane); continue; } r -= I_OUT;
        if (r < 2 * I_E) { const int up = r / I_E; r -= up * I_E; const int e = r / 512, q = r % 512, kb = q / 32, nb = q % 32, n0 = nb * 32;
            const int drow = (n0 / 128) * 256 + up * 128 + (n0 % 128);
            transpose_item((up ? p.wu : p.wg) + (size_t)e * D * FF, FF, kb * 64, n0, (bf16*)(ws + WS_WGU_T) + ((size_t)e * 2048 + drow) * 1024, scr, lane); continue; } r -= 2 * I_E;
        if (r < I_E) { const int e = r / 512, q = r % 512, kb = q / 32, nb = q % 32;
            transpose_item(p.wd + (size_t)e * FF * D, D, kb * 64, nb * 32, (bf16*)(ws + WS_WD_T) + ((size_t)e * 1024 + nb * 32) * 1024, scr, lane); continue; } r -= I_E;
        {
            const int cb = r / 16, ks = r % 16; const int col = cb * 256 + lane * 4;
            f32x4 a[5];
#pragma unroll
            for (int q = 0; q < 5; ++q) a[q] = (f32x4){0.f, 0.f, 0.f, 0.f};
            for (int k = ks * 64; k < ks * 64 + 64; ++k) {
                const f32x4 w = *(const f32x4*)(p.ada_w + (size_t)k * 6144 + col);
#pragma unroll
                for (int q = 0; q < 5; ++q) { const float cv = (q < 4) ? p.c[q * D + k] : p.c_ctx[k]; a[q] += w * silu_(cv); }
            }
            float* mp = (float*)(ws + WS_MODP);
#pragma unroll
            for (int q = 0; q < 5; ++q) *(f32x4*)(mp + ((size_t)ks * 5 + q) * 6144 + col) = a[q];
        }
    }
    const int gt = blockIdx.x * NTHR + tid, NGT = gridDim.x * NTHR;
    for (int i = gt; i < 1024; i += NGT) { const float l0 = p.lb_logits[i], l1 = p.lb_logits[1024 + i]; ((float*)(ws + WS_LB))[i] = 1.0f / (1.0f + __expf(l1 - l0)); }
    for (int i = gt; i < 16 * 1024; i += NGT) { const int g = i >> 10, k = i & 1023; ((float*)(ws + WS_WGT))[i] = p.w_in[(size_t)k * PROJ + NPROJ + g]; ((float*)(ws + WS_RWT))[i] = p.router_w[k * 16 + g]; }
}

__device__ __forceinline__ void phase_u(const Params& p, LAS unsigned char* lds) {
    const int tid = threadIdx.x, lane = tid & 63, wave = tid >> 6;
    unsigned char* ws = p.ws;
    LAS float* Lsh = (LAS float*)lds;
    LAS float* Lsc = Lsh + 5 * 1024;
    LAS float* Lnw = Lsc + 5 * 1024;
    LAS float* Lwg = Lnw + 1024;
    const float* modp = (const float*)(ws + WS_MODP);
    for (int idx = tid; idx < 5 * 2048; idx += NTHR) { const int r = idx / 2048, col = idx % 2048; float s = p.ada_b[col];
        for (int ks = 0; ks < 16; ++ks) s += modp[((size_t)ks * 5 + r) * 6144 + col];
        if (col < 1024) Lsh[r * 1024 + col] = s; else Lsc[r * 1024 + col - 1024] = s; }
    for (int e = blockIdx.x * NTHR + tid; e < 5 * 6144; e += gridDim.x * NTHR) { const int r = e / 6144, col = e % 6144; float s = p.ada_b[col];
        for (int ks = 0; ks < 16; ++ks) s += modp[((size_t)ks * 5 + r) * 6144 + col];
        ((float*)(ws + WS_MOD))[e] = s; }
    for (int i = tid; i < 1024; i += NTHR) Lnw[i] = p.norm1_w[i];
    for (int i = tid; i < 16 * 1024; i += NTHR) Lwg[i] = ((const float*)(ws + WS_WGT))[i];
    __syncthreads();
    const int gw = blockIdx.x * NWAVES + wave, NGW = gridDim.x * NWAVES;
    for (int row = gw; row < R_ALL; row += NGW) {
        const int b = row / SROW, s = row % SROW;
        const float* src = (s < CTX) ? p.ctx + ((size_t)b * CTX + s) * D : p.x + ((size_t)b * SEQ + (s - CTX)) * D;
        const int r = (s < CTX) ? 4 : b;
        f32x4 v[4]; float ss = 0.f;
#pragma unroll
        for (int j = 0; j < 4; ++j) { v[j] = *(const f32x4*)(src + j * 256 + lane * 4); ss += (v[j].x * v[j].x + v[j].y * v[j].y) + (v[j].z * v[j].z + v[j].w * v[j].w); }
        const float rstd = rsqrtf(wave_sum(ss) * (1.0f / D) + EPS);
        bf16* urow = (bf16*)(ws + WS_U) + (size_t)row * D;
#pragma unroll
        for (int j = 0; j < 4; ++j) { const int c0 = j * 256 + lane * 4;
            const f32x4 nw = *(const LAS f32x4*)(Lnw + c0), sc = *(const LAS f32x4*)(Lsc + r * 1024 + c0), sh = *(const LAS f32x4*)(Lsh + r * 1024 + c0);
            v[j] = v[j] * rstd * nw * (1.0f + sc) + sh;
            u32x2 w; w.x = pk2(v[j].x, v[j].y); w.y = pk2(v[j].z, v[j].w); *(u32x2*)(urow + c0) = w; }
        float mine = 0.f;
#pragma unroll 2
        for (int g = 0; g < 16; ++g) { float a = 0.f;
#pragma unroll
            for (int j = 0; j < 4; ++j) { const f32x4 w = *(const LAS f32x4*)(Lwg + g * 1024 + j * 256 + lane * 4); a += (v[j].x * w.x + v[j].y * w.y) + (v[j].z * w.z + v[j].w * w.w); }
            a = wave_sum(a); if (lane == g) mine = a; }
        if (lane < 16) { float gv = mine + p.ml_gate_b[lane];
            if ((lane >> 2) & 1) gv = fminf(gv, 0.f) - log1pf(__expf(-fabsf(gv)));
            ((float*)(ws + WS_GATES))[(size_t)row * 16 + lane] = gv; }
    }
}

__device__ __forceinline__ void phase_conv(const Params& p) {
    unsigned char* ws = p.ws;
    const bf16* QK = (const bf16*)(ws + WS_QK); bf16* QKC = (bf16*)(ws + WS_QKC);
    const long total = (long)R_ALL * 128;
    for (long it = (long)blockIdx.x * NTHR + threadIdx.x; it < total; it += (long)gridDim.x * NTHR) {
        const int row = (int)(it >> 7), ch = (int)(it & 127) * 8;
        const int b = row / SROW, s = row % SROW;
        float a[8];
#pragma unroll
        for (int e = 0; e < 8; ++e) a[e] = p.conv_b[ch + e];
        if (s < CTX) {
#pragma unroll
            for (int j = 0; j < 3; ++j) { const int s2 = s + j - 1; if (s2 < 0 || s2 >= CTX) continue;
                const u32x4 w = *(const u32x4*)(QK + ((size_t)b * SROW + s2) * 1024 + ch); const float* cw = p.conv_w + (size_t)(3 + j) * 1024 + ch;
                a[0] += bflo(w.x) * cw[0]; a[1] += bfhi(w.x) * cw[1]; a[2] += bflo(w.y) * cw[2]; a[3] += bfhi(w.y) * cw[3];
                a[4] += bflo(w.z) * cw[4]; a[5] += bfhi(w.z) * cw[5]; a[6] += bflo(w.w) * cw[6]; a[7] += bfhi(w.w) * cw[7]; }
        } else {
            const int t = s - CTX, gr = t >> 6, gc = t & 63;
#pragma unroll
            for (int i = 0; i < 3; ++i) { const int r2 = gr + i - 1; if (r2 < 0 || r2 >= 128) continue;
#pragma unroll
                for (int j = 0; j < 3; ++j) { const int c2 = gc + j - 1; if (c2 < 0 || c2 >= 64) continue;
                    const u32x4 w = *(const u32x4*)(QK + ((size_t)b * SROW + CTX + r2 * 64 + c2) * 1024 + ch); const float* cw = p.conv_w + (size_t)(i * 3 + j) * 1024 + ch;
                    a[0] += bflo(w.x) * cw[0]; a[1] += bfhi(w.x) * cw[1]; a[2] += bflo(w.y) * cw[2]; a[3] += bfhi(w.y) * cw[3];
                    a[4] += bflo(w.z) * cw[4]; a[5] += bfhi(w.z) * cw[5]; a[6] += bflo(w.w) * cw[6]; a[7] += bfhi(w.w) * cw[7]; } }
        }
        const float sc = (ch >= 512) ? 0.08838834764831845f : 1.0f;
#pragma unroll
        for (int e = 0; e < 8; ++e) a[e] = silu_(a[e]) * sc;
        u32x4 o; o.x = pk2(a[0], a[1]); o.y = pk2(a[2], a[3]); o.z = pk2(a[4], a[5]); o.w = pk2(a[6], a[7]);
        *(u32x4*)(QKC + (size_t)row * 1024 + ch) = o;
    }
}

template <bool ML>
__device__ __forceinline__ void scan_chain(const Params& p, LAS unsigned char* lds, int dir, int b, int h) {
    const int tid = threadIdx.x, v = tid & 127, cq = tid >> 7;
    unsigned char* ws = p.ws;
    LAS float* Fd = (LAS float*)lds;
    LAS float* Kd = Fd + 1024, *Qd = Kd + 1024, *Vd = Qd + 1024;
    LAS float* Pn = Vd + 1024;
    LAS float* Pd = Pn + 4096;
    LAS float* Li = Pd + 32, *Lf = Li + 8, *Em = Lf + 8;
    float S[32], nn[32];
#pragma unroll
    for (int i = 0; i < 32; ++i) { S[i] = 0.f; nn[i] = 0.f; }
    float m = 0.f;
    const int st = tid >> 6, sp = tid & 63;
    float rf0, rf1, rk0, rk1, rq0, rq1, rv0, rv1, rli = 0.f, rlf = 0.f;
#define ROW_OF(n) (b * SROW + (dir ? ((n) < CTX ? CTX - 1 - (n) : CTX + (SROW - 1 - (n))) : (n)))
#define STAGE_LOAD(n0_) do { const int row = ROW_OF((n0_) + st); const int c = h * 128 + 2 * sp; \
        if (!ML) { \
            const unsigned lf = *(const unsigned*)((const bf16*)(ws + WS_LF) + (size_t)row * 1024 + dir * 512 + c); \
            const unsigned q = *(const unsigned*)((const bf16*)(ws + WS_HQ) + (size_t)row * 512 + c); \
            const unsigned vv = *(const unsigned*)((const bf16*)(ws + WS_HV) + (size_t)row * 512 + c); \
            rf0 = __expf(h2f((unsigned short)(lf & 0xffff))); rf1 = __expf(h2f((unsigned short)(lf >> 16))); rk0 = 1.0f - rf0; rk1 = 1.0f - rf1; \
            rq0 = bflo(q); rq1 = bfhi(q); rv0 = bflo(vv); rv1 = bfhi(vv); \
        } else { \
            const unsigned q = *(const unsigned*)((const bf16*)(ws + WS_QKC) + (size_t)row * 1024 + c); \
            const unsigned k = *(const unsigned*)((const bf16*)(ws + WS_QKC) + (size_t)row * 1024 + 512 + c); \
            const unsigned vv = *(const unsigned*)((const bf16*)(ws + WS_MV) + (size_t)row * 512 + c); \
            rf0 = rf1 = 0.f; rk0 = bflo(k); rk1 = bfhi(k); rq0 = bflo(q); rq1 = bfhi(q); rv0 = bflo(vv); rv1 = bfhi(vv); \
            if (sp == 0) { const float* gp = (const float*)(ws + WS_GATES) + (size_t)row * 16 + dir * 8 + h; rli = gp[0]; rlf = gp[4]; } \
        } } while (0)
#define STAGE_WRITE() do { const int o_ = st * 128 + 2 * sp; \
        Fd[o_] = rf0; Fd[o_ + 1] = rf1; Kd[o_] = rk0; Kd[o_ + 1] = rk1; Qd[o_] = rq0; Qd[o_ + 1] = rq1; Vd[o_] = rv0; Vd[o_ + 1] = rv1; \
        if (ML && sp == 0) { Li[st] = rli; Lf[st] = rlf; } } while (0)
    STAGE_LOAD(0); STAGE_WRITE(); __syncthreads();
    for (int n0 = 0; n0 < SROW; n0 += 8) {
        if (n0 + 8 < SROW) STAGE_LOAD(n0 + 8);
#pragma unroll 1
        for (int t = 0; t < 8; ++t) {
            const float vv = Vd[t * 128 + v];
            float o = 0.f, dn = 0.f, fa = 0.f, ia = 0.f;
            if (ML) { const float li = Li[t], lf = Lf[t]; const float mn = fmaxf(lf + m, li); fa = __expf(lf + m - mn); ia = __expf(li - mn); m = mn; if (tid == 0) Em[t] = __expf(-mn); }
#pragma unroll
            for (int c4 = 0; c4 < 8; ++c4) {
                const f32x4 kk = *(const LAS f32x4*)(Kd + t * 128 + cq * 32 + c4 * 4), qq = *(const LAS f32x4*)(Qd + t * 128 + cq * 32 + c4 * 4);
                f32x4 ff; if (!ML) ff = *(const LAS f32x4*)(Fd + t * 128 + cq * 32 + c4 * 4);
#pragma unroll
                for (int e = 0; e < 4; ++e) { const int i = c4 * 4 + e;
                    if (!ML) { S[i] = ff[e] * S[i] + kk[e] * vv; o += S[i] * qq[e]; }
                    else { const float ik = ia * kk[e]; S[i] = fa * S[i] + ik * vv; nn[i] = fa * nn[i] + ik; o += S[i] * qq[e]; dn += nn[i] * qq[e]; } }
            }
            Pn[(t * 4 + cq) * 128 + v] = o;
            if (ML && v == 0) Pd[t * 4 + cq] = dn;
        }
        __syncthreads();
        if (n0 >= CTX) {
            const int t = tid >> 6, v0 = 2 * (tid & 63);
            float o0 = (Pn[(t * 4 + 0) * 128 + v0] + Pn[(t * 4 + 1) * 128 + v0]) + (Pn[(t * 4 + 2) * 128 + v0] + Pn[(t * 4 + 3) * 128 + v0]);
            float o1 = (Pn[(t * 4 + 0) * 128 + v0 + 1] + Pn[(t * 4 + 1) * 128 + v0 + 1]) + (Pn[(t * 4 + 2) * 128 + v0 + 1] + Pn[(t * 4 + 3) * 128 + v0 + 1]);
            if (ML) { const float den = (Pd[t * 4 + 0] + Pd[t * 4 + 1]) + (Pd[t * 4 + 2] + Pd[t * 4 + 3]); const float dd = fmaxf(fabsf(den), Em[t]); o0 = o0 / dd; o1 = o1 / dd; }
            const int row = ROW_OF(n0 + t); const int xrow = b * SEQ + (row - b * SROW - CTX);
            bf16* O = (bf16*)p.out + ((size_t)dir * R_X + xrow) * 1024 + (ML ? 512 : 0) + h * 128 + v0;
            *(unsigned*)O = pk2(o0, o1);
        }
        if (n0 + 8 < SROW) STAGE_WRITE();
        __syncthreads();
    }
}

__device__ __forceinline__ void phase_mixprep(const Params& p) {
    unsigned char* ws = p.ws;
    const int tid = threadIdx.x, lane = tid & 63, wave = tid >> 6;
    const int gw = blockIdx.x * NWAVES + wave, NGW = gridDim.x * NWAVES;
    for (int xr = gw; xr < R_X; xr += NGW) {
        const int b = xr / SEQ, t = xr % SEQ; const size_t row = (size_t)b * SROW + CTX + t;
        const bf16* of = (const bf16*)p.out + (size_t)xr * 1024 + lane * 16;
        const bf16* ob = (const bf16*)p.out + ((size_t)R_X + xr) * 1024 + lane * 16;
        float v[16];
#pragma unroll
        for (int q = 0; q < 2; ++q) { const u32x4 a = *(const u32x4*)(of + q * 8), c = *(const u32x4*)(ob + q * 8);
            v[q * 8 + 0] = bflo(a.x) + bflo(c.x); v[q * 8 + 1] = bfhi(a.x) + bfhi(c.x); v[q * 8 + 2] = bflo(a.y) + bflo(c.y); v[q * 8 + 3] = bfhi(a.y) + bfhi(c.y);
            v[q * 8 + 4] = bflo(a.z) + bflo(c.z); v[q * 8 + 5] = bfhi(a.z) + bfhi(c.z); v[q * 8 + 6] = bflo(a.w) + bflo(c.w); v[q * 8 + 7] = bfhi(a.w) + bfhi(c.w); }
        float s = 0.f;
#pragma unroll
        for (int e = 0; e < 16; ++e) s += v[e];
        s += __shfl_xor(s, 1); s += __shfl_xor(s, 2); s += __shfl_xor(s, 4);
        const bool ml = lane >= 32;
        const float mean = ml ? s * (1.0f / 128.0f) : 0.f;
        float q2 = 0.f;
#pragma unroll
        for (int e = 0; e < 16; ++e) { v[e] -= mean; q2 += v[e] * v[e]; }
        q2 += __shfl_xor(q2, 1); q2 += __shfl_xor(q2, 2); q2 += __shfl_xor(q2, 4);
        const float rstd = rsqrtf(q2 * (1.0f / 128.0f) + EPS);
        const int c0 = (lane & 31) * 16;
        const float* nw = (ml ? p.ml_norm_w : p.hg_norm_w) + c0;
        const bf16* gt = (const bf16*)(ws + (ml ? WS_MO : WS_HG)) + row * 512 + c0;
        const u32x4 g0 = *(const u32x4*)gt, g1 = *(const u32x4*)(gt + 8);
        float g[16] = {bflo(g0.x), bfhi(g0.x), bflo(g0.y), bfhi(g0.y), bflo(g0.z), bfhi(g0.z), bflo(g0.w), bfhi(g0.w),
                       bflo(g1.x), bfhi(g1.x), bflo(g1.y), bfhi(g1.y), bflo(g1.z), bfhi(g1.z), bflo(g1.w), bfhi(g1.w)};
#pragma unroll
        for (int e = 0; e < 16; ++e) v[e] = v[e] * rstd * nw[e] * g[e];
        u32x4 o0, o1; o0.x = pk2(v[0], v[1]); o0.y = pk2(v[2], v[3]); o0.z = pk2(v[4], v[5]); o0.w = pk2(v[6], v[7]);
        o1.x = pk2(v[8], v[9]); o1.y = pk2(v[10], v[11]); o1.z = pk2(v[12], v[13]); o1.w = pk2(v[14], v[15]);
        bf16* am = (bf16*)(ws + WS_AMIX2) + (size_t)xr * 1024 + lane * 16;
        *(u32x4*)am = o0; *(u32x4*)(am + 8) = o1;
    }
}

__device__ __forceinline__ void phase_vx(const Params& p, LAS unsigned char* lds) {
    unsigned char* ws = p.ws;
    const int tid = threadIdx.x, lane = tid & 63, wave = tid >> 6;
    LAS float* Lrw = (LAS float*)lds;
    LAS float* Lnw = Lrw + 16 * 1024;
    LAS float* Lsh = Lnw + 1024;
    LAS float* Lsc = Lsh + 4096;
    const float* mod = (const float*)(ws + WS_MOD);
    for (int i = tid; i < 16 * 1024; i += NTHR) Lrw[i] = ((const float*)(ws + WS_RWT))[i];
    for (int i = tid; i < 1024; i += NTHR) Lnw[i] = p.norm2_w[i];
    for (int i = tid; i < 4096; i += NTHR) { const int b = i >> 10, c = i & 1023; Lsh[i] = mod[(size_t)b * 6144 + 3072 + c]; Lsc[i] = mod[(size_t)b * 6144 + 4096 + c]; }
    __syncthreads();
    const int gw = blockIdx.x * NWAVES + wave, NGW = gridDim.x * NWAVES;
    for (int xr = gw; xr < R_X; xr += NGW) {
        const int b = xr / SEQ, t = xr % SEQ;
        const float* src = p.out + (size_t)xr * D;
        f32x4 v[4]; float ss = 0.f;
#pragma unroll
        for (int j = 0; j < 4; ++j) { v[j] = *(const f32x4*)(src + j * 256 + lane * 4); ss += (v[j].x * v[j].x + v[j].y * v[j].y) + (v[j].z * v[j].z + v[j].w * v[j].w); }
        const float rstd = rsqrtf(wave_sum(ss) * (1.0f / D) + EPS);
        bf16* vrow = (bf16*)(ws + WS_VX) + (size_t)xr * D;
#pragma unroll
        for (int j = 0; j < 4; ++j) { const int c0 = j * 256 + lane * 4;
            const f32x4 nw = *(const LAS f32x4*)(Lnw + c0), sc = *(const LAS f32x4*)(Lsc + b * 1024 + c0), sh = *(const LAS f32x4*)(Lsh + b * 1024 + c0);
            v[j] = v[j] * rstd * nw * (1.0f + sc) + sh;
            u32x2 w; w.x = pk2(v[j].x, v[j].y); w.y = pk2(v[j].z, v[j].w); *(u32x2*)(vrow + c0) = w; }
        float mine = 0.f;
#pragma unroll 2
        for (int g = 0; g < 16; ++g) { float a = 0.f;
#pragma unroll
            for (int j = 0; j < 4; ++j) { const f32x4 w = *(const LAS f32x4*)(Lrw + g * 1024 + j * 256 + lane * 4); a += (v[j].x * w.x + v[j].y * w.y) + (v[j].z * w.z + v[j].w * w.w); }
            a = wave_sum(a); if (lane == g) mine = a; }
        float mx = (lane < 16) ? mine : -3.0e38f;
        mx = fmaxf(mx, __shfl_xor(mx, 1)); mx = fmaxf(mx, __shfl_xor(mx, 2)); mx = fmaxf(mx, __shfl_xor(mx, 4)); mx = fmaxf(mx, __shfl_xor(mx, 8));
        mx = __shfl(mx, 0);
        float ex = (lane < 16) ? __expf(mine - mx) : 0.f;
        float sm = ex; sm += __shfl_xor(sm, 1); sm += __shfl_xor(sm, 2); sm += __shfl_xor(sm, 4); sm += __shfl_xor(sm, 8);
        sm = __shfl(sm, 0);
        if (lane < 16) ((float*)(ws + WS_AFF))[((size_t)b * 16 + lane) * SEQ + t] = ex / sm;
    }
}

__device__ __forceinline__ void phase_topk_naive(const Params& p, LAS unsigned char* lds) {
    unsigned char* ws = p.ws;
    const int tid = threadIdx.x;
    LAS float* La = (LAS float*)lds;
    for (int item = blockIdx.x; item < 64 * 16; item += gridDim.x) {
        const int be = item >> 4, tb = item & 15, b = be >> 4, e = be & 15;
        const float* aff = (const float*)(ws + WS_AFF) + (size_t)be * SEQ;
        __syncthreads();
        for (int i = tid; i < SEQ / 4; i += NTHR) *(LAS f32x4*)(La + i * 4) = *(const f32x4*)(aff + i * 4);
        __syncthreads();
        const int t = tb * NTHR + tid; const float a = La[t];
        int rank = 0;
        for (int i = 0; i < SEQ; i += 4) { const f32x4 w = *(const LAS f32x4*)(La + i);
            rank += (w.x > a || (w.x == a && i < t)) ? 1 : 0; rank += (w.y > a || (w.y == a && i + 1 < t)) ? 1 : 0;
            rank += (w.z > a || (w.z == a && i + 2 < t)) ? 1 : 0; rank += (w.w > a || (w.w == a && i + 3 < t)) ? 1 : 0; }
        int slot = -1;
        if (rank < CAP) { slot = rank; const int mrow = (e * NB + b) * CAP + rank; ((int*)(ws + WS_ROWMAP))[mrow] = b * SEQ + t; ((float*)(ws + WS_GATEV))[mrow] = a; }
        ((int*)(ws + WS_SLOT))[((size_t)b * SEQ + t) * 16 + e] = slot;
    }
}

__device__ __forceinline__ void phase_final(const Params& p) {
    unsigned char* ws = p.ws;
    const int tid = threadIdx.x, lane = tid & 63, wave = tid >> 6;
    const int gw = blockIdx.x * NWAVES + wave, NGW = gridDim.x * NWAVES;
    const float* mod = (const float*)(ws + WS_MOD);
    for (int xr = gw; xr < R_X; xr += NGW) {
        const int b = xr / SEQ;
        float* row = p.out + (size_t)xr * D;
        f32x4 acc[4];
#pragma unroll
        for (int j = 0; j < 4; ++j) acc[j] = (f32x4){0.f, 0.f, 0.f, 0.f};
        const int myslot = (lane < 16) ? ((const int*)(ws + WS_SLOT))[(size_t)xr * 16 + lane] : -1;
        for (int e = 0; e < 16; ++e) { const int sl = __shfl(myslot, e); if (sl < 0) continue;
            const bf16* y = (const bf16*)(ws + WS_Y) + ((size_t)(e * NB + b) * CAP + sl) * D;
#pragma unroll
            for (int j = 0; j < 4; ++j) { const u32x2 w = *(const u32x2*)(y + j * 256 + lane * 4); acc[j].x += bflo(w.x); acc[j].y += bfhi(w.x); acc[j].z += bflo(w.y); acc[j].w += bfhi(w.y); } }
        f32x4 v[4]; float ss = 0.f;
#pragma unroll
        for (int j = 0; j < 4; ++j) { const int c0 = j * 256 + lane * 4; const f32x4 g2 = *(const f32x4*)(mod + (size_t)b * 6144 + 5120 + c0);
            v[j] = *(const f32x4*)(row + c0) + g2 * acc[j]; ss += (v[j].x * v[j].x + v[j].y * v[j].y) + (v[j].z * v[j].z + v[j].w * v[j].w); }
        const float rstd = rsqrtf(wave_sum(ss) * (1.0f / D) + EPS);
#pragma unroll
        for (int j = 0; j < 4; ++j) { const int c0 = j * 256 + lane * 4; const f32x4 fw = *(const f32x4*)(p.final_w + c0); *(f32x4*)(row + c0) = v[j] * rstd * fw; }
    }
}

#define KDEF(name) __global__ void __launch_bounds__(NTHR, 2) name(Params p)
#define LDS_DECL extern __shared__ __attribute__((aligned(16))) unsigned char lds_raw[]; LAS unsigned char* lds = (LAS unsigned char*)lds_raw
KDEF(k_prologue) { LDS_DECL; phase_prologue(p, lds); }
KDEF(k_u) { LDS_DECL; phase_u(p, lds); }
KDEF(k_inproj) { LDS_DECL;
    pg8::Gemm g{(const bf16*)(p.ws + WS_U), (const bf16*)(p.ws + WS_WIN_T), D, nullptr}; pg8::StaticOrder S; S.init(R_ALL, NPROJ, gridDim.x, blockIdx.x);
    pg8::EpiInProj E{p.ws, (const float*)(p.ws + WS_LB)};
    pg8::gemm_phase<pg8::EpiInProj, pg8::StaticOrder, true, false>(lds, g, S, E); }
KDEF(k_conv) { phase_conv(p); }
KDEF(k_scan) { LDS_DECL; const int ch = blockIdx.x; if (ch >= 64) return; const int type = ch >> 5, dir = (ch >> 4) & 1, b = (ch >> 2) & 3, h = ch & 3;
    if (type) scan_chain<true>(p, lds, dir, b, h); else scan_chain<false>(p, lds, dir, b, h); }
KDEF(k_mixprep) { phase_mixprep(p); }
KDEF(k_outproj) { LDS_DECL;
    pg8::Gemm g{(const bf16*)(p.ws + WS_AMIX2), (const bf16*)(p.ws + WS_WOUT_T), D, nullptr}; pg8::StaticOrder S; S.init(R_X, D, gridDim.x, blockIdx.x);
    pg8::EpiOutProj E{p.x, p.out, (const float*)(p.ws + WS_MOD)};
    pg8::gemm_phase<pg8::EpiOutProj, pg8::StaticOrder, true, false>(lds, g, S, E); }
KDEF(k_vx) { LDS_DECL; phase_vx(p, lds); }
KDEF(k_topk) { LDS_DECL; phase_topk_naive(p, lds); }
KDEF(k_moe) { LDS_DECL;
    const int w = blockIdx.x, xcd = w & 7, idx = w >> 3, e = xcd * 2 + (idx >> 4), pm = e * 16 + (idx & 15);
    {   pg8::Gemm g{(const bf16*)(p.ws + WS_VX), (const bf16*)(p.ws + WS_WGU_T), D, (const int*)(p.ws + WS_ROWMAP)};
        pg8::PanelOrder S{pm, 8, (size_t)e * 2048 * 1024 * 2}; pg8::EpiMoE1 E{(bf16*)(p.ws + WS_H)};
        pg8::gemm_phase<pg8::EpiMoE1, pg8::PanelOrder, true, true>(lds, g, S, E); }
    VM_WAIT(); __syncthreads();
    if (threadIdx.x == 0) { __builtin_amdgcn_fence(__ATOMIC_ACQUIRE, "agent"); VM_WAIT(); }
    __syncthreads();
    {   pg8::Gemm g{(const bf16*)(p.ws + WS_H), (const bf16*)(p.ws + WS_WD_T), FF, nullptr};
        pg8::PanelOrder S{pm, 4, (size_t)e * 1024 * 1024 * 2}; pg8::EpiMoE2 E{(bf16*)(p.ws + WS_Y), (const float*)(p.ws + WS_GATEV)};
        pg8::gemm_phase<pg8::EpiMoE2, pg8::PanelOrder, true, false>(lds, g, S, E); } }
KDEF(k_final) { phase_final(p); }

extern "C" void kernel_launch(void* const* d_in, const int* in_sizes, int n_in, void* d_out, int out_size, void* d_ws, size_t ws_size, hipStream_t stream) {
    static int ok = 0;
    if (ok == 0) {
        if (n_in != 21 || out_size != R_X * D || ws_size < WS_END) { fprintf(stderr, "kernel_launch: unexpected shapes: n_in %d out %d ws %zu\n", n_in, out_size, ws_size); ok = -1; return; }
        const void* ks[] = {(const void*)k_prologue, (const void*)k_u, (const void*)k_inproj, (const void*)k_conv, (const void*)k_scan, (const void*)k_mixprep, (const void*)k_outproj,
                            (const void*)k_vx, (const void*)k_topk, (const void*)k_moe, (const void*)k_final};
        for (auto k : ks) if (hipFuncSetAttribute(k, hipFuncAttributeMaxDynamicSharedMemorySize, LDS_BYTES) != hipSuccess) { fprintf(stderr, "kernel_launch: hipFuncSetAttribute failed\n"); ok = -1; return; }
        ok = 1;
    }
    if (ok < 0) return;
    Params p{};
    const float** pp = (const float**)&p;
    for (int i = 0; i < 21; ++i) pp[i] = (const float*)d_in[i];
    p.out = (float*)d_out; p.ws = (unsigned char*)d_ws;
    const dim3 G(256), B(NTHR);
    hipLaunchKernelGGL(k_prologue, G, B, LDS_BYTES, stream, p);
    hipLaunchKernelGGL(k_u, G, B, LDS_BYTES, stream, p);
    hipLaunchKernelGGL(k_inproj, G, B, LDS_BYTES, stream, p);
    hipLaunchKernelGGL(k_conv, G, B, LDS_BYTES, stream, p);
    hipLaunchKernelGGL(k_scan, G, B, LDS_BYTES, stream, p);
    hipLaunchKernelGGL(k_mixprep, G, B, LDS_BYTES, stream, p);
    hipLaunchKernelGGL(k_outproj, G, B, LDS_BYTES, stream, p);
    hipLaunchKernelGGL(k_vx, G, B, LDS_BYTES, stream, p);
    hipLaunchKernelGGL(k_topk, G, B, LDS_BYTES, stream, p);
    hipLaunchKernelGGL(k_moe, G, B, LDS_BYTES, stream, p);
    hipLaunchKernelGGL(k_final, G, B, LDS_BYTES, stream, p);
}
```

```cpp
#include <hip/hip_runtime.h>
#include <cstdio>
#include <cstdint>

#define GAS __attribute__((address_space(1)))
#define LAS __attribute__((address_space(3)))
typedef unsigned short bf16;
typedef float f32x4 __attribute__((ext_vector_type(4)));
typedef float f32x2 __attribute__((ext_vector_type(2)));
typedef unsigned u32x4 __attribute__((ext_vector_type(4)));
typedef unsigned u32x2 __attribute__((ext_vector_type(2)));
typedef short bf16x8 __attribute__((ext_vector_type(8)));
typedef __bf16 bf16x2_t __attribute__((ext_vector_type(2)));
typedef _Float16 f16x2_t __attribute__((ext_vector_type(2)));

constexpr int D = 1024, NB = 4, SEQ = 8192, CTX = 256, SROW = SEQ + CTX, R_ALL = NB * SROW, R_X = NB * SEQ;
constexpr int PROJ = 4624, NPROJ = 4608;
constexpr int NE = 16, CAP = 1024, FF = 1024, R_MOE = NE * NB * CAP;
constexpr float EPS = 1e-6f;
constexpr int NTHR = 512, NWAVES = 8;
constexpr int LDS_BYTES = 147456;

constexpr size_t MiB = 1u << 20;
constexpr size_t WS_CTL = 0;
constexpr size_t WS_MODP = 1 * MiB;
constexpr size_t WS_MOD = 3 * MiB;
constexpr size_t WS_LB = WS_MOD + 128 * 1024;
constexpr size_t WS_WGT = WS_LB + 4096;
constexpr size_t WS_RWT = WS_WGT + 65536;
constexpr size_t WS_WIN_T = 4 * MiB;
constexpr size_t WS_WOUT_T = 13 * MiB;
constexpr size_t WS_GATES = 15 * MiB;
constexpr size_t WS_WGU_T = 18 * MiB;
constexpr size_t WS_WD_T = 82 * MiB;
constexpr size_t WS_U = 114 * MiB;
constexpr size_t WS_HQ = 180 * MiB;
constexpr size_t WS_HV = 213 * MiB;
constexpr size_t WS_HG = 246 * MiB;
constexpr size_t WS_LF = 279 * MiB;
constexpr size_t WS_QK = 345 * MiB;
constexpr size_t WS_MV = 411 * MiB;
constexpr size_t WS_MO = 444 * MiB;
constexpr size_t WS_AFF = 477 * MiB;
constexpr size_t WS_ROWMAP = 479 * MiB;
constexpr size_t WS_GATEV = WS_ROWMAP + 262144;
constexpr size_t WS_SLOT = 480 * MiB;
constexpr size_t WS_END = 512 * MiB;
constexpr size_t WS_QKC = WS_U;
constexpr size_t WS_AMIX2 = WS_LF;
constexpr size_t WS_VX = WS_U;
constexpr size_t WS_H = WS_HQ;
constexpr size_t WS_Y = 308 * MiB;

struct Params {
    const float *x, *c, *ctx, *c_ctx, *ada_w, *ada_b, *norm1_w, *w_in, *conv_w, *conv_b, *lb_logits, *ml_gate_b, *hg_norm_w, *ml_norm_w, *w_out, *norm2_w,
        *router_w, *wg, *wu, *wd, *final_w;
    float* out; unsigned char* ws;
};

__device__ __forceinline__ unsigned pk2(float lo, float hi) { f32x2 v = {lo, hi}; bf16x2_t b = __builtin_convertvector(v, bf16x2_t); return __builtin_bit_cast(unsigned, b); }
__device__ __forceinline__ unsigned pkh2(float lo, float hi) { f32x2 v = {lo, hi}; f16x2_t b = __builtin_convertvector(v, f16x2_t); return __builtin_bit_cast(unsigned, b); }
__device__ __forceinline__ float bf2f(unsigned short b) { return __uint_as_float((unsigned)b << 16); }
__device__ __forceinline__ float bflo(unsigned w) { return __uint_as_float(w << 16); }
__device__ __forceinline__ float bfhi(unsigned w) { return __uint_as_float(w & 0xffff0000u); }
__device__ __forceinline__ float h2f(unsigned short h) { return (float)__builtin_bit_cast(_Float16, h); }
__device__ __forceinline__ float sigmoid_(float x) { return 1.0f / (1.0f + __expf(-x)); }
__device__ __forceinline__ float silu_(float x) { return x * sigmoid_(x); }
__device__ __forceinline__ float wave_sum(float v) {
#pragma unroll
    for (int o = 1; o < 64; o <<= 1) v += __shfl_xor(v, o);
    return v;
}
__device__ __forceinline__ int tid_opaque() { int t = threadIdx.x; asm volatile("" : "+v"(t)); return t; }
#define LDS_WAIT() asm volatile("s_waitcnt lgkmcnt(0)" ::: "memory")
#define VM_WAIT() asm volatile("s_waitcnt vmcnt(0)" ::: "memory")

namespace pg8 {
constexpr int BM = 256, BK = 64, HALF = 128, HTB = HALF * BK * 2, STAGE_BYTES = 8 * HTB, NXCD = 8, WGM = 8;
__host__ __device__ __forceinline__ int lds_byte(int r, int c) { const int st = (r >> 4) * 2 + (c >> 5), rr = r & 15, cc = c & 31, ob = rr * 64 + cc * 2; return st * 1024 + (ob ^ (((ob >> 9) & 1) << 5)); }
__host__ __device__ __forceinline__ void stage_rc(int b, int& R, int& C) { const int st = b / 1024, sb = b % 1024, swz = sb ^ (((sb >> 9) & 1) << 5); R = (st >> 1) * 16 + swz / 64; C = (st & 1) * 32 + (swz % 64) / 2; }
__host__ __device__ __forceinline__ int perm32(int rho) { const int n = rho >> 4, i = rho & 15; return 8 * (i >> 2) + 4 * n + (i & 3); }

struct Unit { int pm, pn; size_t boff; };
struct Gemm { const bf16* A; const bf16* Bt; int K; const int* rowmap; };

struct StaticOrder {
    int nM, nN, nwg, G, c;
    __device__ void init(int M, int N, int G_, int c_) { nM = M / BM; nN = N / BM; nwg = nM * nN; G = G_; c = c_; }
    __device__ bool next(int i, Unit& u) const {
        const long L = (long)i * G + c; if (L >= nwg) return false;
        int wgid = (int)L; { const int q = nwg / NXCD, r = nwg % NXCD, xcd = wgid % NXCD, off = wgid / NXCD; wgid = (xcd < r ? xcd * (q + 1) : r * (q + 1) + (xcd - r) * q) + off; }
        const int nig = WGM * nN, gid = wgid / nig, fm = gid * WGM, gsz = (nM - fm) < WGM ? (nM - fm) : WGM;
        u.pm = fm + ((wgid % nig) % gsz); u.pn = (wgid % nig) / gsz; u.boff = 0; return true;
    }
};
struct PanelOrder {
    int pm, npn; size_t boff;
    __device__ bool next(int i, Unit& u) const { if (i >= npn) return false; u.pm = pm; u.pn = i; u.boff = boff; return true; }
};

template <class Epi, class Sched, bool ALIGN_EPI, bool GATHER>
__device__ __forceinline__ void gemm_phase(LAS unsigned char* lds, const Gemm g, const Sched& S, const Epi& E) {
    const int tid = tid_opaque(), wid = __builtin_amdgcn_readfirstlane(tid >> 6), lane = tid & 63, wr = wid >> 2, wc = wid & 3, fr = lane & 15, fq = lane >> 4;
    const int K = g.K, nt = K / BK;
    Unit cur, nxt; int ui = 0;
    if (!S.next(0, cur)) return;
    const size_t kstep = (size_t)(BK * 2);
    const size_t hstep = (size_t)HALF * K * 2;
    const size_t tstep = 2 * hstep;
    unsigned voffA[2][2], voffB[2];
#pragma unroll
    for (int i = 0; i < 2; ++i) { int R, C; stage_rc(tid * 16 + i * 8192, R, C); const int Rb = Epi::PERM ? ((R & ~31) + perm32(R & 31)) : R;
        voffB[i] = (unsigned)(Rb * K + C) * 2u;
#pragma unroll
        for (int h = 0; h < 2; ++h) {
            if (GATHER) voffA[h][i] = (unsigned)g.rowmap[cur.pm * BM + h * HALF + R] * (unsigned)(K * 2) + (unsigned)C * 2u;
            else voffA[h][i] = (unsigned)(R * K + C) * 2u + (unsigned)(h * hstep);
        } }
    const unsigned ldsw = (unsigned)wid * 1024u;
    const int aoff = lds_byte(wr * 64 + fr, fq * 8), boff = lds_byte(wc * 32 + fr, fq * 8);
#define PG8_SA(b, h) (((b) * 2 + (h)) * HTB)
#define PG8_SB(b, h) ((4 + (b) * 2 + (h)) * HTB)
#define PG8_STAGE_A(bufoff, gbase, h) do { _Pragma("unroll") for (int _i = 0; _i < 2; ++_i) \
        __builtin_amdgcn_global_load_lds((const unsigned*)((const char*)(gbase) + voffA[h][_i]), (LAS unsigned*)(lds + (bufoff) + ldsw + _i * 8192), 16, 0, 0); } while (0)
#define PG8_STAGE_B(bufoff, gbase) do { _Pragma("unroll") for (int _i = 0; _i < 2; ++_i) \
        __builtin_amdgcn_global_load_lds((const unsigned*)((const char*)(gbase) + voffB[_i]), (LAS unsigned*)(lds + (bufoff) + ldsw + _i * 8192), 16, 0, 0); } while (0)
#define PG8_LDA(dst, b, h) do { _Pragma("unroll") for (int m = 0; m < 4; ++m) _Pragma("unroll") for (int k = 0; k < 2; ++k) dst[m][k] = *(const LAS bf16x8*)(lds + PG8_SA(b, h) + aoff + m * 2048 + k * 1024); } while (0)
#define PG8_LDB(dst, b, h) do { _Pragma("unroll") for (int n = 0; n < 2; ++n) _Pragma("unroll") for (int k = 0; k < 2; ++k) dst[n][k] = *(const LAS bf16x8*)(lds + PG8_SB(b, h) + boff + n * 2048 + k * 1024); } while (0)
#define PG8_MMA(ai, bj, At, Bt) do { __builtin_amdgcn_s_setprio(1); _Pragma("unroll") for (int m = 0; m < 4; ++m) _Pragma("unroll") for (int n = 0; n < 2; ++n) _Pragma("unroll") for (int k = 0; k < 2; ++k) \
        acc[ai][bj][m][n] = __builtin_amdgcn_mfma_f32_16x16x32_bf16(Bt[n][k], At[m][k], acc[ai][bj][m][n], 0, 0, 0); __builtin_amdgcn_s_setprio(0); } while (0)
#define PG8_WAIT_V(n) asm volatile("s_waitcnt vmcnt(" #n ")" ::: "memory")
#define PG8_WAIT_L(n) asm volatile("s_waitcnt lgkmcnt(" #n ")" ::: "memory")
#define PG8_BAR __builtin_amdgcn_s_barrier()
#define PG8_SCHED __builtin_amdgcn_sched_barrier(0)
    f32x4 acc[2][2][4][2];
#pragma unroll
    for (int a = 0; a < 2; ++a)
#pragma unroll
        for (int b = 0; b < 2; ++b)
#pragma unroll
            for (int m = 0; m < 4; ++m)
#pragma unroll
                for (int n = 0; n < 2; ++n) acc[a][b][m][n] = (f32x4){0.f, 0.f, 0.f, 0.f};
    bf16x8 At[4][2], B0[2][2], B1[2][2];
    const char* cA = GATHER ? (const char*)g.A : (const char*)g.A + (size_t)cur.pm * tstep;
    const char* cB = (const char*)g.Bt + cur.boff + (size_t)cur.pn * tstep;
    if (GATHER) VM_WAIT();
    PG8_STAGE_B(PG8_SB(0, 0), cB); PG8_STAGE_B(PG8_SB(0, 1), cB + hstep); PG8_STAGE_A(PG8_SA(0, 0), cA, 0); PG8_STAGE_A(PG8_SA(0, 1), cA, 1);
    if (wr == 1) PG8_BAR;
    PG8_WAIT_V(2); PG8_BAR;
    PG8_STAGE_B(PG8_SB(1, 0), cB + kstep); PG8_STAGE_A(PG8_SA(1, 0), cA + kstep, 0); PG8_STAGE_B(PG8_SB(1, 1), cB + hstep + kstep);
    PG8_WAIT_V(6); PG8_BAR;
    for (;;) {
        const bool has_next = S.next(ui + 1, nxt);
        const char* nA = has_next ? (GATHER ? (const char*)g.A : (const char*)g.A + (size_t)nxt.pm * tstep) : cA;
        const char* nB = has_next ? (const char*)g.Bt + nxt.boff + (size_t)nxt.pn * tstep : cB;
        for (int t = 0; t < nt; t += 2) {
            const bool last = (t == nt - 2);
            const char* a1 = cA + (size_t)(t + 1) * kstep;
            const char* a2 = last ? nA : cA + (size_t)(t + 2) * kstep; const char* b2 = last ? nB : cB + (size_t)(t + 2) * kstep;
            const char* a3 = a2 + kstep; const char* b3 = b2 + kstep;
            PG8_LDB(B0, 0, 0); PG8_LDB(B1, 0, 1); PG8_SCHED; PG8_LDA(At, 0, 0); PG8_STAGE_A(PG8_SA(1, 1), a1, 1);
            PG8_WAIT_V(8); PG8_WAIT_L(0); PG8_BAR; PG8_MMA(0, 0, At, B0); PG8_MMA(0, 1, At, B1); PG8_BAR; PG8_SCHED;
            PG8_LDA(At, 0, 1); PG8_STAGE_B(PG8_SB(0, 0), b2); PG8_STAGE_B(PG8_SB(0, 1), b2 + hstep); PG8_STAGE_A(PG8_SA(0, 0), a2, 0);
            PG8_WAIT_V(8); PG8_WAIT_L(0); PG8_BAR; PG8_MMA(1, 0, At, B0); PG8_MMA(1, 1, At, B1); PG8_BAR; PG8_SCHED;
            PG8_LDB(B0, 1, 0); PG8_LDB(B1, 1, 1); PG8_SCHED; PG8_LDA(At, 1, 0); PG8_STAGE_A(PG8_SA(0, 1), a2, 1);
            PG8_WAIT_V(8); PG8_WAIT_L(0); PG8_BAR; PG8_MMA(0, 0, At, B0); PG8_MMA(0, 1, At, B1); PG8_BAR; PG8_SCHED;
            PG8_LDA(At, 1, 1); PG8_STAGE_B(PG8_SB(1, 0), b3); PG8_STAGE_B(PG8_SB(1, 1), b3 + hstep); PG8_STAGE_A(PG8_SA(1, 0), a3, 0);
            PG8_WAIT_V(8); PG8_WAIT_L(0); PG8_BAR; PG8_MMA(1, 0, At, B0); PG8_MMA(1, 1, At, B1); PG8_BAR; PG8_SCHED;
        }
        if constexpr (ALIGN_EPI) { if (wr == 0) PG8_BAR; }
        E(acc, cur, wr, wc, fr, fq);
        if (!has_next) break;
#pragma unroll
        for (int a = 0; a < 2; ++a)
#pragma unroll
            for (int b = 0; b < 2; ++b)
#pragma unroll
                for (int m = 0; m < 4; ++m)
#pragma unroll
                    for (int n = 0; n < 2; ++n) acc[a][b][m][n] = (f32x4){0.f, 0.f, 0.f, 0.f};
        cur = nxt; cA = nA; cB = nB; ++ui;
        if constexpr (ALIGN_EPI) { if (wr == 1) PG8_BAR; }
    }
    PG8_WAIT_V(0);
    if constexpr (!ALIGN_EPI) { if (wr == 0) PG8_BAR; }
    PG8_BAR;
#undef PG8_SA
#undef PG8_SB
#undef PG8_STAGE_A
#undef PG8_STAGE_B
#undef PG8_LDA
#undef PG8_LDB
#undef PG8_MMA
#undef PG8_WAIT_V
#undef PG8_WAIT_L
#undef PG8_BAR
#undef PG8_SCHED
}

struct EpiInProj {
    static constexpr bool PERM = true;
    unsigned char* ws; const float* lb;
    __device__ __forceinline__ void operator()(const f32x4 (&acc)[2][2][4][2], const Unit& u, int wr, int wc, int fr_, int fq) const {
        int fr = fr_; asm volatile("" : "+v"(fr));
        const int pn = u.pn; size_t base; int ld, colbase, act;
        if (pn < 2) { base = WS_HQ; ld = 512; colbase = pn * 256; act = 1; }
        else if (pn < 4) { base = WS_HV; ld = 512; colbase = (pn - 2) * 256; act = 0; }
        else if (pn < 6) { base = WS_HG; ld = 512; colbase = (pn - 4) * 256; act = 1; }
        else if (pn < 10) { base = WS_LF; ld = 1024; colbase = (pn - 6) * 256; act = 3; }
        else if (pn < 14) { base = WS_QK; ld = 1024; colbase = (pn - 10) * 256; act = 0; }
        else if (pn < 16) { base = WS_MV; ld = 512; colbase = (pn - 14) * 256; act = 0; }
        else { base = WS_MO; ld = 512; colbase = (pn - 16) * 256; act = 2; }
        bf16* O = (bf16*)(ws + base);
        const int row0 = u.pm * BM + wr * 64 + fr, col0 = colbase + wc * 32 + 8 * fq;
#pragma unroll
        for (int bj = 0; bj < 2; ++bj) {
            float lbv[8];
            if (act == 3) {
#pragma unroll
                for (int e = 0; e < 8; ++e) lbv[e] = lb[col0 + bj * HALF + e];
            }
#pragma unroll
            for (int ai = 0; ai < 2; ++ai)
#pragma unroll
                for (int m = 0; m < 4; ++m) {
                    float v[8];
#pragma unroll
                    for (int e = 0; e < 4; ++e) { v[e] = acc[ai][bj][m][0][e]; v[4 + e] = acc[ai][bj][m][1][e]; }
                    u32x4 w;
                    if (act == 3) {
#pragma unroll
                        for (int e = 0; e < 8; ++e) v[e] = __logf(lbv[e] + (1.0f - lbv[e]) * sigmoid_(v[e]));
                        w.x = pkh2(v[0], v[1]); w.y = pkh2(v[2], v[3]); w.z = pkh2(v[4], v[5]); w.w = pkh2(v[6], v[7]);
                    } else {
                        if (act == 1) {
#pragma unroll
                            for (int e = 0; e < 8; ++e) v[e] = silu_(v[e]);
                        } else if (act == 2) {
#pragma unroll
                            for (int e = 0; e < 8; ++e) v[e] = sigmoid_(v[e]);
                        }
                        w.x = pk2(v[0], v[1]); w.y = pk2(v[2], v[3]); w.z = pk2(v[4], v[5]); w.w = pk2(v[6], v[7]);
                    }
                    *(u32x4*)(O + (size_t)(row0 + ai * HALF + m * 16) * ld + col0 + bj * HALF) = w;
                }
        }
    }
};
struct EpiOutProj {
    static constexpr bool PERM = false;
    const float* x; float* out; const float* mod;
    __device__ __forceinline__ void operator()(const f32x4 (&acc)[2][2][4][2], const Unit& u, int wr, int wc, int fr_, int fq) const {
        int fr = fr_; asm volatile("" : "+v"(fr));
        const int row0 = u.pm * BM + wr * 64 + fr, col0 = u.pn * BM + wc * 32 + 4 * fq;
        const float* g1 = mod + (size_t)(u.pm / 32) * 6144 + 2048;
#pragma unroll
        for (int bj = 0; bj < 2; ++bj)
#pragma unroll
            for (int n = 0; n < 2; ++n) {
                const int c = col0 + bj * HALF + n * 16; const f32x4 gv = *(const f32x4*)(g1 + c);
#pragma unroll
                for (int ai = 0; ai < 2; ++ai)
#pragma unroll
                    for (int m = 0; m < 4; ++m) { const size_t off = (size_t)(row0 + ai * HALF + m * 16) * D + c;
                        *(f32x4*)(out + off) = *(const f32x4*)(x + off) + gv * acc[ai][bj][m][n]; }
            }
    }
};
struct EpiMoE1 {
    static constexpr bool PERM = true;
    bf16* H;
    __device__ __forceinline__ void operator()(const f32x4 (&acc)[2][2][4][2], const Unit& u, int wr, int wc, int fr_, int fq) const {
        int fr = fr_; asm volatile("" : "+v"(fr));
        const int row0 = u.pm * BM + wr * 64 + fr, col0 = u.pn * HALF + wc * 32 + 8 * fq;
#pragma unroll
        for (int ai = 0; ai < 2; ++ai)
#pragma unroll
            for (int m = 0; m < 4; ++m) {
                float v[8];
#pragma unroll
                for (int e = 0; e < 4; ++e) { v[e] = silu_(acc[ai][0][m][0][e]) * acc[ai][1][m][0][e]; v[4 + e] = silu_(acc[ai][0][m][1][e]) * acc[ai][1][m][1][e]; }
                u32x4 w; w.x = pk2(v[0], v[1]); w.y = pk2(v[2], v[3]); w.z = pk2(v[4], v[5]); w.w = pk2(v[6], v[7]);
                *(u32x4*)(H + (size_t)(row0 + ai * HALF + m * 16) * FF + col0) = w;
            }
    }
};
struct EpiMoE2 {
    static constexpr bool PERM = true;
    bf16* Y; const float* gatev;
    __device__ __forceinline__ void operator()(const f32x4 (&acc)[2][2][4][2], const Unit& u, int wr, int wc, int fr_, int fq) const {
        int fr = fr_; asm volatile("" : "+v"(fr));
        const int row0 = u.pm * BM + wr * 64 + fr, col0 = u.pn * BM + wc * 32 + 8 * fq;
#pragma unroll
        for (int ai = 0; ai < 2; ++ai)
#pragma unroll
            for (int m = 0; m < 4; ++m) { const int row = row0 + ai * HALF + m * 16; const float gt = gatev[row];
#pragma unroll
                for (int bj = 0; bj < 2; ++bj) { const f32x4 a = acc[ai][bj][m][0] * gt, b = acc[ai][bj][m][1] * gt;
                    u32x4 w; w.x = pk2(a[0], a[1]); w.y = pk2(a[2], a[3]); w.z = pk2(b[0], b[1]); w.w = pk2(b[2], b[3]);
                    *(u32x4*)(Y + (size_t)row * D + col0 + bj * HALF) = w; } }
    }
};
}

__device__ __forceinline__ void transpose_item(const float* W, int ldw, int k0, int n0, bf16* dst_row0, LAS float* scr, int lane) {
#pragma unroll 8
    for (int i = 0; i < 32; ++i) { const int kk = 2 * i + (lane >> 5); scr[kk * 33 + (lane & 31)] = W[(size_t)(k0 + kk) * ldw + n0 + (lane & 31)]; }
    LDS_WAIT(); asm volatile("" ::: "memory");
    const int c = lane & 7;
#pragma unroll
    for (int j = 0; j < 4; ++j) { const int n = (lane >> 3) + 8 * j; const LAS float* s = scr + (8 * c) * 33 + n;
        u32x4 o; o.x = pk2(s[0 * 33], s[1 * 33]); o.y = pk2(s[2 * 33], s[3 * 33]); o.z = pk2(s[4 * 33], s[5 * 33]); o.w = pk2(s[6 * 33], s[7 * 33]);
        *(u32x4*)(dst_row0 + (size_t)n * 1024 + k0 + 8 * c) = o; }
    LDS_WAIT(); asm volatile("" ::: "memory");
}
__device__ __forceinline__ void phase_prologue(const Params& p, LAS unsigned char* lds) {
    const int tid = tid_opaque(), lane = tid & 63, wave = tid >> 6;
    const int gw = blockIdx.x * NWAVES + wave, NGW = gridDim.x * NWAVES;
    LAS float* scr = (LAS float*)(lds + wave * 16384);
    constexpr int I_IN = 16 * 144, I_OUT = 16 * 32, I_E = 16 * 512, I_MOD = 24 * 16;
    constexpr int NITEMS = I_IN + I_OUT + 3 * I_E + I_MOD;
    unsigned char* ws = p.ws;
    for (int it = gw; it < NITEMS; it += NGW) {
        int r = it;
        if (r < I_IN) { const int kb = r / 144, nb = r % 144; transpose_item(p.w_in, PROJ, kb * 64, nb * 32, (bf16*)(ws + WS_WIN_T) + (size_t)(nb * 32) * 1024, scr, lane); continue; } r -= I_IN;
        if (r < I_OUT) { const int kb = r / 32, nb = r % 32; transpose_item(p.w_out, D, kb * 64, nb * 32, (bf16*)(ws + WS_WOUT_T) + (size_t)(nb * 32) * 1024, scr, lane); continue; } r -= I_OUT;
        if (r < 2 * I_E) { const int up = r / I_E; r -= up * I_E; const int e = r / 512, q = r % 512, kb = q / 32, nb = q % 32, n0 = nb * 32;
            const int drow = (n0 / 128) * 256 + up * 128 + (n0 % 128);
            transpose_item((up ? p.wu : p.wg) + (size_t)e * D * FF, FF, kb * 64, n0, (bf16*)(ws + WS_WGU_T) + ((size_t)e * 2048 + drow) * 1024, scr, lane); continue; } r -= 2 * I_E;
        if (r < I_E) { const int e = r / 512, q = r % 512, kb = q / 32, nb = q % 32;
            transpose_item(p.wd + (size_t)e * FF * D, D, kb * 64, nb * 32, (bf16*)(ws + WS_WD_T) + ((size_t)e * 1024 + nb * 32) * 1024, scr, lane); continue; } r -= I_E;
        {
            const int cb = r / 16, ks = r % 16; const int col = cb * 256 + lane * 4;
            f32x4 a[5];
#pragma unroll
            for (int q = 0; q < 5; ++q) a[q] = (f32x4){0.f, 0.f, 0.f, 0.f};
            for (int k = ks * 64; k < ks * 64 + 64; ++k) {
                const f32x4 w = *(const f32x4*)(p.ada_w + (size_t)k * 6144 + col);
#pragma unroll
                for (int q = 0; q < 5; ++q) { const float cv = (q < 4) ? p.c[q * D + k] : p.c_ctx[k]; a[q] += w * silu_(cv); }
            }
            float* mp = (float*)(ws + WS_MODP);
#pragma unroll
            for (int q = 0; q < 5; ++q) *(f32x4*)(mp + ((size_t)ks * 5 + q) * 6144 + col) = a[q];
        }
    }
    const int gt = blockIdx.x * NTHR + tid, NGT = gridDim.x * NTHR;
    for (int i = gt; i < 1024; i += NGT) { const float l0 = p.lb_logits[i], l1 = p.lb_logits[1024 + i]; ((float*)(ws + WS_LB))[i] = 1.0f / (1.0f + __expf(l1 - l0)); }
    for (int i = gt; i < 16 * 1024; i += NGT) { const int g = i >> 10, k = i & 1023; ((float*)(ws + WS_WGT))[i] = p.w_in[(size_t)k * PROJ + NPROJ + g]; ((float*)(ws + WS_RWT))[i] = p.router_w[k * 16 + g]; }
}

__device__ __forceinline__ void phase_u(const Params& p, LAS unsigned char* lds) {
    const int tid = tid_opaque(), lane = tid & 63, wave = tid >> 6;
    unsigned char* ws = p.ws;
    LAS float* Lsh = (LAS float*)lds;
    LAS float* Lsc = Lsh + 5 * 1024;
    LAS float* Lnw = Lsc + 5 * 1024;
    LAS float* Lwg = Lnw + 1024;
    const float* modp = (const float*)(ws + WS_MODP);
    for (int idx = tid; idx < 5 * 2048; idx += NTHR) { const int r = idx / 2048, col = idx % 2048; float s = p.ada_b[col];
        for (int ks = 0; ks < 16; ++ks) s += modp[((size_t)ks * 5 + r) * 6144 + col];
        if (col < 1024) Lsh[r * 1024 + col] = s; else Lsc[r * 1024 + col - 1024] = s; }
    for (int e = blockIdx.x * NTHR + tid; e < 5 * 6144; e += gridDim.x * NTHR) { const int r = e / 6144, col = e % 6144; float s = p.ada_b[col];
        for (int ks = 0; ks < 16; ++ks) s += modp[((size_t)ks * 5 + r) * 6144 + col];
        ((float*)(ws + WS_MOD))[e] = s; }
    for (int i = tid; i < 1024; i += NTHR) Lnw[i] = p.norm1_w[i];
    for (int i = tid; i < 16 * 1024; i += NTHR) Lwg[i] = ((const float*)(ws + WS_WGT))[i];
    __syncthreads();
    const int gw = blockIdx.x * NWAVES + wave, NGW = gridDim.x * NWAVES;
    for (int row = gw; row < R_ALL; row += NGW) {
        const int b = row / SROW, s = row % SROW;
        const float* src = (s < CTX) ? p.ctx + ((size_t)b * CTX + s) * D : p.x + ((size_t)b * SEQ + (s - CTX)) * D;
        const int r = (s < CTX) ? 4 : b;
        f32x4 v[4]; float ss = 0.f;
#pragma unroll
        for (int j = 0; j < 4; ++j) { v[j] = *(const f32x4*)(src + j * 256 + lane * 4); ss += (v[j].x * v[j].x + v[j].y * v[j].y) + (v[j].z * v[j].z + v[j].w * v[j].w); }
        const float rstd = rsqrtf(wave_sum(ss) * (1.0f / D) + EPS);
        bf16* urow = (bf16*)(ws + WS_U) + (size_t)row * D;
#pragma unroll
        for (int j = 0; j < 4; ++j) { const int c0 = j * 256 + lane * 4;
            const f32x4 nw = *(const LAS f32x4*)(Lnw + c0), sc = *(const LAS f32x4*)(Lsc + r * 1024 + c0), sh = *(const LAS f32x4*)(Lsh + r * 1024 + c0);
            v[j] = v[j] * rstd * nw * (1.0f + sc) + sh;
            u32x2 w; w.x = pk2(v[j].x, v[j].y); w.y = pk2(v[j].z, v[j].w); *(u32x2*)(urow + c0) = w; }
        float mine = 0.f;
#pragma unroll 2
        for (int g = 0; g < 16; ++g) { float a = 0.f;
#pragma unroll
            for (int j = 0; j < 4; ++j) { const f32x4 w = *(const LAS f32x4*)(Lwg + g * 1024 + j * 256 + lane * 4); a += (v[j].x * w.x + v[j].y * w.y) + (v[j].z * w.z + v[j].w * w.w); }
            a = wave_sum(a); if (lane == g) mine = a; }
        if (lane < 16) { float gv = mine + p.ml_gate_b[lane];
            if ((lane >> 2) & 1) gv = fminf(gv, 0.f) - log1pf(__expf(-fabsf(gv)));
            ((float*)(ws + WS_GATES))[(size_t)row * 16 + lane] = gv; }
    }
}

__device__ __forceinline__ void phase_conv(const Params& p) {
    unsigned char* ws = p.ws;
    const bf16* QK = (const bf16*)(ws + WS_QK); bf16* QKC = (bf16*)(ws + WS_QKC);
    const long total = (long)R_ALL * 128;
    const int tid0 = tid_opaque();
    for (long it = (long)blockIdx.x * NTHR + tid0; it < total; it += (long)gridDim.x * NTHR) {
        const int row = (int)(it >> 7), ch = (int)(it & 127) * 8;
        const int b = row / SROW, s = row % SROW;
        float a[8];
#pragma unroll
        for (int e = 0; e < 8; ++e) a[e] = p.conv_b[ch + e];
        if (s < CTX) {
#pragma unroll
            for (int j = 0; j < 3; ++j) { const int s2 = s + j - 1; if (s2 < 0 || s2 >= CTX) continue;
                const u32x4 w = *(const u32x4*)(QK + ((size_t)b * SROW + s2) * 1024 + ch); const float* cw = p.conv_w + (size_t)(3 + j) * 1024 + ch;
                a[0] += bflo(w.x) * cw[0]; a[1] += bfhi(w.x) * cw[1]; a[2] += bflo(w.y) * cw[2]; a[3] += bfhi(w.y) * cw[3];
                a[4] += bflo(w.z) * cw[4]; a[5] += bfhi(w.z) * cw[5]; a[6] += bflo(w.w) * cw[6]; a[7] += bfhi(w.w) * cw[7]; }
        } else {
            const int t = s - CTX, gr = t >> 6, gc = t & 63;
#pragma unroll
            for (int i = 0; i < 3; ++i) { const int r2 = gr + i - 1; if (r2 < 0 || r2 >= 128) continue;
#pragma unroll
                for (int j = 0; j < 3; ++j) { const int c2 = gc + j - 1; if (c2 < 0 || c2 >= 64) continue;
                    const u32x4 w = *(const u32x4*)(QK + ((size_t)b * SROW + CTX + r2 * 64 + c2) * 1024 + ch); const float* cw = p.conv_w + (size_t)(i * 3 + j) * 1024 + ch;
                    a[0] += bflo(w.x) * cw[0]; a[1] += bfhi(w.x) * cw[1]; a[2] += bflo(w.y) * cw[2]; a[3] += bfhi(w.y) * cw[3];
                    a[4] += bflo(w.z) * cw[4]; a[5] += bfhi(w.z) * cw[5]; a[6] += bflo(w.w) * cw[6]; a[7] += bfhi(w.w) * cw[7]; } }
        }
        const float sc = (ch >= 512) ? 0.08838834764831845f : 1.0f;
#pragma unroll
        for (int e = 0; e < 8; ++e) a[e] = silu_(a[e]) * sc;
        u32x4 o; o.x = pk2(a[0], a[1]); o.y = pk2(a[2], a[3]); o.z = pk2(a[4], a[5]); o.w = pk2(a[6], a[7]);
        *(u32x4*)(QKC + (size_t)row * 1024 + ch) = o;
    }
}

template <bool ML>
__device__ __forceinline__ void scan_chain(const Params& p, LAS unsigned char* lds, int dir, int b, int h) {
    const int tid = tid_opaque(), v = tid & 127, cq = tid >> 7;
    unsigned char* ws = p.ws;
    LAS float* Fd = (LAS float*)lds;
    LAS float* Kd = Fd + 1024, *Qd = Kd + 1024, *Vd = Qd + 1024;
    LAS float* Pn = Vd + 1024;
    LAS float* Pd = Pn + 4096;
    LAS float* Li = Pd + 32, *Lf = Li + 8, *Em = Lf + 8;
    float S[32], nn[32];
#pragma unroll
    for (int i = 0; i < 32; ++i) { S[i] = 0.f; nn[i] = 0.f; }
    float m = 0.f;
    const int st = tid >> 6, sp = tid & 63;
    float rf0, rf1, rk0, rk1, rq0, rq1, rv0, rv1, rli = 0.f, rlf = 0.f;
#define ROW_OF(n) (b * SROW + (dir ? ((n) < CTX ? CTX - 1 - (n) : CTX + (SROW - 1 - (n))) : (n)))
#define STAGE_LOAD(n0_) do { const int row = ROW_OF((n0_) + st); const int c = h * 128 + 2 * sp; \
        if (!ML) { \
            const unsigned lf = *(const unsigned*)((const bf16*)(ws + WS_LF) + (size_t)row * 1024 + dir * 512 + c); \
            const unsigned q = *(const unsigned*)((const bf16*)(ws + WS_HQ) + (size_t)row * 512 + c); \
            const unsigned vv = *(const unsigned*)((const bf16*)(ws + WS_HV) + (size_t)row * 512 + c); \
            rf0 = __expf(h2f((unsigned short)(lf & 0xffff))); rf1 = __expf(h2f((unsigned short)(lf >> 16))); rk0 = 1.0f - rf0; rk1 = 1.0f - rf1; \
            rq0 = bflo(q); rq1 = bfhi(q); rv0 = bflo(vv); rv1 = bfhi(vv); \
        } else { \
            const unsigned q = *(const unsigned*)((const bf16*)(ws + WS_QKC) + (size_t)row * 1024 + c); \
            const unsigned k = *(const unsigned*)((const bf16*)(ws + WS_QKC) + (size_t)row * 1024 + 512 + c); \
            const unsigned vv = *(const unsigned*)((const bf16*)(ws + WS_MV) + (size_t)row * 512 + c); \
            rf0 = rf1 = 0.f; rk0 = bflo(k); rk1 = bfhi(k); rq0 = bflo(q); rq1 = bfhi(q); rv0 = bflo(vv); rv1 = bfhi(vv); \
            if (sp == 0) { const float* gp = (const float*)(ws + WS_GATES) + (size_t)row * 16 + dir * 8 + h; rli = gp[0]; rlf = gp[4]; } \
        } } while (0)
#define STAGE_WRITE() do { const int o_ = st * 128 + 2 * sp; \
        Fd[o_] = rf0; Fd[o_ + 1] = rf1; Kd[o_] = rk0; Kd[o_ + 1] = rk1; Qd[o_] = rq0; Qd[o_ + 1] = rq1; Vd[o_] = rv0; Vd[o_ + 1] = rv1; \
        if (ML && sp == 0) { Li[st] = rli; Lf[st] = rlf; } } while (0)
    STAGE_LOAD(0); STAGE_WRITE(); __syncthreads();
    for (int n0 = 0; n0 < SROW; n0 += 8) {
        if (n0 + 8 < SROW) STAGE_LOAD(n0 + 8);
#pragma unroll 1
        for (int t = 0; t < 8; ++t) {
            const float vv = Vd[t * 128 + v];
            float o = 0.f, dn = 0.f, fa = 0.f, ia = 0.f;
            if (ML) { const float li = Li[t], lf = Lf[t]; const float mn = fmaxf(lf + m, li); fa = __expf(lf + m - mn); ia = __expf(li - mn); m = mn; if (tid == 0) Em[t] = __expf(-mn); }
#pragma unroll
            for (int c4 = 0; c4 < 8; ++c4) {
                const f32x4 kk = *(const LAS f32x4*)(Kd + t * 128 + cq * 32 + c4 * 4), qq = *(const LAS f32x4*)(Qd + t * 128 + cq * 32 + c4 * 4);
                f32x4 ff; if (!ML) ff = *(const LAS f32x4*)(Fd + t * 128 + cq * 32 + c4 * 4);
#pragma unroll
                for (int e = 0; e < 4; ++e) { const int i = c4 * 4 + e;
                    if (!ML) { S[i] = ff[e] * S[i] + kk[e] * vv; o += S[i] * qq[e]; }
                    else { const float ik = ia * kk[e]; S[i] = fa * S[i] + ik * vv; nn[i] = fa * nn[i] + ik; o += S[i] * qq[e]; dn += nn[i] * qq[e]; } }
            }
            Pn[(t * 4 + cq) * 128 + v] = o;
            if (ML && v == 0) Pd[t * 4 + cq] = dn;
        }
        __syncthreads();
        if (n0 >= CTX) {
            const int t = tid >> 6, v0 = 2 * (tid & 63);
            float o0 = (Pn[(t * 4 + 0) * 128 + v0] + Pn[(t * 4 + 1) * 128 + v0]) + (Pn[(t * 4 + 2) * 128 + v0] + Pn[(t * 4 + 3) * 128 + v0]);
            float o1 = (Pn[(t * 4 + 0) * 128 + v0 + 1] + Pn[(t * 4 + 1) * 128 + v0 + 1]) + (Pn[(t * 4 + 2) * 128 + v0 + 1] + Pn[(t * 4 + 3) * 128 + v0 + 1]);
            if (ML) { const float den = (Pd[t * 4 + 0] + Pd[t * 4 + 1]) + (Pd[t * 4 + 2] + Pd[t * 4 + 3]); const float dd = fmaxf(fabsf(den), Em[t]); o0 = o0 / dd; o1 = o1 / dd; }
            const int row = ROW_OF(n0 + t); const int xrow = b * SEQ + (row - b * SROW - CTX);
            bf16* O = (bf16*)p.out + ((size_t)dir * R_X + xrow) * 1024 + (ML ? 512 : 0) + h * 128 + v0;
            *(unsigned*)O = pk2(o0, o1);
        }
        if (n0 + 8 < SROW) STAGE_WRITE();
        __syncthreads();
    }
}

__device__ __forceinline__ void phase_mixprep(const Params& p) {
    unsigned char* ws = p.ws;
    const int tid = tid_opaque(), lane = tid & 63, wave = tid >> 6;
    const int gw = blockIdx.x * NWAVES + wave, NGW = gridDim.x * NWAVES;
    for (int xr = gw; xr < R_X; xr += NGW) {
        const int b = xr / SEQ, t = xr % SEQ; const size_t row = (size_t)b * SROW + CTX + t;
        const bf16* of = (const bf16*)p.out + (size_t)xr * 1024 + lane * 16;
        const bf16* ob = (const bf16*)p.out + ((size_t)R_X + xr) * 1024 + lane * 16;
        float v[16];
#pragma unroll
        for (int q = 0; q < 2; ++q) { const u32x4 a = *(const u32x4*)(of + q * 8), c = *(const u32x4*)(ob + q * 8);
            v[q * 8 + 0] = bflo(a.x) + bflo(c.x); v[q * 8 + 1] = bfhi(a.x) + bfhi(c.x); v[q * 8 + 2] = bflo(a.y) + bflo(c.y); v[q * 8 + 3] = bfhi(a.y) + bfhi(c.y);
            v[q * 8 + 4] = bflo(a.z) + bflo(c.z); v[q * 8 + 5] = bfhi(a.z) + bfhi(c.z); v[q * 8 + 6] = bflo(a.w) + bflo(c.w); v[q * 8 + 7] = bfhi(a.w) + bfhi(c.w); }
        float s = 0.f;
#pragma unroll
        for (int e = 0; e < 16; ++e) s += v[e];
        s += __shfl_xor(s, 1); s += __shfl_xor(s, 2); s += __shfl_xor(s, 4);
        const bool ml = lane >= 32;
        const float mean = ml ? s * (1.0f / 128.0f) : 0.f;
        float q2 = 0.f;
#pragma unroll
        for (int e = 0; e < 16; ++e) { v[e] -= mean; q2 += v[e] * v[e]; }
        q2 += __shfl_xor(q2, 1); q2 += __shfl_xor(q2, 2); q2 += __shfl_xor(q2, 4);
        const float rstd = rsqrtf(q2 * (1.0f / 128.0f) + EPS);
        const int c0 = (lane & 31) * 16;
        const float* nw = (ml ? p.ml_norm_w : p.hg_norm_w) + c0;
        const bf16* gt = (const bf16*)(ws + (ml ? WS_MO : WS_HG)) + row * 512 + c0;
        const u32x4 g0 = *(const u32x4*)gt, g1 = *(const u32x4*)(gt + 8);
        float g[16] = {bflo(g0.x), bfhi(g0.x), bflo(g0.y), bfhi(g0.y), bflo(g0.z), bfhi(g0.z), bflo(g0.w), bfhi(g0.w),
                       bflo(g1.x), bfhi(g1.x), bflo(g1.y), bfhi(g1.y), bflo(g1.z), bfhi(g1.z), bflo(g1.w), bfhi(g1.w)};
#pragma unroll
        for (int e = 0; e < 16; ++e) v[e] = v[e] * rstd * nw[e] * g[e];
        u32x4 o0, o1; o0.x = pk2(v[0], v[1]); o0.y = pk2(v[2], v[3]); o0.z = pk2(v[4], v[5]); o0.w = pk2(v[6], v[7]);
        o1.x = pk2(v[8], v[9]); o1.y = pk2(v[10], v[11]); o1.z = pk2(v[12], v[13]); o1.w = pk2(v[14], v[15]);
        bf16* am = (bf16*)(ws + WS_AMIX2) + (size_t)xr * 1024 + lane * 16;
        *(u32x4*)am = o0; *(u32x4*)(am + 8) = o1;
    }
}

__device__ __forceinline__ void phase_vx(const Params& p, LAS unsigned char* lds) {
    unsigned char* ws = p.ws;
    const int tid = tid_opaque(), lane = tid & 63, wave = tid >> 6;
    LAS float* Lrw = (LAS float*)lds;
    LAS float* Lnw = Lrw + 16 * 1024;
    LAS float* Lsh = Lnw + 1024;
    LAS float* Lsc = Lsh + 4096;
    const float* mod = (const float*)(ws + WS_MOD);
    for (int i = tid; i < 16 * 1024; i += NTHR) Lrw[i] = ((const float*)(ws + WS_RWT))[i];
    for (int i = tid; i < 1024; i += NTHR) Lnw[i] = p.norm2_w[i];
    for (int i = tid; i < 4096; i += NTHR) { const int b = i >> 10, c = i & 1023; Lsh[i] = mod[(size_t)b * 6144 + 3072 + c]; Lsc[i] = mod[(size_t)b * 6144 + 4096 + c]; }
    __syncthreads();
    const int gw = blockIdx.x * NWAVES + wave, NGW = gridDim.x * NWAVES;
    for (int xr = gw; xr < R_X; xr += NGW) {
        const int b = xr / SEQ, t = xr % SEQ;
        const float* src = p.out + (size_t)xr * D;
        f32x4 v[4]; float ss = 0.f;
#pragma unroll
        for (int j = 0; j < 4; ++j) { v[j] = *(const f32x4*)(src + j * 256 + lane * 4); ss += (v[j].x * v[j].x + v[j].y * v[j].y) + (v[j].z * v[j].z + v[j].w * v[j].w); }
        const float rstd = rsqrtf(wave_sum(ss) * (1.0f / D) + EPS);
        bf16* vrow = (bf16*)(ws + WS_VX) + (size_t)xr * D;
#pragma unroll
        for (int j = 0; j < 4; ++j) { const int c0 = j * 256 + lane * 4;
            const f32x4 nw = *(const LAS f32x4*)(Lnw + c0), sc = *(const LAS f32x4*)(Lsc + b * 1024 + c0), sh = *(const LAS f32x4*)(Lsh + b * 1024 + c0);
            v[j] = v[j] * rstd * nw * (1.0f + sc) + sh;
            u32x2 w; w.x = pk2(v[j].x, v[j].y); w.y = pk2(v[j].z, v[j].w); *(u32x2*)(vrow + c0) = w; }
        float mine = 0.f;
#pragma unroll 2
        for (int g = 0; g < 16; ++g) { float a = 0.f;
#pragma unroll
            for (int j = 0; j < 4; ++j) { const f32x4 w = *(const LAS f32x4*)(Lrw + g * 1024 + j * 256 + lane * 4); a += (v[j].x * w.x + v[j].y * w.y) + (v[j].z * w.z + v[j].w * w.w); }
            a = wave_sum(a); if (lane == g) mine = a; }
        float mx = (lane < 16) ? mine : -3.0e38f;
        mx = fmaxf(mx, __shfl_xor(mx, 1)); mx = fmaxf(mx, __shfl_xor(mx, 2)); mx = fmaxf(mx, __shfl_xor(mx, 4)); mx = fmaxf(mx, __shfl_xor(mx, 8));
        mx = __shfl(mx, 0);
        float ex = (lane < 16) ? __expf(mine - mx) : 0.f;
        float sm = ex; sm += __shfl_xor(sm, 1); sm += __shfl_xor(sm, 2); sm += __shfl_xor(sm, 4); sm += __shfl_xor(sm, 8);
        sm = __shfl(sm, 0);
        if (lane < 16) ((float*)(ws + WS_AFF))[((size_t)b * 16 + lane) * SEQ + t] = ex / sm;
    }
}

__device__ __forceinline__ void phase_topk_naive(const Params& p, LAS unsigned char* lds) {
    unsigned char* ws = p.ws;
    const int tid = tid_opaque();
    LAS float* La = (LAS float*)lds;
    for (int item = blockIdx.x; item < 64 * 16; item += gridDim.x) {
        const int be = item >> 4, tb = item & 15, b = be >> 4, e = be & 15;
        const float* aff = (const float*)(ws + WS_AFF) + (size_t)be * SEQ;
        __syncthreads();
        for (int i = tid; i < SEQ / 4; i += NTHR) *(LAS f32x4*)(La + i * 4) = *(const f32x4*)(aff + i * 4);
        __syncthreads();
        const int t = tb * NTHR + tid; const float a = La[t];
        int rank = 0;
        for (int i = 0; i < SEQ; i += 4) { const f32x4 w = *(const LAS f32x4*)(La + i);
            rank += (w.x > a || (w.x == a && i < t)) ? 1 : 0; rank += (w.y > a || (w.y == a && i + 1 < t)) ? 1 : 0;
            rank += (w.z > a || (w.z == a && i + 2 < t)) ? 1 : 0; rank += (w.w > a || (w.w == a && i + 3 < t)) ? 1 : 0; }
        int slot = -1;
        if (rank < CAP) { slot = rank; const int mrow = (e * NB + b) * CAP + rank; ((int*)(ws + WS_ROWMAP))[mrow] = b * SEQ + t; ((float*)(ws + WS_GATEV))[mrow] = a; }
        ((int*)(ws + WS_SLOT))[((size_t)b * SEQ + t) * 16 + e] = slot;
    }
}

__device__ __forceinline__ void phase_final(const Params& p) {
    unsigned char* ws = p.ws;
    const int tid = tid_opaque(), lane = tid & 63, wave = tid >> 6;
    const int gw = blockIdx.x * NWAVES + wave, NGW = gridDim.x * NWAVES;
    const float* mod = (const float*)(ws + WS_MOD);
    for (int xr = gw; xr < R_X; xr += NGW) {
        const int b = xr / SEQ;
        float* row = p.out + (size_t)xr * D;
        f32x4 acc[4];
#pragma unroll
        for (int j = 0; j < 4; ++j) acc[j] = (f32x4){0.f, 0.f, 0.f, 0.f};
        const int myslot = (lane < 16) ? ((const int*)(ws + WS_SLOT))[(size_t)xr * 16 + lane] : -1;
        for (int e = 0; e < 16; ++e) { const int sl = __shfl(myslot, e); if (sl < 0) continue;
            const bf16* y = (const bf16*)(ws + WS_Y) + ((size_t)(e * NB + b) * CAP + sl) * D;
#pragma unroll
            for (int j = 0; j < 4; ++j) { const u32x2 w = *(const u32x2*)(y + j * 256 + lane * 4); acc[j].x += bflo(w.x); acc[j].y += bfhi(w.x); acc[j].z += bflo(w.y); acc[j].w += bfhi(w.y); } }
        f32x4 v[4]; float ss = 0.f;
#pragma unroll
        for (int j = 0; j < 4; ++j) { const int c0 = j * 256 + lane * 4; const f32x4 g2 = *(const f32x4*)(mod + (size_t)b * 6144 + 5120 + c0);
            v[j] = *(const f32x4*)(row + c0) + g2 * acc[j]; ss += (v[j].x * v[j].x + v[j].y * v[j].y) + (v[j].z * v[j].z + v[j].w * v[j].w); }
        const float rstd = rsqrtf(wave_sum(ss) * (1.0f / D) + EPS);
#pragma unroll
        for (int j = 0; j < 4; ++j) { const int c0 = j * 256 + lane * 4; const f32x4 fw = *(const f32x4*)(p.final_w + c0); *(f32x4*)(row + c0) = v[j] * rstd * fw; }
    }
}

#define XB_TMO      128
#define XB_XCNT(j)  (256  + 64 * (j))
#define XB_XSUB(j)  (1280 + 64 * (j))
#define XB_XGEN(j)  (2304 + 64 * (j))
#define XB_TOP      3328
#define XB_TOPGEN   3392
#define XCD_BAR_WORDS 3456
#define XB_SPIN_CAP (1u << 20)
__device__ __forceinline__ unsigned xb_ld(unsigned* p)              { return __hip_atomic_load(p, __ATOMIC_RELAXED, __HIP_MEMORY_SCOPE_AGENT); }
__device__ __forceinline__ unsigned xb_add(unsigned* p, unsigned v) { return __hip_atomic_fetch_add(p, v, __ATOMIC_RELAXED, __HIP_MEMORY_SCOPE_AGENT); }
__device__ __forceinline__ unsigned xb_xcc_id() { return (unsigned)__builtin_amdgcn_s_getreg((3 << 11) | 20) & 0xFu; }
#define XB_SPIN(cond, bar) do { unsigned _sp = 0; while (cond) { __builtin_amdgcn_s_sleep(1); \
    if ((++_sp & 255u) == 0u) { if (xb_ld(&(bar)[XB_TMO])) break; if (_sp > XB_SPIN_CAP) { atomicAdd(&(bar)[XB_TMO], 1u); break; } } } } while (0)
struct XcdBarrier { unsigned* bar; unsigned x; volatile LAS unsigned* st; };
__device__ __forceinline__ XcdBarrier xcd_barrier_post(unsigned* bar, volatile LAS unsigned* st) {
    XcdBarrier b; b.bar = bar; b.x = xb_xcc_id(); b.st = st;
    if (threadIdx.x == 0) (void)xb_add(&bar[XB_XCNT(b.x)], 1u);
    return b;
}
__device__ __forceinline__ void xcd_barrier_complete(unsigned* bar, unsigned x, unsigned& nloc, unsigned& nx) {
    const unsigned G = gridDim.x * gridDim.y * gridDim.z;
    unsigned sum, cnt, mine, sp = 0u;
    for (;;) {
        sum = 0u; cnt = 0u; mine = 0u;
#pragma unroll
        for (unsigned j = 0; j < 16; ++j) { const unsigned c = xb_ld(&bar[XB_XCNT(j)]); sum += c; cnt += (c > 0u) ? 1u : 0u; mine = (j == x) ? c : mine; }
        if (sum == G) break;
        __builtin_amdgcn_s_sleep(1);
        if ((++sp & 255u) == 0u) { if (xb_ld(&bar[XB_TMO])) break; if (sp > XB_SPIN_CAP) { atomicAdd(&bar[XB_TMO], 1u); break; } }
    }
    nloc = mine > 0u ? mine : 1u; nx = cnt > 0u ? cnt : 1u;
}
__device__ __forceinline__ void xcd_barrier(const XcdBarrier& b) {
    asm volatile("s_waitcnt vmcnt(0)" ::: "memory");
    __syncthreads();
    if (threadIdx.x == 0) {
        unsigned* bar = b.bar;
        __builtin_amdgcn_s_waitcnt(0);
        unsigned nloc = b.st[0], nx = b.st[1];
        if (nloc == 0u) { xcd_barrier_complete(bar, b.x, nloc, nx); b.st[0] = nloc; b.st[1] = nx; }
        const unsigned old = xb_add(&bar[XB_XSUB(b.x)], 1u);
        const unsigned gen = old / nloc;
        if (old + 1u == (gen + 1u) * nloc) {
            __builtin_amdgcn_fence(__ATOMIC_RELEASE, "agent");
            asm volatile("s_waitcnt vmcnt(0)" ::: "memory");
            const unsigned og = xb_add(&bar[XB_TOP], 1u);
            const unsigned tg = og / nx;
            if (og + 1u == (tg + 1u) * nx) xb_add(&bar[XB_TOPGEN], 1u);
            else XB_SPIN(xb_ld(&bar[XB_TOPGEN]) == tg, bar);
            __builtin_amdgcn_fence(__ATOMIC_ACQUIRE, "agent");
            xb_add(&bar[XB_XGEN(b.x)], 1u);
            asm volatile("s_waitcnt vmcnt(0)" ::: "memory");
        } else {
            XB_SPIN(xb_ld(&bar[XB_XGEN(b.x)]) == gen, bar);
            __builtin_amdgcn_fence(__ATOMIC_ACQUIRE, "agent");
            asm volatile("s_waitcnt vmcnt(0)" ::: "memory");
        }
    }
    __syncthreads();
}

constexpr int MISC_OFF = 131072 + 320;
constexpr int CW_BAR = 4096;
constexpr size_t CTL_ZERO_BYTES = 65536;

__global__ void __launch_bounds__(NTHR, 2) mega_fwd(Params p) {
    extern __shared__ __attribute__((aligned(16))) unsigned char lds_raw[];
    LAS unsigned char* lds = (LAS unsigned char*)lds_raw;
    for (int u = threadIdx.x; u < (LDS_BYTES - 131072) / 4; u += NTHR) ((LAS unsigned*)(lds + 131072))[u] = 0u;
    __syncthreads();
    XcdBarrier bar = xcd_barrier_post((unsigned*)(p.ws + WS_CTL) + CW_BAR, (volatile LAS unsigned*)(lds + MISC_OFF) + 8);
#define GRID_BAR() xcd_barrier(bar)
    phase_prologue(p, lds);
    GRID_BAR();
    phase_u(p, lds);
    GRID_BAR();
    {   pg8::Gemm g{(const bf16*)(p.ws + WS_U), (const bf16*)(p.ws + WS_WIN_T), D, nullptr}; pg8::StaticOrder S; S.init(R_ALL, NPROJ, gridDim.x, blockIdx.x);
        pg8::EpiInProj E{p.ws, (const float*)(p.ws + WS_LB)};
        pg8::gemm_phase<pg8::EpiInProj, pg8::StaticOrder, true, false>(lds, g, S, E); }
    GRID_BAR();
    phase_conv(p);
    GRID_BAR();
    {   const int ch = blockIdx.x;
        if (ch < 64) { const int type = ch >> 5, dir = (ch >> 4) & 1, b = (ch >> 2) & 3, h = ch & 3;
            if (type) scan_chain<true>(p, lds, dir, b, h); else scan_chain<false>(p, lds, dir, b, h); } }
    GRID_BAR();
    phase_mixprep(p);
    GRID_BAR();
    {   pg8::Gemm g{(const bf16*)(p.ws + WS_AMIX2), (const bf16*)(p.ws + WS_WOUT_T), D, nullptr}; pg8::StaticOrder S; S.init(R_X, D, gridDim.x, blockIdx.x);
        pg8::EpiOutProj E{p.x, p.out, (const float*)(p.ws + WS_MOD)};
        pg8::gemm_phase<pg8::EpiOutProj, pg8::StaticOrder, true, false>(lds, g, S, E); }
    GRID_BAR();
    phase_vx(p, lds);
    GRID_BAR();
    phase_topk_naive(p, lds);
    GRID_BAR();
    for (int w = blockIdx.x; w < 256; w += gridDim.x) {
        const int xcd = w & 7, idx = w >> 3, e = xcd * 2 + (idx >> 4), pm = e * 16 + (idx & 15);
        {   pg8::Gemm g{(const bf16*)(p.ws + WS_VX), (const bf16*)(p.ws + WS_WGU_T), D, (const int*)(p.ws + WS_ROWMAP)};
            pg8::PanelOrder S{pm, 8, (size_t)e * 2048 * 1024 * 2}; pg8::EpiMoE1 E{(bf16*)(p.ws + WS_H)};
            pg8::gemm_phase<pg8::EpiMoE1, pg8::PanelOrder, true, true>(lds, g, S, E); }
        VM_WAIT(); __syncthreads();
        if (threadIdx.x == 0) { __builtin_amdgcn_fence(__ATOMIC_ACQUIRE, "agent"); VM_WAIT(); }
        __syncthreads();
        {   pg8::Gemm g{(const bf16*)(p.ws + WS_H), (const bf16*)(p.ws + WS_WD_T), FF, nullptr};
            pg8::PanelOrder S{pm, 4, (size_t)e * 1024 * 1024 * 2}; pg8::EpiMoE2 E{(bf16*)(p.ws + WS_Y), (const float*)(p.ws + WS_GATEV)};
            pg8::gemm_phase<pg8::EpiMoE2, pg8::PanelOrder, true, false>(lds, g, S, E); }
    }
    GRID_BAR();
    phase_final(p);
}

extern "C" void kernel_launch(void* const* d_in, const int* in_sizes, int n_in, void* d_out, int out_size, void* d_ws, size_t ws_size, hipStream_t stream) {
    static int grid = 0;
    if (grid == 0) {
        if (n_in != 21 || out_size != R_X * D || ws_size < WS_END) { fprintf(stderr, "kernel_launch: unexpected shapes: n_in %d out %d ws %zu\n", n_in, out_size, ws_size); grid = -1; return; }
        int dev = 0, cus = 0, per_cu = 0;
        if (hipGetDevice(&dev) != hipSuccess || hipDeviceGetAttribute(&cus, hipDeviceAttributeMultiprocessorCount, dev) != hipSuccess) { grid = -1; return; }
        if (hipFuncSetAttribute((const void*)mega_fwd, hipFuncAttributeMaxDynamicSharedMemorySize, LDS_BYTES) != hipSuccess) { fprintf(stderr, "kernel_launch: hipFuncSetAttribute failed\n"); grid = -1; return; }
        if (hipOccupancyMaxActiveBlocksPerMultiprocessor(&per_cu, (const void*)mega_fwd, NTHR, LDS_BYTES) != hipSuccess || per_cu < 1) { fprintf(stderr, "kernel_launch: occupancy query says %d blocks/CU; nothing launched\n", per_cu); (void)hipGetLastError(); grid = -1; return; }
        grid = cus;
    }
    if (grid < 0) return;
    (void)hipMemsetAsync((char*)d_ws + WS_CTL, 0, CTL_ZERO_BYTES, stream);
    Params p{};
    const float** pp = (const float**)&p;
    for (int i = 0; i < 21; ++i) pp[i] = (const float*)d_in[i];
    p.out = (float*)d_out; p.ws = (unsigned char*)d_ws;
    hipLaunchKernelGGL(mega_fwd, dim3(grid), dim3(NTHR), LDS_BYTES, stream, p);
}
```

```cpp
#include <hip/hip_runtime.h>
#include <cstdio>
#include <cstdint>

#define GAS __attribute__((address_space(1)))
#define LAS __attribute__((address_space(3)))
typedef unsigned short bf16;
typedef float f32x4 __attribute__((ext_vector_type(4)));
typedef float f32x2 __attribute__((ext_vector_type(2)));
typedef unsigned u32x4 __attribute__((ext_vector_type(4)));
typedef unsigned u32x2 __attribute__((ext_vector_type(2)));
typedef short bf16x8 __attribute__((ext_vector_type(8)));
typedef __bf16 bf16x2_t __attribute__((ext_vector_type(2)));
typedef _Float16 f16x2_t __attribute__((ext_vector_type(2)));

constexpr int D = 1024, NB = 4, SEQ = 8192, CTX = 256, SROW = SEQ + CTX, R_ALL = NB * SROW, R_X = NB * SEQ;
constexpr int PROJ = 4624, NPROJ = 4608;
constexpr int NE = 16, CAP = 1024, FF = 1024, R_MOE = NE * NB * CAP;
constexpr float EPS = 1e-6f;
constexpr int NTHR = 512, NWAVES = 8;
constexpr int LDS_BYTES = 147456;

constexpr size_t MiB = 1u << 20;
constexpr size_t WS_CTL = 0;
constexpr size_t WS_MODP = 1 * MiB;
constexpr size_t WS_MOD = 3 * MiB;
constexpr size_t WS_LB = WS_MOD + 128 * 1024;
constexpr size_t WS_WGT = WS_LB + 4096;
constexpr size_t WS_RWT = WS_WGT + 65536;
constexpr size_t WS_WIN_T = 4 * MiB;
constexpr size_t WS_WOUT_T = 13 * MiB;
constexpr size_t WS_GATES = 15 * MiB;
constexpr size_t WS_WGU_T = 18 * MiB;
constexpr size_t WS_WD_T = 82 * MiB;
constexpr size_t WS_U = 114 * MiB;
constexpr size_t WS_HQ = 180 * MiB;
constexpr size_t WS_HV = 213 * MiB;
constexpr size_t WS_HG = 246 * MiB;
constexpr size_t WS_LF = 279 * MiB;
constexpr size_t WS_QK = 345 * MiB;
constexpr size_t WS_MV = 411 * MiB;
constexpr size_t WS_MO = 444 * MiB;
constexpr size_t WS_AFF = 477 * MiB;
constexpr size_t WS_ROWMAP = 479 * MiB;
constexpr size_t WS_GATEV = WS_ROWMAP + 262144;
constexpr size_t WS_SLOT = 480 * MiB;
constexpr size_t WS_SEG = 484 * MiB;
constexpr size_t WS_END = 512 * MiB;
constexpr size_t WS_QKC = WS_U;
constexpr size_t WS_AMIX2 = WS_LF;
constexpr size_t WS_VX = WS_U;
constexpr size_t WS_H = WS_HQ;
constexpr size_t WS_Y = 308 * MiB;

struct Params {
    const float *x, *c, *ctx, *c_ctx, *ada_w, *ada_b, *norm1_w, *w_in, *conv_w, *conv_b, *lb_logits, *ml_gate_b, *hg_norm_w, *ml_norm_w, *w_out, *norm2_w,
        *router_w, *wg, *wu, *wd, *final_w;
    float* out; unsigned char* ws;
};

__device__ __forceinline__ unsigned pk2(float lo, float hi) { f32x2 v = {lo, hi}; bf16x2_t b = __builtin_convertvector(v, bf16x2_t); return __builtin_bit_cast(unsigned, b); }
__device__ __forceinline__ unsigned pkh2(float lo, float hi) { f32x2 v = {lo, hi}; f16x2_t b = __builtin_convertvector(v, f16x2_t); return __builtin_bit_cast(unsigned, b); }
__device__ __forceinline__ float bf2f(unsigned short b) { return __uint_as_float((unsigned)b << 16); }
__device__ __forceinline__ float bflo(unsigned w) { return __uint_as_float(w << 16); }
__device__ __forceinline__ float bfhi(unsigned w) { return __uint_as_float(w & 0xffff0000u); }
__device__ __forceinline__ float h2f(unsigned short h) { return (float)__builtin_bit_cast(_Float16, h); }
__device__ __forceinline__ float sigmoid_(float x) { return 1.0f / (1.0f + __expf(-x)); }
__device__ __forceinline__ float silu_(float x) { return x * sigmoid_(x); }
__device__ __forceinline__ float wave_sum(float v) {
#pragma unroll
    for (int o = 1; o < 64; o <<= 1) v += __shfl_xor(v, o);
    return v;
}
__device__ __forceinline__ int tid_opaque() { int t = threadIdx.x; asm volatile("" : "+v"(t)); return t; }
#define LDS_WAIT() asm volatile("s_waitcnt lgkmcnt(0)" ::: "memory")
#define VM_WAIT() asm volatile("s_waitcnt vmcnt(0)" ::: "memory")

namespace pg8 {
constexpr int BM = 256, BK = 64, HALF = 128, HTB = HALF * BK * 2, STAGE_BYTES = 8 * HTB, NXCD = 8, WGM = 8;
__host__ __device__ __forceinline__ int lds_byte(int r, int c) { const int st = (r >> 4) * 2 + (c >> 5), rr = r & 15, cc = c & 31, ob = rr * 64 + cc * 2; return st * 1024 + (ob ^ (((ob >> 9) & 1) << 5)); }
__host__ __device__ __forceinline__ void stage_rc(int b, int& R, int& C) { const int st = b / 1024, sb = b % 1024, swz = sb ^ (((sb >> 9) & 1) << 5); R = (st >> 1) * 16 + swz / 64; C = (st & 1) * 32 + (swz % 64) / 2; }
__host__ __device__ __forceinline__ int perm32(int rho) { const int n = rho >> 4, i = rho & 15; return 8 * (i >> 2) + 4 * n + (i & 3); }

struct Unit { int pm, pn; size_t boff; };
struct Gemm { const bf16* A; const bf16* Bt; int K; const int* rowmap; };

struct StaticOrder {
    int nM, nN, nwg, G, c;
    __device__ void init(int M, int N, int G_, int c_) { nM = M / BM; nN = N / BM; nwg = nM * nN; G = G_; c = c_; }
    __device__ bool next(int i, Unit& u) const {
        const long L = (long)i * G + c; if (L >= nwg) return false;
        int wgid = (int)L; { const int q = nwg / NXCD, r = nwg % NXCD, xcd = wgid % NXCD, off = wgid / NXCD; wgid = (xcd < r ? xcd * (q + 1) : r * (q + 1) + (xcd - r) * q) + off; }
        const int nig = WGM * nN, gid = wgid / nig, fm = gid * WGM, gsz = (nM - fm) < WGM ? (nM - fm) : WGM;
        u.pm = fm + ((wgid % nig) % gsz); u.pn = (wgid % nig) / gsz; u.boff = 0; return true;
    }
};
struct PanelOrder {
    int pm, npn; size_t boff;
    __device__ bool next(int i, Unit& u) const { if (i >= npn) return false; u.pm = pm; u.pn = i; u.boff = boff; return true; }
};

template <class Epi, class Sched, bool ALIGN_EPI, bool GATHER>
__device__ __forceinline__ void gemm_phase(LAS unsigned char* lds, const Gemm g, const Sched& S, const Epi& E) {
    const int tid = tid_opaque(), wid = __builtin_amdgcn_readfirstlane(tid >> 6), lane = tid & 63, wr = wid >> 2, wc = wid & 3, fr = lane & 15, fq = lane >> 4;
    const int K = g.K, nt = K / BK;
    Unit cur, nxt; int ui = 0;
    if (!S.next(0, cur)) return;
    const size_t kstep = (size_t)(BK * 2);
    const size_t hstep = (size_t)HALF * K * 2;
    const size_t tstep = 2 * hstep;
    unsigned voffA[2][2], voffB[2];
#pragma unroll
    for (int i = 0; i < 2; ++i) { int R, C; stage_rc(tid * 16 + i * 8192, R, C); const int Rb = Epi::PERM ? ((R & ~31) + perm32(R & 31)) : R;
        voffB[i] = (unsigned)(Rb * K + C) * 2u;
#pragma unroll
        for (int h = 0; h < 2; ++h) {
            if (GATHER) voffA[h][i] = (unsigned)g.rowmap[cur.pm * BM + h * HALF + R] * (unsigned)(K * 2) + (unsigned)C * 2u;
            else voffA[h][i] = (unsigned)(R * K + C) * 2u + (unsigned)(h * hstep);
        } }
    const unsigned ldsw = (unsigned)wid * 1024u;
    const int aoff = lds_byte(wr * 64 + fr, fq * 8), boff = lds_byte(wc * 32 + fr, fq * 8);
#define PG8_SA(b, h) (((b) * 2 + (h)) * HTB)
#define PG8_SB(b, h) ((4 + (b) * 2 + (h)) * HTB)
#define PG8_STAGE_A(bufoff, gbase, h) do { _Pragma("unroll") for (int _i = 0; _i < 2; ++_i) \
        __builtin_amdgcn_global_load_lds((const unsigned*)((const char*)(gbase) + voffA[h][_i]), (LAS unsigned*)(lds + (bufoff) + ldsw + _i * 8192), 16, 0, 0); } while (0)
#define PG8_STAGE_B(bufoff, gbase) do { _Pragma("unroll") for (int _i = 0; _i < 2; ++_i) \
        __builtin_amdgcn_global_load_lds((const unsigned*)((const char*)(gbase) + voffB[_i]), (LAS unsigned*)(lds + (bufoff) + ldsw + _i * 8192), 16, 0, 0); } while (0)
#define PG8_LDA(dst, b, h) do { _Pragma("unroll") for (int m = 0; m < 4; ++m) _Pragma("unroll") for (int k = 0; k < 2; ++k) dst[m][k] = *(const LAS bf16x8*)(lds + PG8_SA(b, h) + aoff + m * 2048 + k * 1024); } while (0)
#define PG8_LDB(dst, b, h) do { _Pragma("unroll") for (int n = 0; n < 2; ++n) _Pragma("unroll") for (int k = 0; k < 2; ++k) dst[n][k] = *(const LAS bf16x8*)(lds + PG8_SB(b, h) + boff + n * 2048 + k * 1024); } while (0)
#define PG8_MMA(ai, bj, At, Bt) do { __builtin_amdgcn_s_setprio(1); _Pragma("unroll") for (int m = 0; m < 4; ++m) _Pragma("unroll") for (int n = 0; n < 2; ++n) _Pragma("unroll") for (int k = 0; k < 2; ++k) \
        acc[ai][bj][m][n] = __builtin_amdgcn_mfma_f32_16x16x32_bf16(Bt[n][k], At[m][k], acc[ai][bj][m][n], 0, 0, 0); __builtin_amdgcn_s_setprio(0); } while (0)
#define PG8_WAIT_V(n) asm volatile("s_waitcnt vmcnt(" #n ")" ::: "memory")
#define PG8_WAIT_L(n) asm volatile("s_waitcnt lgkmcnt(" #n ")" ::: "memory")
#define PG8_BAR __builtin_amdgcn_s_barrier()
#define PG8_SCHED __builtin_amdgcn_sched_barrier(0)
    f32x4 acc[2][2][4][2];
#pragma unroll
    for (int a = 0; a < 2; ++a)
#pragma unroll
        for (int b = 0; b < 2; ++b)
#pragma unroll
            for (int m = 0; m < 4; ++m)
#pragma unroll
                for (int n = 0; n < 2; ++n) acc[a][b][m][n] = (f32x4){0.f, 0.f, 0.f, 0.f};
    bf16x8 At[4][2], B0[2][2], B1[2][2];
    const char* cA = GATHER ? (const char*)g.A : (const char*)g.A + (size_t)cur.pm * tstep;
    const char* cB = (const char*)g.Bt + cur.boff + (size_t)cur.pn * tstep;
    if (GATHER) VM_WAIT();
    PG8_STAGE_B(PG8_SB(0, 0), cB); PG8_STAGE_B(PG8_SB(0, 1), cB + hstep); PG8_STAGE_A(PG8_SA(0, 0), cA, 0); PG8_STAGE_A(PG8_SA(0, 1), cA, 1);
    if (wr == 1) PG8_BAR;
    PG8_WAIT_V(2); PG8_BAR;
    PG8_STAGE_B(PG8_SB(1, 0), cB + kstep); PG8_STAGE_A(PG8_SA(1, 0), cA + kstep, 0); PG8_STAGE_B(PG8_SB(1, 1), cB + hstep + kstep);
    PG8_WAIT_V(6); PG8_BAR;
    for (;;) {
        const bool has_next = S.next(ui + 1, nxt);
        const char* nA = has_next ? (GATHER ? (const char*)g.A : (const char*)g.A + (size_t)nxt.pm * tstep) : cA;
        const char* nB = has_next ? (const char*)g.Bt + nxt.boff + (size_t)nxt.pn * tstep : cB;
        for (int t = 0; t < nt; t += 2) {
            const bool last = (t == nt - 2);
            const char* a1 = cA + (size_t)(t + 1) * kstep;
            const char* a2 = last ? nA : cA + (size_t)(t + 2) * kstep; const char* b2 = last ? nB : cB + (size_t)(t + 2) * kstep;
            const char* a3 = a2 + kstep; const char* b3 = b2 + kstep;
            PG8_LDB(B0, 0, 0); PG8_LDB(B1, 0, 1); PG8_SCHED; PG8_LDA(At, 0, 0); PG8_STAGE_A(PG8_SA(1, 1), a1, 1);
            PG8_WAIT_V(8); PG8_WAIT_L(0); PG8_BAR; PG8_MMA(0, 0, At, B0); PG8_MMA(0, 1, At, B1); PG8_BAR; PG8_SCHED;
            PG8_LDA(At, 0, 1); PG8_STAGE_B(PG8_SB(0, 0), b2); PG8_STAGE_B(PG8_SB(0, 1), b2 + hstep); PG8_STAGE_A(PG8_SA(0, 0), a2, 0);
            PG8_WAIT_V(8); PG8_WAIT_L(0); PG8_BAR; PG8_MMA(1, 0, At, B0); PG8_MMA(1, 1, At, B1); PG8_BAR; PG8_SCHED;
            PG8_LDB(B0, 1, 0); PG8_LDB(B1, 1, 1); PG8_SCHED; PG8_LDA(At, 1, 0); PG8_STAGE_A(PG8_SA(0, 1), a2, 1);
            PG8_WAIT_V(8); PG8_WAIT_L(0); PG8_BAR; PG8_MMA(0, 0, At, B0); PG8_MMA(0, 1, At, B1); PG8_BAR; PG8_SCHED;
            PG8_LDA(At, 1, 1); PG8_STAGE_B(PG8_SB(1, 0), b3); PG8_STAGE_B(PG8_SB(1, 1), b3 + hstep); PG8_STAGE_A(PG8_SA(1, 0), a3, 0);
            PG8_WAIT_V(8); PG8_WAIT_L(0); PG8_BAR; PG8_MMA(1, 0, At, B0); PG8_MMA(1, 1, At, B1); PG8_BAR; PG8_SCHED;
        }
        if constexpr (ALIGN_EPI) { if (wr == 0) PG8_BAR; }
        E(acc, cur, wr, wc, fr, fq);
        if (!has_next) break;
#pragma unroll
        for (int a = 0; a < 2; ++a)
#pragma unroll
            for (int b = 0; b < 2; ++b)
#pragma unroll
                for (int m = 0; m < 4; ++m)
#pragma unroll
                    for (int n = 0; n < 2; ++n) acc[a][b][m][n] = (f32x4){0.f, 0.f, 0.f, 0.f};
        cur = nxt; cA = nA; cB = nB; ++ui;
        if constexpr (ALIGN_EPI) { if (wr == 1) PG8_BAR; }
    }
    PG8_WAIT_V(0);
    if constexpr (!ALIGN_EPI) { if (wr == 0) PG8_BAR; }
    PG8_BAR;
#undef PG8_SA
#undef PG8_SB
#undef PG8_STAGE_A
#undef PG8_STAGE_B
#undef PG8_LDA
#undef PG8_LDB
#undef PG8_MMA
#undef PG8_WAIT_V
#undef PG8_WAIT_L
#undef PG8_BAR
#undef PG8_SCHED
}

struct EpiInProj {
    static constexpr bool PERM = true;
    unsigned char* ws; const float* lb;
    __device__ __forceinline__ void operator()(const f32x4 (&acc)[2][2][4][2], const Unit& u, int wr, int wc, int fr_, int fq) const {
        int fr = fr_; asm volatile("" : "+v"(fr));
        const int pn = u.pn; size_t base; int ld, colbase, act;
        if (pn < 2) { base = WS_HQ; ld = 512; colbase = pn * 256; act = 1; }
        else if (pn < 4) { base = WS_HV; ld = 512; colbase = (pn - 2) * 256; act = 0; }
        else if (pn < 6) { base = WS_HG; ld = 512; colbase = (pn - 4) * 256; act = 1; }
        else if (pn < 10) { base = WS_LF; ld = 1024; colbase = (pn - 6) * 256; act = 3; }
        else if (pn < 14) { base = WS_QK; ld = 1024; colbase = (pn - 10) * 256; act = 0; }
        else if (pn < 16) { base = WS_MV; ld = 512; colbase = (pn - 14) * 256; act = 0; }
        else { base = WS_MO; ld = 512; colbase = (pn - 16) * 256; act = 2; }
        bf16* O = (bf16*)(ws + base);
        const int row0 = u.pm * BM + wr * 64 + fr, col0 = colbase + wc * 32 + 8 * fq;
#pragma unroll
        for (int bj = 0; bj < 2; ++bj) {
            float lbv[8];
            if (act == 3) {
#pragma unroll
                for (int e = 0; e < 8; ++e) lbv[e] = lb[col0 + bj * HALF + e];
            }
#pragma unroll
            for (int ai = 0; ai < 2; ++ai)
#pragma unroll
                for (int m = 0; m < 4; ++m) {
                    float v[8];
#pragma unroll
                    for (int e = 0; e < 4; ++e) { v[e] = acc[ai][bj][m][0][e]; v[4 + e] = acc[ai][bj][m][1][e]; }
                    u32x4 w;
                    if (act == 3) {
#pragma unroll
                        for (int e = 0; e < 8; ++e) v[e] = __logf(lbv[e] + (1.0f - lbv[e]) * sigmoid_(v[e]));
                        w.x = pkh2(v[0], v[1]); w.y = pkh2(v[2], v[3]); w.z = pkh2(v[4], v[5]); w.w = pkh2(v[6], v[7]);
                    } else {
                        if (act == 1) {
#pragma unroll
                            for (int e = 0; e < 8; ++e) v[e] = silu_(v[e]);
                        } else if (act == 2) {
#pragma unroll
                            for (int e = 0; e < 8; ++e) v[e] = sigmoid_(v[e]);
                        }
                        w.x = pk2(v[0], v[1]); w.y = pk2(v[2], v[3]); w.z = pk2(v[4], v[5]); w.w = pk2(v[6], v[7]);
                    }
                    *(u32x4*)(O + (size_t)(row0 + ai * HALF + m * 16) * ld + col0 + bj * HALF) = w;
                }
        }
    }
};
struct EpiOutProj {
    static constexpr bool PERM = false;
    const float* x; float* out; const float* mod;
    __device__ __forceinline__ void operator()(const f32x4 (&acc)[2][2][4][2], const Unit& u, int wr, int wc, int fr_, int fq) const {
        int fr = fr_; asm volatile("" : "+v"(fr));
        const int row0 = u.pm * BM + wr * 64 + fr, col0 = u.pn * BM + wc * 32 + 4 * fq;
        const float* g1 = mod + (size_t)(u.pm / 32) * 6144 + 2048;
#pragma unroll
        for (int bj = 0; bj < 2; ++bj)
#pragma unroll
            for (int n = 0; n < 2; ++n) {
                const int c = col0 + bj * HALF + n * 16; const f32x4 gv = *(const f32x4*)(g1 + c);
#pragma unroll
                for (int ai = 0; ai < 2; ++ai)
#pragma unroll
                    for (int m = 0; m < 4; ++m) { const size_t off = (size_t)(row0 + ai * HALF + m * 16) * D + c;
                        *(f32x4*)(out + off) = *(const f32x4*)(x + off) + gv * acc[ai][bj][m][n]; }
            }
    }
};
struct EpiMoE1 {
    static constexpr bool PERM = true;
    bf16* H;
    __device__ __forceinline__ void operator()(const f32x4 (&acc)[2][2][4][2], const Unit& u, int wr, int wc, int fr_, int fq) const {
        int fr = fr_; asm volatile("" : "+v"(fr));
        const int row0 = u.pm * BM + wr * 64 + fr, col0 = u.pn * HALF + wc * 32 + 8 * fq;
#pragma unroll
        for (int ai = 0; ai < 2; ++ai)
#pragma unroll
            for (int m = 0; m < 4; ++m) {
                float v[8];
#pragma unroll
                for (int e = 0; e < 4; ++e) { v[e] = silu_(acc[ai][0][m][0][e]) * acc[ai][1][m][0][e]; v[4 + e] = silu_(acc[ai][0][m][1][e]) * acc[ai][1][m][1][e]; }
                u32x4 w; w.x = pk2(v[0], v[1]); w.y = pk2(v[2], v[3]); w.z = pk2(v[4], v[5]); w.w = pk2(v[6], v[7]);
                *(u32x4*)(H + (size_t)(row0 + ai * HALF + m * 16) * FF + col0) = w;
            }
    }
};
struct EpiMoE2 {
    static constexpr bool PERM = true;
    bf16* Y; const float* gatev;
    __device__ __forceinline__ void operator()(const f32x4 (&acc)[2][2][4][2], const Unit& u, int wr, int wc, int fr_, int fq) const {
        int fr = fr_; asm volatile("" : "+v"(fr));
        const int row0 = u.pm * BM + wr * 64 + fr, col0 = u.pn * BM + wc * 32 + 8 * fq;
#pragma unroll
        for (int ai = 0; ai < 2; ++ai)
#pragma unroll
            for (int m = 0; m < 4; ++m) { const int row = row0 + ai * HALF + m * 16; const float gt = gatev[row];
#pragma unroll
                for (int bj = 0; bj < 2; ++bj) { const f32x4 a = acc[ai][bj][m][0] * gt, b = acc[ai][bj][m][1] * gt;
                    u32x4 w; w.x = pk2(a[0], a[1]); w.y = pk2(a[2], a[3]); w.z = pk2(b[0], b[1]); w.w = pk2(b[2], b[3]);
                    *(u32x4*)(Y + (size_t)row * D + col0 + bj * HALF) = w; } }
    }
};
}

__device__ __forceinline__ void transpose_item(const float* W, int ldw, int k0, int n0, bf16* dst_row0, LAS float* scr, int lane) {
#pragma unroll 8
    for (int i = 0; i < 32; ++i) { const int kk = 2 * i + (lane >> 5); scr[kk * 33 + (lane & 31)] = W[(size_t)(k0 + kk) * ldw + n0 + (lane & 31)]; }
    LDS_WAIT(); asm volatile("" ::: "memory");
    const int c = lane & 7;
#pragma unroll
    for (int j = 0; j < 4; ++j) { const int n = (lane >> 3) + 8 * j; const LAS float* s = scr + (8 * c) * 33 + n;
        u32x4 o; o.x = pk2(s[0 * 33], s[1 * 33]); o.y = pk2(s[2 * 33], s[3 * 33]); o.z = pk2(s[4 * 33], s[5 * 33]); o.w = pk2(s[6 * 33], s[7 * 33]);
        *(u32x4*)(dst_row0 + (size_t)n * 1024 + k0 + 8 * c) = o; }
    LDS_WAIT(); asm volatile("" ::: "memory");
}
__device__ __forceinline__ void phase_prologue(const Params& p, LAS unsigned char* lds) {
    const int tid = tid_opaque(), lane = tid & 63, wave = tid >> 6;
    const int gw = blockIdx.x * NWAVES + wave, NGW = gridDim.x * NWAVES;
    LAS float* scr = (LAS float*)(lds + wave * 16384);
    constexpr int I_IN = 16 * 144, I_OUT = 16 * 32, I_E = 16 * 512, I_MOD = 24 * 16;
    constexpr int NITEMS = I_IN + I_OUT + 3 * I_E + I_MOD;
    unsigned char* ws = p.ws;
    for (int it = gw; it < NITEMS; it += NGW) {
        int r = it;
        if (r < I_IN) { const int kb = r / 144, nb = r % 144; transpose_item(p.w_in, PROJ, kb * 64, nb * 32, (bf16*)(ws + WS_WIN_T) + (size_t)(nb * 32) * 1024, scr, lane); continue; } r -= I_IN;
        if (r < I_OUT) { const int kb = r / 32, nb = r % 32; transpose_item(p.w_out, D, kb * 64, nb * 32, (bf16*)(ws + WS_WOUT_T) + (size_t)(nb * 32) * 1024, scr, lane); continue; } r -= I_OUT;
        if (r < 2 * I_E) { const int up = r / I_E; r -= up * I_E; const int e = r / 512, q = r % 512, kb = q / 32, nb = q % 32, n0 = nb * 32;
            const int drow = (n0 / 128) * 256 + up * 128 + (n0 % 128);
            transpose_item((up ? p.wu : p.wg) + (size_t)e * D * FF, FF, kb * 64, n0, (bf16*)(ws + WS_WGU_T) + ((size_t)e * 2048 + drow) * 1024, scr, lane); continue; } r -= 2 * I_E;
        if (r < I_E) { const int e = r / 512, q = r % 512, kb = q / 32, nb = q % 32;
            transpose_item(p.wd + (size_t)e * FF * D, D, kb * 64, nb * 32, (bf16*)(ws + WS_WD_T) + ((size_t)e * 1024 + nb * 32) * 1024, scr, lane); continue; } r -= I_E;
        {
            const int cb = r / 16, ks = r % 16; const int col = cb * 256 + lane * 4;
            f32x4 a[5];
#pragma unroll
            for (int q = 0; q < 5; ++q) a[q] = (f32x4){0.f, 0.f, 0.f, 0.f};
            for (int k = ks * 64; k < ks * 64 + 64; ++k) {
                const f32x4 w = *(const f32x4*)(p.ada_w + (size_t)k * 6144 + col);
#pragma unroll
                for (int q = 0; q < 5; ++q) { const float cv = (q < 4) ? p.c[q * D + k] : p.c_ctx[k]; a[q] += w * silu_(cv); }
            }
            float* mp = (float*)(ws + WS_MODP);
#pragma unroll
            for (int q = 0; q < 5; ++q) *(f32x4*)(mp + ((size_t)ks * 5 + q) * 6144 + col) = a[q];
        }
    }
    const int gt = blockIdx.x * NTHR + tid, NGT = gridDim.x * NTHR;
    for (int i = gt; i < 1024; i += NGT) { const float l0 = p.lb_logits[i], l1 = p.lb_logits[1024 + i]; ((float*)(ws + WS_LB))[i] = 1.0f / (1.0f + __expf(l1 - l0)); }
    for (int i = gt; i < 16 * 1024; i += NGT) { const int g = i >> 10, k = i & 1023; ((float*)(ws + WS_WGT))[i] = p.w_in[(size_t)k * PROJ + NPROJ + g]; ((float*)(ws + WS_RWT))[i] = p.router_w[k * 16 + g]; }
}

__device__ __forceinline__ void phase_u(const Params& p, LAS unsigned char* lds) {
    const int tid = tid_opaque(), lane = tid & 63, wave = tid >> 6;
    unsigned char* ws = p.ws;
    LAS float* Lsh = (LAS float*)lds;
    LAS float* Lsc = Lsh + 5 * 1024;
    LAS float* Lnw = Lsc + 5 * 1024;
    LAS float* Lwg = Lnw + 1024;
    const float* modp = (const float*)(ws + WS_MODP);
    for (int idx = tid; idx < 5 * 2048; idx += NTHR) { const int r = idx / 2048, col = idx % 2048; float s = p.ada_b[col];
        for (int ks = 0; ks < 16; ++ks) s += modp[((size_t)ks * 5 + r) * 6144 + col];
        if (col < 1024) Lsh[r * 1024 + col] = s; else Lsc[r * 1024 + col - 1024] = s; }
    for (int e = blockIdx.x * NTHR + tid; e < 5 * 6144; e += gridDim.x * NTHR) { const int r = e / 6144, col = e % 6144; float s = p.ada_b[col];
        for (int ks = 0; ks < 16; ++ks) s += modp[((size_t)ks * 5 + r) * 6144 + col];
        ((float*)(ws + WS_MOD))[e] = s; }
    for (int i = tid; i < 1024; i += NTHR) Lnw[i] = p.norm1_w[i];
    for (int i = tid; i < 16 * 1024; i += NTHR) Lwg[i] = ((const float*)(ws + WS_WGT))[i];
    __syncthreads();
    const int gw = blockIdx.x * NWAVES + wave, NGW = gridDim.x * NWAVES;
    for (int row = gw; row < R_ALL; row += NGW) {
        const int b = row / SROW, s = row % SROW;
        const float* src = (s < CTX) ? p.ctx + ((size_t)b * CTX + s) * D : p.x + ((size_t)b * SEQ + (s - CTX)) * D;
        const int r = (s < CTX) ? 4 : b;
        f32x4 v[4]; float ss = 0.f;
#pragma unroll
        for (int j = 0; j < 4; ++j) { v[j] = *(const f32x4*)(src + j * 256 + lane * 4); ss += (v[j].x * v[j].x + v[j].y * v[j].y) + (v[j].z * v[j].z + v[j].w * v[j].w); }
        const float rstd = rsqrtf(wave_sum(ss) * (1.0f / D) + EPS);
        bf16* urow = (bf16*)(ws + WS_U) + (size_t)row * D;
#pragma unroll
        for (int j = 0; j < 4; ++j) { const int c0 = j * 256 + lane * 4;
            const f32x4 nw = *(const LAS f32x4*)(Lnw + c0), sc = *(const LAS f32x4*)(Lsc + r * 1024 + c0), sh = *(const LAS f32x4*)(Lsh + r * 1024 + c0);
            v[j] = v[j] * rstd * nw * (1.0f + sc) + sh;
            u32x2 w; w.x = pk2(v[j].x, v[j].y); w.y = pk2(v[j].z, v[j].w); *(u32x2*)(urow + c0) = w; }
        float mine = 0.f;
#pragma unroll 2
        for (int g = 0; g < 16; ++g) { float a = 0.f;
#pragma unroll
            for (int j = 0; j < 4; ++j) { const f32x4 w = *(const LAS f32x4*)(Lwg + g * 1024 + j * 256 + lane * 4); a += (v[j].x * w.x + v[j].y * w.y) + (v[j].z * w.z + v[j].w * w.w); }
            a = wave_sum(a); if (lane == g) mine = a; }
        if (lane < 16) { float gv = mine + p.ml_gate_b[lane];
            if ((lane >> 2) & 1) gv = fminf(gv, 0.f) - log1pf(__expf(-fabsf(gv)));
            ((float*)(ws + WS_GATES))[(size_t)row * 16 + lane] = gv; }
    }
}

__device__ __forceinline__ void phase_conv(const Params& p) {
    unsigned char* ws = p.ws;
    const bf16* QK = (const bf16*)(ws + WS_QK); bf16* QKC = (bf16*)(ws + WS_QKC);
    const long total = (long)R_ALL * 128;
    const int tid0 = tid_opaque();
    for (long it = (long)blockIdx.x * NTHR + tid0; it < total; it += (long)gridDim.x * NTHR) {
        const int row = (int)(it >> 7), ch = (int)(it & 127) * 8;
        const int b = row / SROW, s = row % SROW;
        float a[8];
#pragma unroll
        for (int e = 0; e < 8; ++e) a[e] = p.conv_b[ch + e];
        if (s < CTX) {
#pragma unroll
            for (int j = 0; j < 3; ++j) { const int s2 = s + j - 1; if (s2 < 0 || s2 >= CTX) continue;
                const u32x4 w = *(const u32x4*)(QK + ((size_t)b * SROW + s2) * 1024 + ch); const float* cw = p.conv_w + (size_t)(3 + j) * 1024 + ch;
                a[0] += bflo(w.x) * cw[0]; a[1] += bfhi(w.x) * cw[1]; a[2] += bflo(w.y) * cw[2]; a[3] += bfhi(w.y) * cw[3];
                a[4] += bflo(w.z) * cw[4]; a[5] += bfhi(w.z) * cw[5]; a[6] += bflo(w.w) * cw[6]; a[7] += bfhi(w.w) * cw[7]; }
        } else {
            const int t = s - CTX, gr = t >> 6, gc = t & 63;
#pragma unroll
            for (int i = 0; i < 3; ++i) { const int r2 = gr + i - 1; if (r2 < 0 || r2 >= 128) continue;
#pragma unroll
                for (int j = 0; j < 3; ++j) { const int c2 = gc + j - 1; if (c2 < 0 || c2 >= 64) continue;
                    const u32x4 w = *(const u32x4*)(QK + ((size_t)b * SROW + CTX + r2 * 64 + c2) * 1024 + ch); const float* cw = p.conv_w + (size_t)(i * 3 + j) * 1024 + ch;
                    a[0] += bflo(w.x) * cw[0]; a[1] += bfhi(w.x) * cw[1]; a[2] += bflo(w.y) * cw[2]; a[3] += bfhi(w.y) * cw[3];
                    a[4] += bflo(w.z) * cw[4]; a[5] += bfhi(w.z) * cw[5]; a[6] += bflo(w.w) * cw[6]; a[7] += bfhi(w.w) * cw[7]; } }
        }
        const float sc = (ch >= 512) ? 0.08838834764831845f : 1.0f;
#pragma unroll
        for (int e = 0; e < 8; ++e) a[e] = silu_(a[e]) * sc;
        u32x4 o; o.x = pk2(a[0], a[1]); o.y = pk2(a[2], a[3]); o.z = pk2(a[4], a[5]); o.w = pk2(a[6], a[7]);
        *(u32x4*)(QKC + (size_t)row * 1024 + ch) = o;
    }
}

template <bool ML>
__device__ __forceinline__ void scan_chain(const Params& p, LAS unsigned char* lds, int dir, int b, int h) {
    const int tid = tid_opaque(), v = tid & 127, cq = tid >> 7;
    unsigned char* ws = p.ws;
    LAS float* Fd = (LAS float*)lds;
    LAS float* Kd = Fd + 1024, *Qd = Kd + 1024, *Vd = Qd + 1024;
    LAS float* Pn = Vd + 1024;
    LAS float* Pd = Pn + 4096;
    LAS float* Li = Pd + 32, *Lf = Li + 8, *Em = Lf + 8;
    float S[32], nn[32];
#pragma unroll
    for (int i = 0; i < 32; ++i) { S[i] = 0.f; nn[i] = 0.f; }
    float m = 0.f;
    const int st = tid >> 6, sp = tid & 63;
    float rf0, rf1, rk0, rk1, rq0, rq1, rv0, rv1, rli = 0.f, rlf = 0.f;
#define ROW_OF(n) (b * SROW + (dir ? ((n) < CTX ? CTX - 1 - (n) : CTX + (SROW - 1 - (n))) : (n)))
#define STAGE_LOAD(n0_) do { const int row = ROW_OF((n0_) + st); const int c = h * 128 + 2 * sp; \
        if (!ML) { \
            const unsigned lf = *(const unsigned*)((const bf16*)(ws + WS_LF) + (size_t)row * 1024 + dir * 512 + c); \
            const unsigned q = *(const unsigned*)((const bf16*)(ws + WS_HQ) + (size_t)row * 512 + c); \
            const unsigned vv = *(const unsigned*)((const bf16*)(ws + WS_HV) + (size_t)row * 512 + c); \
            rf0 = __expf(h2f((unsigned short)(lf & 0xffff))); rf1 = __expf(h2f((unsigned short)(lf >> 16))); rk0 = 1.0f - rf0; rk1 = 1.0f - rf1; \
            rq0 = bflo(q); rq1 = bfhi(q); rv0 = bflo(vv); rv1 = bfhi(vv); \
        } else { \
            const unsigned q = *(const unsigned*)((const bf16*)(ws + WS_QKC) + (size_t)row * 1024 + c); \
            const unsigned k = *(const unsigned*)((const bf16*)(ws + WS_QKC) + (size_t)row * 1024 + 512 + c); \
            const unsigned vv = *(const unsigned*)((const bf16*)(ws + WS_MV) + (size_t)row * 512 + c); \
            rf0 = rf1 = 0.f; rk0 = bflo(k); rk1 = bfhi(k); rq0 = bflo(q); rq1 = bfhi(q); rv0 = bflo(vv); rv1 = bfhi(vv); \
            if (sp == 0) { const float* gp = (const float*)(ws + WS_GATES) + (size_t)row * 16 + dir * 8 + h; rli = gp[0]; rlf = gp[4]; } \
        } } while (0)
#define STAGE_WRITE() do { const int o_ = st * 128 + 2 * sp; \
        Fd[o_] = rf0; Fd[o_ + 1] = rf1; Kd[o_] = rk0; Kd[o_ + 1] = rk1; Qd[o_] = rq0; Qd[o_ + 1] = rq1; Vd[o_] = rv0; Vd[o_ + 1] = rv1; \
        if (ML && sp == 0) { Li[st] = rli; Lf[st] = rlf; } } while (0)
    STAGE_LOAD(0); STAGE_WRITE(); __syncthreads();
    for (int n0 = 0; n0 < SROW; n0 += 8) {
        if (n0 + 8 < SROW) STAGE_LOAD(n0 + 8);
#pragma unroll 1
        for (int t = 0; t < 8; ++t) {
            const float vv = Vd[t * 128 + v];
            float o = 0.f, dn = 0.f, fa = 0.f, ia = 0.f;
            if (ML) { const float li = Li[t], lf = Lf[t]; const float mn = fmaxf(lf + m, li); fa = __expf(lf + m - mn); ia = __expf(li - mn); m = mn; if (tid == 0) Em[t] = __expf(-mn); }
#pragma unroll
            for (int c4 = 0; c4 < 8; ++c4) {
                const f32x4 kk = *(const LAS f32x4*)(Kd + t * 128 + cq * 32 + c4 * 4), qq = *(const LAS f32x4*)(Qd + t * 128 + cq * 32 + c4 * 4);
                f32x4 ff; if (!ML) ff = *(const LAS f32x4*)(Fd + t * 128 + cq * 32 + c4 * 4);
#pragma unroll
                for (int e = 0; e < 4; ++e) { const int i = c4 * 4 + e;
                    if (!ML) { S[i] = ff[e] * S[i] + kk[e] * vv; o += S[i] * qq[e]; }
                    else { const float ik = ia * kk[e]; S[i] = fa * S[i] + ik * vv; nn[i] = fa * nn[i] + ik; o += S[i] * qq[e]; dn += nn[i] * qq[e]; } }
            }
            Pn[(t * 4 + cq) * 128 + v] = o;
            if (ML && v == 0) Pd[t * 4 + cq] = dn;
        }
        __syncthreads();
        if (n0 >= CTX) {
            const int t = tid >> 6, v0 = 2 * (tid & 63);
            float o0 = (Pn[(t * 4 + 0) * 128 + v0] + Pn[(t * 4 + 1) * 128 + v0]) + (Pn[(t * 4 + 2) * 128 + v0] + Pn[(t * 4 + 3) * 128 + v0]);
            float o1 = (Pn[(t * 4 + 0) * 128 + v0 + 1] + Pn[(t * 4 + 1) * 128 + v0 + 1]) + (Pn[(t * 4 + 2) * 128 + v0 + 1] + Pn[(t * 4 + 3) * 128 + v0 + 1]);
            if (ML) { const float den = (Pd[t * 4 + 0] + Pd[t * 4 + 1]) + (Pd[t * 4 + 2] + Pd[t * 4 + 3]); const float dd = fmaxf(fabsf(den), Em[t]); o0 = o0 / dd; o1 = o1 / dd; }
            const int row = ROW_OF(n0 + t); const int xrow = b * SEQ + (row - b * SROW - CTX);
            bf16* O = (bf16*)p.out + ((size_t)dir * R_X + xrow) * 1024 + (ML ? 512 : 0) + h * 128 + v0;
            *(unsigned*)O = pk2(o0, o1);
        }
        if (n0 + 8 < SROW) STAGE_WRITE();
        __syncthreads();
    }
}

namespace sc {
typedef short v4i16_t __attribute__((ext_vector_type(4)));
constexpr int PQ = 272, PK = 144;
constexpr int L_QT = 0, L_KT = 17408, L_K2T = 34816, L_V = 53248, L_P = 70656, L_O = 79872, L_ST = 97280, L_TOT = 132096, L_DVEC = 136192, L_EREF = 136704,
              L_N = 137216, L_DV = 137728, L_FL = 137984, L_END = 138240;
constexpr size_t SEG_STRIDE = 66560;

__device__ __forceinline__ int row_of(int dir, int b, int n) { const int s = dir ? (n < CTX ? CTX - 1 - n : CTX + (SROW - 1 - n)) : n; return b * SROW + s; }
__device__ __forceinline__ bf16x8 ld8(LAS unsigned char* lds, int off) { return *(const LAS bf16x8*)(lds + off); }
__device__ __forceinline__ bf16x8 trB(LAS unsigned char* lds, int off) {
    const v4i16_t a = __builtin_amdgcn_ds_read_tr16_b64_v4i16((LAS v4i16_t*)(lds + off));
    const v4i16_t b = __builtin_amdgcn_ds_read_tr16_b64_v4i16((LAS v4i16_t*)(lds + off + 4 * PQ));
    return (bf16x8){a[0], a[1], a[2], a[3], b[0], b[1], b[2], b[3]};
}
__device__ __forceinline__ float rdlane(float v, int idx) { return __uint_as_float((unsigned)__builtin_amdgcn_readlane((int)__float_as_uint(v), idx)); }
#define SC_MFMA(a, b, c) __builtin_amdgcn_mfma_f32_16x16x32_bf16((a), (b), (c), 0, 0, 0)

template <bool ML>
__device__ __forceinline__ void pc_step(LAS unsigned char* lds, int w, int li, int g, int offA, int offB) {
    for (int ti = w; ti < 10; ti += 8) {
        const int ib = (ti >= 6) ? 3 : (ti >= 3) ? 2 : (ti >= 1) ? 1 : 0, jb = ti - (ib * (ib + 1)) / 2;
        f32x4 acc = (f32x4){0.f, 0.f, 0.f, 0.f};
#pragma unroll
        for (int s = 0; s < 4; ++s) acc = SC_MFMA(ld8(lds, offA + (16 * jb + li) * PQ + (32 * s + 8 * g) * 2), ld8(lds, offB + (16 * ib + li) * PQ + (32 * s + 8 * g) * 2), acc);
        const int i = 16 * ib + li, j0 = 16 * jb + 4 * g;
        const float v0 = (j0 + 0 <= i) ? acc[0] : 0.f, v1 = (j0 + 1 <= i) ? acc[1] : 0.f, v2 = (j0 + 2 <= i) ? acc[2] : 0.f, v3 = (j0 + 3 <= i) ? acc[3] : 0.f;
        u32x2 pw; pw.x = pk2(v0, v1); pw.y = pk2(v2, v3);
        *(LAS u32x2*)(lds + L_P + i * PK + j0 * 2) = pw;
        if (ML) { float ps = (bflo(pw.x) + bfhi(pw.x)) + (bflo(pw.y) + bfhi(pw.y)); ps += __shfl_xor(ps, 16); ps += __shfl_xor(ps, 32);
            if (g == 0) __hip_atomic_fetch_add((LAS float*)(lds + L_DV) + i, ps, __ATOMIC_RELAXED, __HIP_MEMORY_SCOPE_WORKGROUP); }
    }
}
__device__ __forceinline__ void w_step(const Params& p, LAS unsigned char* lds, int tid, int dir, int b, int nbase, int col0) {
#pragma unroll
    for (int q = 0; q < 2; ++q) { const int idx = tid + q * NTHR, i = idx >> 4, ch = idx & 15;
        const u32x4 val = *(const LAS u32x4*)(lds + L_O + i * PQ + ch * 16);
        const int row = row_of(dir, b, nbase + i), xrow = b * SEQ + (row - b * SROW - CTX);
        *(u32x4*)((bf16*)p.out + ((size_t)dir * R_X + xrow) * 1024 + col0 + ch * 8) = val; }
}
__device__ __forceinline__ void save_tiles(float* dst, const f32x4 (&S)[8], int w, int lane) {
#pragma unroll
    for (int t = 0; t < 8; ++t) *(f32x4*)(dst + ((size_t)(w * 8 + t) * 64 + lane) * 4) = S[t];
}

struct HgIn { unsigned lf[8], q[8], v[8]; };
template <bool OUT>
__device__ __forceinline__ void hg_load(const Params& p, HgIn& r, int dir, int b, int h, int nbase, int w, int l) {
    const unsigned char* ws = p.ws;
#pragma unroll
    for (int t = 0; t < 8; ++t) { const size_t row = (size_t)row_of(dir, b, nbase + 8 * w + t);
        r.lf[t] = *(const unsigned*)((const bf16*)(ws + WS_LF) + row * 1024 + dir * 512 + h * 128 + 2 * l);
        r.v[t] = *(const unsigned*)((const bf16*)(ws + WS_HV) + row * 512 + h * 128 + 2 * l);
        if (OUT) r.q[t] = *(const unsigned*)((const bf16*)(ws + WS_HQ) + row * 512 + h * 128 + 2 * l); else r.q[t] = 0u; }
}
template <bool OUT>
__device__ __forceinline__ void hg_run(const Params& p, LAS unsigned char* lds, int dir, int b, int h, int n0, int nch, f32x4 (&S)[8], float& lt0, float& lt1) {
    const int tid = tid_opaque(), w = __builtin_amdgcn_readfirstlane(tid >> 6), l = tid & 63, li = l & 15, g = l >> 4;
    HgIn cur, nxt;
    hg_load<OUT>(p, cur, dir, b, h, n0, w, l);
    for (int c = 0; c < nch; ++c) {
        const int nbase = n0 + 64 * c;
        float a0[8], a1[8], f0[8], f1[8]; float c0 = 0.f, c1 = 0.f;
#pragma unroll
        for (int t = 0; t < 8; ++t) { f0[t] = h2f((unsigned short)(cur.lf[t] & 0xffffu)); f1[t] = h2f((unsigned short)(cur.lf[t] >> 16)); c0 += f0[t]; c1 += f1[t]; a0[t] = c0; a1[t] = c1; }
        *(LAS f32x2*)(lds + L_TOT + (w * 128 + 2 * l) * 4) = (f32x2){c0, c1};
        __syncthreads();
        float pre0 = 0.f, pre1 = 0.f, ar0 = 0.f, ar1 = 0.f, al0 = 0.f, al1 = 0.f;
#pragma unroll
        for (int w2 = 0; w2 < 8; ++w2) { const f32x2 tt = *(const LAS f32x2*)(lds + L_TOT + (w2 * 128 + 2 * l) * 4);
            if (w2 < w) { pre0 += tt.x; pre1 += tt.y; } if (w2 < 4) { ar0 += tt.x; ar1 += tt.y; } al0 += tt.x; al1 += tt.y; }
        unsigned k2a[8], k2b[8];
#pragma unroll
        for (int t = 0; t < 8; ++t) { const int j = 8 * w + t;
            const float A0 = a0[t] + pre0, A1 = a1[t] + pre1;
            const float k0 = 1.0f - __expf(f0[t]), k1 = 1.0f - __expf(f1[t]);
            const float kt0 = k0 * __expf(fminf(ar0 - A0, 60.f)), kt1 = k1 * __expf(fminf(ar1 - A1, 60.f));
            const float kk0 = k0 * __expf(al0 - A0), kk1 = k1 * __expf(al1 - A1);
            *(LAS unsigned*)(lds + L_KT + j * PQ + 4 * l) = pk2(kt0, kt1);
            *(LAS unsigned*)(lds + L_V + j * PQ + 4 * l) = cur.v[t];
            if (OUT) { const float q0 = bflo(cur.q[t]) * __expf(fminf(A0 - ar0, 60.f)), q1 = bfhi(cur.q[t]) * __expf(fminf(A1 - ar1, 60.f));
                *(LAS unsigned*)(lds + L_QT + j * PQ + 4 * l) = pk2(q0, q1); }
            const unsigned kk = pk2(kk0, kk1);
            if (t & 1) { k2a[t >> 1] = (k2a[t >> 1] & 0xffffu) | (kk << 16); k2b[t >> 1] = (k2b[t >> 1] & 0xffffu) | (kk & 0xffff0000u); }
            else { k2a[t >> 1] = kk & 0xffffu; k2b[t >> 1] = kk >> 16; } }
        *(LAS u32x4*)(lds + L_K2T + (2 * l) * PK + 16 * w) = (u32x4){k2a[0], k2a[1], k2a[2], k2a[3]};
        *(LAS u32x4*)(lds + L_K2T + (2 * l + 1) * PK + 16 * w) = (u32x4){k2b[0], k2b[1], k2b[2], k2b[3]};
        if (w == 0) { *(LAS f32x2*)(lds + L_DVEC + 8 * l) = (f32x2){__expf(al0), __expf(al1)}; *(LAS f32x2*)(lds + L_EREF + 8 * l) = (f32x2){__expf(ar0), __expf(ar1)}; }
        lt0 += al0; lt1 += al1;
        __syncthreads();
        if (c + 1 < nch) hg_load<OUT>(p, nxt, dir, b, h, nbase + 64, w, l);
        if (OUT) { pc_step<false>(lds, w, li, g, L_KT, L_QT); __syncthreads(); }
        bf16x8 bv[2];
#pragma unroll
        for (int s = 0; s < 2; ++s) bv[s] = trB(lds, L_V + (32 * s + 8 * g + (li >> 2)) * PQ + (16 * w + 4 * (li & 3)) * 2);
        if (OUT) {
#pragma unroll
            for (int t = 0; t < 8; ++t) { const f32x4 er = *(const LAS f32x4*)(lds + L_EREF + (16 * t + 4 * g) * 4); const f32x4 sv = S[t] * er;
                u32x2 pw; pw.x = pk2(sv[0], sv[1]); pw.y = pk2(sv[2], sv[3]); *(LAS u32x2*)(lds + L_ST + (16 * w + li) * PQ + (16 * t + 4 * g) * 2) = pw; }
            bf16x8 bs[4];
#pragma unroll
            for (int s = 0; s < 4; ++s) bs[s] = ld8(lds, L_ST + (16 * w + li) * PQ + (32 * s + 8 * g) * 2);
#pragma unroll
            for (int it = 0; it < 4; ++it) { f32x4 acc = (f32x4){0.f, 0.f, 0.f, 0.f};
#pragma unroll
                for (int s = 0; s < 2; ++s) if (32 * s <= 16 * it + 15) acc = SC_MFMA(bv[s], ld8(lds, L_P + (16 * it + li) * PK + (32 * s + 8 * g) * 2), acc);
#pragma unroll
                for (int s = 0; s < 4; ++s) acc = SC_MFMA(bs[s], ld8(lds, L_QT + (16 * it + li) * PQ + (32 * s + 8 * g) * 2), acc);
                u32x2 pw; pw.x = pk2(acc[0], acc[1]); pw.y = pk2(acc[2], acc[3]); *(LAS u32x2*)(lds + L_O + (16 * it + li) * PQ + (16 * w + 4 * g) * 2) = pw; }
        }
#pragma unroll
        for (int t = 0; t < 8; ++t) { const f32x4 dv = *(const LAS f32x4*)(lds + L_DVEC + (16 * t + 4 * g) * 4); S[t] = S[t] * dv;
#pragma unroll
            for (int s = 0; s < 2; ++s) S[t] = SC_MFMA(ld8(lds, L_K2T + (16 * t + li) * PK + (32 * s + 8 * g) * 2), bv[s], S[t]); }
        __syncthreads();
        if (OUT) w_step(p, lds, tid, dir, b, nbase, h * 128);
        cur = nxt;
    }
}

struct MlIn { unsigned q[8], k[8], v[8]; float li, lf; };
template <bool OUT>
__device__ __forceinline__ void ml_load(const Params& p, MlIn& r, int dir, int b, int h, int nbase, int w, int l) {
    const unsigned char* ws = p.ws;
#pragma unroll
    for (int t = 0; t < 8; ++t) { const size_t row = (size_t)row_of(dir, b, nbase + 8 * w + t);
        r.k[t] = *(const unsigned*)((const bf16*)(ws + WS_QKC) + row * 1024 + 512 + h * 128 + 2 * l);
        r.v[t] = *(const unsigned*)((const bf16*)(ws + WS_MV) + row * 512 + h * 128 + 2 * l);
        if (OUT) r.q[t] = *(const unsigned*)((const bf16*)(ws + WS_QKC) + row * 1024 + h * 128 + 2 * l); else r.q[t] = 0u; }
    const float* gp = (const float*)(ws + WS_GATES) + (size_t)row_of(dir, b, nbase + l) * 16 + dir * 8 + h; r.li = gp[0]; r.lf = gp[4];
}
template <bool OUT>
__device__ __forceinline__ void ml_run(const Params& p, LAS unsigned char* lds, int dir, int b, int h, int n0, int nch, f32x4 (&S)[8], float& m_prev, float& btot) {
    const int tid = tid_opaque(), w = __builtin_amdgcn_readfirstlane(tid >> 6), l = tid & 63, li = l & 15, g = l >> 4;
    MlIn cur, nxt;
    ml_load<OUT>(p, cur, dir, b, h, n0, w, l);
    for (int c = 0; c < nch; ++c) {
        const int nbase = n0 + 64 * c;
        float bs_ = cur.lf;
#pragma unroll
        for (int o = 1; o < 64; o <<= 1) { const float t = __shfl_up(bs_, o); if (l >= o) bs_ += t; }
        const float gg = cur.li - bs_;
        float gm = gg;
#pragma unroll
        for (int o = 1; o < 64; o <<= 1) gm = fmaxf(gm, __shfl_xor(gm, o));
        const float G = fmaxf(m_prev, gm), s_in = __expf(m_prev - G), eg = __expf(gg - G), b63 = rdlane(bs_, 63);
        if (w == 0 && OUT) *(LAS float*)(lds + L_FL + 4 * l) = __expf(-(bs_ + G));
        float n0v = 0.f, n1v = 0.f;
        if (OUT) { const f32x2 nn = *(const LAS f32x2*)(lds + L_N + 8 * l); n0v = nn.x * s_in; n1v = nn.y * s_in; }
        float ks0 = 0.f, ks1 = 0.f; unsigned k2a[8], k2b[8];
#pragma unroll
        for (int t = 0; t < 8; ++t) { const int j = 8 * w + t; const float egj = rdlane(eg, j);
            const float kh0 = bflo(cur.k[t]) * egj, kh1 = bfhi(cur.k[t]) * egj; ks0 += kh0; ks1 += kh1;
            const unsigned kk = pk2(kh0, kh1);
            *(LAS unsigned*)(lds + L_V + j * PQ + 4 * l) = cur.v[t];
            if (OUT) { *(LAS unsigned*)(lds + L_KT + j * PQ + 4 * l) = kk; *(LAS unsigned*)(lds + L_QT + j * PQ + 4 * l) = cur.q[t];
                const float qd = wave_sum(bflo(cur.q[t]) * n0v + bfhi(cur.q[t]) * n1v); if (l == 0) *(LAS float*)(lds + L_DV + 4 * j) = qd; }
            if (t & 1) { k2a[t >> 1] = (k2a[t >> 1] & 0xffffu) | (kk << 16); k2b[t >> 1] = (k2b[t >> 1] & 0xffffu) | (kk & 0xffff0000u); }
            else { k2a[t >> 1] = kk & 0xffffu; k2b[t >> 1] = kk >> 16; } }
        *(LAS u32x4*)(lds + L_K2T + (2 * l) * PK + 16 * w) = (u32x4){k2a[0], k2a[1], k2a[2], k2a[3]};
        *(LAS u32x4*)(lds + L_K2T + (2 * l + 1) * PK + 16 * w) = (u32x4){k2b[0], k2b[1], k2b[2], k2b[3]};
        *(LAS f32x2*)(lds + L_TOT + (w * 128 + 2 * l) * 4) = (f32x2){ks0, ks1};
        __syncthreads();
        if (tid < 128) { float s = *(const LAS float*)(lds + L_N + 4 * tid) * s_in;
#pragma unroll
            for (int w2 = 0; w2 < 8; ++w2) s += *(const LAS float*)(lds + L_TOT + (w2 * 128 + tid) * 4);
            *(LAS float*)(lds + L_N + 4 * tid) = s; }
        if (c + 1 < nch) ml_load<OUT>(p, nxt, dir, b, h, nbase + 64, w, l);
        if (OUT) { pc_step<true>(lds, w, li, g, L_KT, L_QT); __syncthreads(); }
        bf16x8 bv[2];
#pragma unroll
        for (int s = 0; s < 2; ++s) bv[s] = trB(lds, L_V + (32 * s + 8 * g + (li >> 2)) * PQ + (16 * w + 4 * (li & 3)) * 2);
#pragma unroll
        for (int t = 0; t < 8; ++t) S[t] = S[t] * s_in;
        if (OUT) {
#pragma unroll
            for (int t = 0; t < 8; ++t) { u32x2 pw; pw.x = pk2(S[t][0], S[t][1]); pw.y = pk2(S[t][2], S[t][3]); *(LAS u32x2*)(lds + L_ST + (16 * w + li) * PQ + (16 * t + 4 * g) * 2) = pw; }
            bf16x8 bs[4];
#pragma unroll
            for (int s = 0; s < 4; ++s) bs[s] = ld8(lds, L_ST + (16 * w + li) * PQ + (32 * s + 8 * g) * 2);
#pragma unroll
            for (int it = 0; it < 4; ++it) { f32x4 acc = (f32x4){0.f, 0.f, 0.f, 0.f};
#pragma unroll
                for (int s = 0; s < 2; ++s) if (32 * s <= 16 * it + 15) acc = SC_MFMA(bv[s], ld8(lds, L_P + (16 * it + li) * PK + (32 * s + 8 * g) * 2), acc);
#pragma unroll
                for (int s = 0; s < 4; ++s) acc = SC_MFMA(bs[s], ld8(lds, L_QT + (16 * it + li) * PQ + (32 * s + 8 * g) * 2), acc);
                const int i = 16 * it + li; const float den = *(const LAS float*)(lds + L_DV + 4 * i), fl = *(const LAS float*)(lds + L_FL + 4 * i);
                const float rd = 1.0f / fmaxf(fabsf(den), fl); acc = acc * rd;
                u32x2 pw; pw.x = pk2(acc[0], acc[1]); pw.y = pk2(acc[2], acc[3]); *(LAS u32x2*)(lds + L_O + i * PQ + (16 * w + 4 * g) * 2) = pw; }
        }
#pragma unroll
        for (int t = 0; t < 8; ++t) {
#pragma unroll
            for (int s = 0; s < 2; ++s) S[t] = SC_MFMA(ld8(lds, L_K2T + (16 * t + li) * PK + (32 * s + 8 * g) * 2), bv[s], S[t]); }
        m_prev = b63 + G; btot += b63;
        __syncthreads();
        if (OUT) w_step(p, lds, tid, dir, b, nbase, 512 + h * 128);
        cur = nxt;
    }
}

__device__ __forceinline__ void pass_a(const Params& p, LAS unsigned char* lds, int item) {
    const int tid = tid_opaque(), w = __builtin_amdgcn_readfirstlane(tid >> 6), l = tid & 63;
    const int chain = item >> 2, sa = item & 3, type = chain >> 5, dir = (chain >> 4) & 1, b = (chain >> 2) & 3, h = chain & 3;
    const int n0 = sa == 0 ? 0 : CTX + (sa - 1) * 2048, nch = sa == 0 ? 4 : 32;
    float* rec = (float*)(p.ws + WS_SEG + (size_t)item * SEG_STRIDE);
    f32x4 S[8];
#pragma unroll
    for (int t = 0; t < 8; ++t) S[t] = (f32x4){0.f, 0.f, 0.f, 0.f};
    if (type == 0) { float lt0 = 0.f, lt1 = 0.f; hg_run<false>(p, lds, dir, b, h, n0, nch, S, lt0, lt1);
        save_tiles(rec, S, w, l); if (w == 0) *(f32x2*)(rec + 16384 + 2 * l) = (f32x2){lt0, lt1}; }
    else { float m_prev = -1.0e30f, btot = 0.f;
        if (tid < 128) *(LAS float*)(lds + L_N + 4 * tid) = 0.f;
        __syncthreads();
        ml_run<false>(p, lds, dir, b, h, n0, nch, S, m_prev, btot);
        save_tiles(rec, S, w, l); if (tid < 128) rec[16384 + tid] = *(const LAS float*)(lds + L_N + 4 * tid);
        if (tid == 0) { rec[16384 + 128] = m_prev; rec[16384 + 129] = btot; } }
    __syncthreads();
}
__device__ __forceinline__ void pass_b(const Params& p, LAS unsigned char* lds, int item) {
    const int tid = tid_opaque(), w = __builtin_amdgcn_readfirstlane(tid >> 6), l = tid & 63, g = l >> 4;
    const int chain = item >> 2, k = item & 3, type = chain >> 5, dir = (chain >> 4) & 1, b = (chain >> 2) & 3, h = chain & 3;
    const int n0 = CTX + k * 2048;
    for (int i = tid; i < 64 * PK / 4; i += NTHR) *(LAS unsigned*)(lds + L_P + 4 * i) = 0u;
    f32x4 S[8];
#pragma unroll
    for (int t = 0; t < 8; ++t) S[t] = (f32x4){0.f, 0.f, 0.f, 0.f};
    if (type == 0) {
        for (int j = 0; j <= k; ++j) { const float* rec = (const float*)(p.ws + WS_SEG + (size_t)(chain * 4 + j) * SEG_STRIDE);
#pragma unroll
            for (int t = 0; t < 8; ++t) { const f32x4 lt = *(const f32x4*)(rec + 16384 + 16 * t + 4 * g); const f32x4 u = *(const f32x4*)(rec + ((size_t)(w * 8 + t) * 64 + l) * 4);
                S[t][0] = S[t][0] * __expf(lt[0]) + u[0]; S[t][1] = S[t][1] * __expf(lt[1]) + u[1]; S[t][2] = S[t][2] * __expf(lt[2]) + u[2]; S[t][3] = S[t][3] * __expf(lt[3]) + u[3]; } }
        __syncthreads();
        float lt0 = 0.f, lt1 = 0.f; hg_run<true>(p, lds, dir, b, h, n0, 32, S, lt0, lt1);
    } else {
        float m_in = -1.0e30f, nacc = 0.f;
        for (int j = 0; j <= k; ++j) { const float* rec = (const float*)(p.ws + WS_SEG + (size_t)(chain * 4 + j) * SEG_STRIDE);
            const float m_loc = rec[16384 + 128], bj = rec[16384 + 129]; const float mn = fmaxf(bj + m_in, m_loc), sa_ = __expf(bj + m_in - mn), sb_ = __expf(m_loc - mn);
#pragma unroll
            for (int t = 0; t < 8; ++t) { const f32x4 u = *(const f32x4*)(rec + ((size_t)(w * 8 + t) * 64 + l) * 4); S[t] = S[t] * sa_ + u * sb_; }
            if (tid < 128) nacc = nacc * sa_ + rec[16384 + tid] * sb_;
            m_in = mn; }
        if (tid < 128) *(LAS float*)(lds + L_N + 4 * tid) = nacc;
        __syncthreads();
        float btot = 0.f; ml_run<true>(p, lds, dir, b, h, n0, 32, S, m_in, btot);
    }
    __syncthreads();
}
#undef SC_MFMA
}

__device__ __forceinline__ void phase_mixprep(const Params& p) {
    unsigned char* ws = p.ws;
    const int tid = tid_opaque(), lane = tid & 63, wave = tid >> 6;
    const int gw = blockIdx.x * NWAVES + wave, NGW = gridDim.x * NWAVES;
    for (int xr = gw; xr < R_X; xr += NGW) {
        const int b = xr / SEQ, t = xr % SEQ; const size_t row = (size_t)b * SROW + CTX + t;
        const bf16* of = (const bf16*)p.out + (size_t)xr * 1024 + lane * 16;
        const bf16* ob = (const bf16*)p.out + ((size_t)R_X + xr) * 1024 + lane * 16;
        float v[16];
#pragma unroll
        for (int q = 0; q < 2; ++q) { const u32x4 a = *(const u32x4*)(of + q * 8), c = *(const u32x4*)(ob + q * 8);
            v[q * 8 + 0] = bflo(a.x) + bflo(c.x); v[q * 8 + 1] = bfhi(a.x) + bfhi(c.x); v[q * 8 + 2] = bflo(a.y) + bflo(c.y); v[q * 8 + 3] = bfhi(a.y) + bfhi(c.y);
            v[q * 8 + 4] = bflo(a.z) + bflo(c.z); v[q * 8 + 5] = bfhi(a.z) + bfhi(c.z); v[q * 8 + 6] = bflo(a.w) + bflo(c.w); v[q * 8 + 7] = bfhi(a.w) + bfhi(c.w); }
        float s = 0.f;
#pragma unroll
        for (int e = 0; e < 16; ++e) s += v[e];
        s += __shfl_xor(s, 1); s += __shfl_xor(s, 2); s += __shfl_xor(s, 4);
        const bool ml = lane >= 32;
        const float mean = ml ? s * (1.0f / 128.0f) : 0.f;
        float q2 = 0.f;
#pragma unroll
        for (int e = 0; e < 16; ++e) { v[e] -= mean; q2 += v[e] * v[e]; }
        q2 += __shfl_xor(q2, 1); q2 += __shfl_xor(q2, 2); q2 += __shfl_xor(q2, 4);
        const float rstd = rsqrtf(q2 * (1.0f / 128.0f) + EPS);
        const int c0 = (lane & 31) * 16;
        const float* nw = (ml ? p.ml_norm_w : p.hg_norm_w) + c0;
        const bf16* gt = (const bf16*)(ws + (ml ? WS_MO : WS_HG)) + row * 512 + c0;
        const u32x4 g0 = *(const u32x4*)gt, g1 = *(const u32x4*)(gt + 8);
        float g[16] = {bflo(g0.x), bfhi(g0.x), bflo(g0.y), bfhi(g0.y), bflo(g0.z), bfhi(g0.z), bflo(g0.w), bfhi(g0.w),
                       bflo(g1.x), bfhi(g1.x), bflo(g1.y), bfhi(g1.y), bflo(g1.z), bfhi(g1.z), bflo(g1.w), bfhi(g1.w)};
#pragma unroll
        for (int e = 0; e < 16; ++e) v[e] = v[e] * rstd * nw[e] * g[e];
        u32x4 o0, o1; o0.x = pk2(v[0], v[1]); o0.y = pk2(v[2], v[3]); o0.z = pk2(v[4], v[5]); o0.w = pk2(v[6], v[7]);
        o1.x = pk2(v[8], v[9]); o1.y = pk2(v[10], v[11]); o1.z = pk2(v[12], v[13]); o1.w = pk2(v[14], v[15]);
        bf16* am = (bf16*)(ws + WS_AMIX2) + (size_t)xr * 1024 + lane * 16;
        *(u32x4*)am = o0; *(u32x4*)(am + 8) = o1;
    }
}

__device__ __forceinline__ void phase_vx(const Params& p, LAS unsigned char* lds) {
    unsigned char* ws = p.ws;
    const int tid = tid_opaque(), lane = tid & 63, wave = tid >> 6;
    LAS float* Lrw = (LAS float*)lds;
    LAS float* Lnw = Lrw + 16 * 1024;
    LAS float* Lsh = Lnw + 1024;
    LAS float* Lsc = Lsh + 4096;
    const float* mod = (const float*)(ws + WS_MOD);
    for (int i = tid; i < 16 * 1024; i += NTHR) Lrw[i] = ((const float*)(ws + WS_RWT))[i];
    for (int i = tid; i < 1024; i += NTHR) Lnw[i] = p.norm2_w[i];
    for (int i = tid; i < 4096; i += NTHR) { const int b = i >> 10, c = i & 1023; Lsh[i] = mod[(size_t)b * 6144 + 3072 + c]; Lsc[i] = mod[(size_t)b * 6144 + 4096 + c]; }
    __syncthreads();
    const int gw = blockIdx.x * NWAVES + wave, NGW = gridDim.x * NWAVES;
    for (int xr = gw; xr < R_X; xr += NGW) {
        const int b = xr / SEQ, t = xr % SEQ;
        const float* src = p.out + (size_t)xr * D;
        f32x4 v[4]; float ss = 0.f;
#pragma unroll
        for (int j = 0; j < 4; ++j) { v[j] = *(const f32x4*)(src + j * 256 + lane * 4); ss += (v[j].x * v[j].x + v[j].y * v[j].y) + (v[j].z * v[j].z + v[j].w * v[j].w); }
        const float rstd = rsqrtf(wave_sum(ss) * (1.0f / D) + EPS);
        bf16* vrow = (bf16*)(ws + WS_VX) + (size_t)xr * D;
#pragma unroll
        for (int j = 0; j < 4; ++j) { const int c0 = j * 256 + lane * 4;
            const f32x4 nw = *(const LAS f32x4*)(Lnw + c0), sc = *(const LAS f32x4*)(Lsc + b * 1024 + c0), sh = *(const LAS f32x4*)(Lsh + b * 1024 + c0);
            v[j] = v[j] * rstd * nw * (1.0f + sc) + sh;
            u32x2 w; w.x = pk2(v[j].x, v[j].y); w.y = pk2(v[j].z, v[j].w); *(u32x2*)(vrow + c0) = w; }
        float mine = 0.f;
#pragma unroll 2
        for (int g = 0; g < 16; ++g) { float a = 0.f;
#pragma unroll
            for (int j = 0; j < 4; ++j) { const f32x4 w = *(const LAS f32x4*)(Lrw + g * 1024 + j * 256 + lane * 4); a += (v[j].x * w.x + v[j].y * w.y) + (v[j].z * w.z + v[j].w * w.w); }
            a = wave_sum(a); if (lane == g) mine = a; }
        float mx = (lane < 16) ? mine : -3.0e38f;
        mx = fmaxf(mx, __shfl_xor(mx, 1)); mx = fmaxf(mx, __shfl_xor(mx, 2)); mx = fmaxf(mx, __shfl_xor(mx, 4)); mx = fmaxf(mx, __shfl_xor(mx, 8));
        mx = __shfl(mx, 0);
        float ex = (lane < 16) ? __expf(mine - mx) : 0.f;
        float sm = ex; sm += __shfl_xor(sm, 1); sm += __shfl_xor(sm, 2); sm += __shfl_xor(sm, 4); sm += __shfl_xor(sm, 8);
        sm = __shfl(sm, 0);
        if (lane < 16) ((float*)(ws + WS_AFF))[((size_t)b * 16 + lane) * SEQ + t] = ex / sm;
    }
}

__device__ __forceinline__ void phase_topk_naive(const Params& p, LAS unsigned char* lds) {
    unsigned char* ws = p.ws;
    const int tid = tid_opaque();
    LAS float* La = (LAS float*)lds;
    for (int item = blockIdx.x; item < 64 * 16; item += gridDim.x) {
        const int be = item >> 4, tb = item & 15, b = be >> 4, e = be & 15;
        const float* aff = (const float*)(ws + WS_AFF) + (size_t)be * SEQ;
        __syncthreads();
        for (int i = tid; i < SEQ / 4; i += NTHR) *(LAS f32x4*)(La + i * 4) = *(const f32x4*)(aff + i * 4);
        __syncthreads();
        const int t = tb * NTHR + tid; const float a = La[t];
        int rank = 0;
        for (int i = 0; i < SEQ; i += 4) { const f32x4 w = *(const LAS f32x4*)(La + i);
            rank += (w.x > a || (w.x == a && i < t)) ? 1 : 0; rank += (w.y > a || (w.y == a && i + 1 < t)) ? 1 : 0;
            rank += (w.z > a || (w.z == a && i + 2 < t)) ? 1 : 0; rank += (w.w > a || (w.w == a && i + 3 < t)) ? 1 : 0; }
        int slot = -1;
        if (rank < CAP) { slot = rank; const int mrow = (e * NB + b) * CAP + rank; ((int*)(ws + WS_ROWMAP))[mrow] = b * SEQ + t; ((float*)(ws + WS_GATEV))[mrow] = a; }
        ((int*)(ws + WS_SLOT))[((size_t)b * SEQ + t) * 16 + e] = slot;
    }
}

__device__ __forceinline__ void phase_final(const Params& p) {
    unsigned char* ws = p.ws;
    const int tid = tid_opaque(), lane = tid & 63, wave = tid >> 6;
    const int gw = blockIdx.x * NWAVES + wave, NGW = gridDim.x * NWAVES;
    const float* mod = (const float*)(ws + WS_MOD);
    for (int xr = gw; xr < R_X; xr += NGW) {
        const int b = xr / SEQ;
        float* row = p.out + (size_t)xr * D;
        f32x4 acc[4];
#pragma unroll
        for (int j = 0; j < 4; ++j) acc[j] = (f32x4){0.f, 0.f, 0.f, 0.f};
        const int myslot = (lane < 16) ? ((const int*)(ws + WS_SLOT))[(size_t)xr * 16 + lane] : -1;
        for (int e = 0; e < 16; ++e) { const int sl = __shfl(myslot, e); if (sl < 0) continue;
            const bf16* y = (const bf16*)(ws + WS_Y) + ((size_t)(e * NB + b) * CAP + sl) * D;
#pragma unroll
            for (int j = 0; j < 4; ++j) { const u32x2 w = *(const u32x2*)(y + j * 256 + lane * 4); acc[j].x += bflo(w.x); acc[j].y += bfhi(w.x); acc[j].z += bflo(w.y); acc[j].w += bfhi(w.y); } }
        f32x4 v[4]; float ss = 0.f;
#pragma unroll
        for (int j = 0; j < 4; ++j) { const int c0 = j * 256 + lane * 4; const f32x4 g2 = *(const f32x4*)(mod + (size_t)b * 6144 + 5120 + c0);
            v[j] = *(const f32x4*)(row + c0) + g2 * acc[j]; ss += (v[j].x * v[j].x + v[j].y * v[j].y) + (v[j].z * v[j].z + v[j].w * v[j].w); }
        const float rstd = rsqrtf(wave_sum(ss) * (1.0f / D) + EPS);
#pragma unroll
        for (int j = 0; j < 4; ++j) { const int c0 = j * 256 + lane * 4; const f32x4 fw = *(const f32x4*)(p.final_w + c0); *(f32x4*)(row + c0) = v[j] * rstd * fw; }
    }
}

#define XB_TMO      128
#define XB_XCNT(j)  (256  + 64 * (j))
#define XB_XSUB(j)  (1280 + 64 * (j))
#define XB_XGEN(j)  (2304 + 64 * (j))
#define XB_TOP      3328
#define XB_TOPGEN   3392
#define XCD_BAR_WORDS 3456
#define XB_SPIN_CAP (1u << 20)
__device__ __forceinline__ unsigned xb_ld(unsigned* p)              { return __hip_atomic_load(p, __ATOMIC_RELAXED, __HIP_MEMORY_SCOPE_AGENT); }
__device__ __forceinline__ unsigned xb_add(unsigned* p, unsigned v) { return __hip_atomic_fetch_add(p, v, __ATOMIC_RELAXED, __HIP_MEMORY_SCOPE_AGENT); }
__device__ __forceinline__ unsigned xb_xcc_id() { return (unsigned)__builtin_amdgcn_s_getreg((3 << 11) | 20) & 0xFu; }
#define XB_SPIN(cond, bar) do { unsigned _sp = 0; while (cond) { __builtin_amdgcn_s_sleep(1); \
    if ((++_sp & 255u) == 0u) { if (xb_ld(&(bar)[XB_TMO])) break; if (_sp > XB_SPIN_CAP) { atomicAdd(&(bar)[XB_TMO], 1u); break; } } } } while (0)
struct XcdBarrier { unsigned* bar; unsigned x; volatile LAS unsigned* st; };
__device__ __forceinline__ XcdBarrier xcd_barrier_post(unsigned* bar, volatile LAS unsigned* st) {
    XcdBarrier b; b.bar = bar; b.x = xb_xcc_id(); b.st = st;
    if (threadIdx.x == 0) (void)xb_add(&bar[XB_XCNT(b.x)], 1u);
    return b;
}
__device__ __forceinline__ void xcd_barrier_complete(unsigned* bar, unsigned x, unsigned& nloc, unsigned& nx) {
    const unsigned G = gridDim.x * gridDim.y * gridDim.z;
    unsigned sum, cnt, mine, sp = 0u;
    for (;;) {
        sum = 0u; cnt = 0u; mine = 0u;
#pragma unroll
        for (unsigned j = 0; j < 16; ++j) { const unsigned c = xb_ld(&bar[XB_XCNT(j)]); sum += c; cnt += (c > 0u) ? 1u : 0u; mine = (j == x) ? c : mine; }
        if (sum == G) break;
        __builtin_amdgcn_s_sleep(1);
        if ((++sp & 255u) == 0u) { if (xb_ld(&bar[XB_TMO])) break; if (sp > XB_SPIN_CAP) { atomicAdd(&bar[XB_TMO], 1u); break; } }
    }
    nloc = mine > 0u ? mine : 1u; nx = cnt > 0u ? cnt : 1u;
}
__device__ __forceinline__ void xcd_barrier(const XcdBarrier& b) {
    asm volatile("s_waitcnt vmcnt(0)" ::: "memory");
    __syncthreads();
    if (threadIdx.x == 0) {
        unsigned* bar = b.bar;
        __builtin_amdgcn_s_waitcnt(0);
        unsigned nloc = b.st[0], nx = b.st[1];
        if (nloc == 0u) { xcd_barrier_complete(bar, b.x, nloc, nx); b.st[0] = nloc; b.st[1] = nx; }
        const unsigned old = xb_add(&bar[XB_XSUB(b.x)], 1u);
        const unsigned gen = old / nloc;
        if (old + 1u == (gen + 1u) * nloc) {
            __builtin_amdgcn_fence(__ATOMIC_RELEASE, "agent");
            asm volatile("s_waitcnt vmcnt(0)" ::: "memory");
            const unsigned og = xb_add(&bar[XB_TOP], 1u);
            const unsigned tg = og / nx;
            if (og + 1u == (tg + 1u) * nx) xb_add(&bar[XB_TOPGEN], 1u);
            else XB_SPIN(xb_ld(&bar[XB_TOPGEN]) == tg, bar);
            __builtin_amdgcn_fence(__ATOMIC_ACQUIRE, "agent");
            xb_add(&bar[XB_XGEN(b.x)], 1u);
            asm volatile("s_waitcnt vmcnt(0)" ::: "memory");
        } else {
            XB_SPIN(xb_ld(&bar[XB_XGEN(b.x)]) == gen, bar);
            __builtin_amdgcn_fence(__ATOMIC_ACQUIRE, "agent");
            asm volatile("s_waitcnt vmcnt(0)" ::: "memory");
        }
    }
    __syncthreads();
}

constexpr int MISC_OFF = LDS_BYTES - 256;
constexpr int CW_BAR = 4096;
constexpr size_t CTL_ZERO_BYTES = 65536;

__global__ void __launch_bounds__(NTHR, 2) mega_fwd(Params p) {
    extern __shared__ __attribute__((aligned(16))) unsigned char lds_raw[];
    LAS unsigned char* lds = (LAS unsigned char*)lds_raw;
    for (int u = threadIdx.x; u < 64; u += NTHR) ((LAS unsigned*)(lds + MISC_OFF))[u] = 0u;
    __syncthreads();
    XcdBarrier bar = xcd_barrier_post((unsigned*)(p.ws + WS_CTL) + CW_BAR, (volatile LAS unsigned*)(lds + MISC_OFF) + 8);
#define GRID_BAR() xcd_barrier(bar)
    phase_prologue(p, lds);
    GRID_BAR();
    phase_u(p, lds);
    GRID_BAR();
    {   pg8::Gemm g{(const bf16*)(p.ws + WS_U), (const bf16*)(p.ws + WS_WIN_T), D, nullptr}; pg8::StaticOrder S; S.init(R_ALL, NPROJ, gridDim.x, blockIdx.x);
        pg8::EpiInProj E{p.ws, (const float*)(p.ws + WS_LB)};
        pg8::gemm_phase<pg8::EpiInProj, pg8::StaticOrder, true, false>(lds, g, S, E); }
    GRID_BAR();
    phase_conv(p);
    GRID_BAR();
    for (int item = blockIdx.x; item < 256; item += gridDim.x) sc::pass_a(p, lds, item);
    GRID_BAR();
    for (int item = blockIdx.x; item < 256; item += gridDim.x) sc::pass_b(p, lds, item);
    GRID_BAR();
    phase_mixprep(p);
    GRID_BAR();
    {   pg8::Gemm g{(const bf16*)(p.ws + WS_AMIX2), (const bf16*)(p.ws + WS_WOUT_T), D, nullptr}; pg8::StaticOrder S; S.init(R_X, D, gridDim.x, blockIdx.x);
        pg8::EpiOutProj E{p.x, p.out, (const float*)(p.ws + WS_MOD)};
        pg8::gemm_phase<pg8::EpiOutProj, pg8::StaticOrder, true, false>(lds, g, S, E); }
    GRID_BAR();
    phase_vx(p, lds);
    GRID_BAR();
    phase_topk_naive(p, lds);
    GRID_BAR();
    for (int w = blockIdx.x; w < 256; w += gridDim.x) {
        const int xcd = w & 7, idx = w >> 3, e = xcd * 2 + (idx >> 4), pm = e * 16 + (idx & 15);
        {   pg8::Gemm g{(const bf16*)(p.ws + WS_VX), (const bf16*)(p.ws + WS_WGU_T), D, (const int*)(p.ws + WS_ROWMAP)};
            pg8::PanelOrder S{pm, 8, (size_t)e * 2048 * 1024 * 2}; pg8::EpiMoE1 E{(bf16*)(p.ws + WS_H)};
            pg8::gemm_phase<pg8::EpiMoE1, pg8::PanelOrder, true, true>(lds, g, S, E); }
        VM_WAIT(); __syncthreads();
        if (threadIdx.x == 0) { __builtin_amdgcn_fence(__ATOMIC_ACQUIRE, "agent"); VM_WAIT(); }
        __syncthreads();
        {   pg8::Gemm g{(const bf16*)(p.ws + WS_H), (const bf16*)(p.ws + WS_WD_T), FF, nullptr};
            pg8::PanelOrder S{pm, 4, (size_t)e * 1024 * 1024 * 2}; pg8::EpiMoE2 E{(bf16*)(p.ws + WS_Y), (const float*)(p.ws + WS_GATEV)};
            pg8::gemm_phase<pg8::EpiMoE2, pg8::PanelOrder, true, false>(lds, g, S, E); }
    }
    GRID_BAR();
    phase_final(p);
}

extern "C" void kernel_launch(void* const* d_in, const int* in_sizes, int n_in, void* d_out, int out_size, void* d_ws, size_t ws_size, hipStream_t stream) {
    static int grid = 0;
    if (grid == 0) {
        if (n_in != 21 || out_size != R_X * D || ws_size < WS_END) { fprintf(stderr, "kernel_launch: unexpected shapes: n_in %d out %d ws %zu\n", n_in, out_size, ws_size); grid = -1; return; }
        int dev = 0, cus = 0, per_cu = 0;
        if (hipGetDevice(&dev) != hipSuccess || hipDeviceGetAttribute(&cus, hipDeviceAttributeMultiprocessorCount, dev) != hipSuccess) { grid = -1; return; }
        if (hipFuncSetAttribute((const void*)mega_fwd, hipFuncAttributeMaxDynamicSharedMemorySize, LDS_BYTES) != hipSuccess) { fprintf(stderr, "kernel_launch: hipFuncSetAttribute failed\n"); grid = -1; return; }
        if (hipOccupancyMaxActiveBlocksPerMultiprocessor(&per_cu, (const void*)mega_fwd, NTHR, LDS_BYTES) != hipSuccess || per_cu < 1) { fprintf(stderr, "kernel_launch: occupancy query says %d blocks/CU; nothing launched\n", per_cu); (void)hipGetLastError(); grid = -1; return; }
        grid = cus;
    }
    if (grid < 0) return;
    (void)hipMemsetAsync((char*)d_ws + WS_CTL, 0, CTL_ZERO_BYTES, stream);
    Params p{};
    const float** pp = (const float**)&p;
    for (int i = 0; i < 21; ++i) pp[i] = (const float*)d_in[i];
    p.out = (float*)d_out; p.ws = (unsigned char*)d_ws;
    hipLaunchKernelGGL(mega_fwd, dim3(grid), dim3(NTHR), LDS_BYTES, stream, p);
}
```

```cpp
#include <hip/hip_runtime.h>
#include <cstdio>
#include <cstdint>

#define GAS __attribute__((address_space(1)))
#define LAS __attribute__((address_space(3)))
typedef unsigned short bf16;
typedef float f32x4 __attribute__((ext_vector_type(4)));
typedef float f32x2 __attribute__((ext_vector_type(2)));
typedef unsigned u32x4 __attribute__((ext_vector_type(4)));
typedef unsigned u32x2 __attribute__((ext_vector_type(2)));
typedef short bf16x8 __attribute__((ext_vector_type(8)));
typedef __bf16 bf16x2_t __attribute__((ext_vector_type(2)));
typedef _Float16 f16x2_t __attribute__((ext_vector_type(2)));

constexpr int D = 1024, NB = 4, SEQ = 8192, CTX = 256, SROW = SEQ + CTX, R_ALL = NB * SROW, R_X = NB * SEQ;
constexpr int PROJ = 4624, NPROJ = 4608;
constexpr int NE = 16, CAP = 1024, FF = 1024, R_MOE = NE * NB * CAP;
constexpr float EPS = 1e-6f;
constexpr int NTHR = 512, NWAVES = 8;
constexpr int LDS_BYTES = 147456;

constexpr size_t MiB = 1u << 20;
constexpr size_t WS_CTL = 0;
constexpr size_t WS_MODP = 1 * MiB;
constexpr size_t WS_MOD = 3 * MiB;
constexpr size_t WS_LB = WS_MOD + 128 * 1024;
constexpr size_t WS_WGT = WS_LB + 4096;
constexpr size_t WS_RWT = WS_WGT + 65536;
constexpr size_t WS_WIN_T = 4 * MiB;
constexpr size_t WS_WOUT_T = 13 * MiB;
constexpr size_t WS_GATES = 15 * MiB;
constexpr size_t WS_WGU_T = 18 * MiB;
constexpr size_t WS_WD_T = 82 * MiB;
constexpr size_t WS_U = 114 * MiB;
constexpr size_t WS_HQ = 180 * MiB;
constexpr size_t WS_HV = 213 * MiB;
constexpr size_t WS_HG = 246 * MiB;
constexpr size_t WS_LF = 279 * MiB;
constexpr size_t WS_QK = 345 * MiB;
constexpr size_t WS_MV = 411 * MiB;
constexpr size_t WS_MO = 444 * MiB;
constexpr size_t WS_AFF = 477 * MiB;
constexpr size_t WS_ROWMAP = 479 * MiB;
constexpr size_t WS_GATEV = WS_ROWMAP + 262144;
constexpr size_t WS_SLOT = 480 * MiB;
constexpr size_t WS_SEG = 484 * MiB;
constexpr size_t WS_END = 512 * MiB;
constexpr size_t WS_QKC = WS_U;
constexpr size_t WS_AMIX2 = WS_LF;
constexpr size_t WS_VX = WS_U;
constexpr size_t WS_H = WS_HQ;
constexpr size_t WS_Y = 308 * MiB;

struct Params {
    const float *x, *c, *ctx, *c_ctx, *ada_w, *ada_b, *norm1_w, *w_in, *conv_w, *conv_b, *lb_logits, *ml_gate_b, *hg_norm_w, *ml_norm_w, *w_out, *norm2_w,
        *router_w, *wg, *wu, *wd, *final_w;
    float* out; unsigned char* ws;
};

__device__ __forceinline__ unsigned pk2(float lo, float hi) { f32x2 v = {lo, hi}; bf16x2_t b = __builtin_convertvector(v, bf16x2_t); return __builtin_bit_cast(unsigned, b); }
__device__ __forceinline__ unsigned pkh2(float lo, float hi) { f32x2 v = {lo, hi}; f16x2_t b = __builtin_convertvector(v, f16x2_t); return __builtin_bit_cast(unsigned, b); }
__device__ __forceinline__ float bf2f(unsigned short b) { return __uint_as_float((unsigned)b << 16); }
__device__ __forceinline__ float bflo(unsigned w) { return __uint_as_float(w << 16); }
__device__ __forceinline__ float bfhi(unsigned w) { return __uint_as_float(w & 0xffff0000u); }
__device__ __forceinline__ float h2f(unsigned short h) { return (float)__builtin_bit_cast(_Float16, h); }
__device__ __forceinline__ float sigmoid_(float x) { return 1.0f / (1.0f + __expf(-x)); }
__device__ __forceinline__ float silu_(float x) { return x * sigmoid_(x); }
__device__ __forceinline__ float wave_sum(float v) {
#pragma unroll
    for (int o = 1; o < 64; o <<= 1) v += __shfl_xor(v, o);
    return v;
}
__device__ __forceinline__ int tid_opaque() { int t = threadIdx.x; asm volatile("" : "+v"(t)); return t; }
__device__ __forceinline__ float butterfly16(const float (&a)[16], int lane) {
    const bool h5 = (lane & 32) != 0, h4 = (lane & 16) != 0, h3 = (lane & 8) != 0, h2 = (lane & 4) != 0;
    float b8[8], b4[4], b2[2];
#pragma unroll
    for (int e = 0; e < 8; ++e) { const float keep = h5 ? a[e + 8] : a[e], send = h5 ? a[e] : a[e + 8]; b8[e] = keep + __shfl_xor(send, 32); }
#pragma unroll
    for (int e = 0; e < 4; ++e) { const float keep = h4 ? b8[e + 4] : b8[e], send = h4 ? b8[e] : b8[e + 4]; b4[e] = keep + __shfl_xor(send, 16); }
#pragma unroll
    for (int e = 0; e < 2; ++e) { const float keep = h3 ? b4[e + 2] : b4[e], send = h3 ? b4[e] : b4[e + 2]; b2[e] = keep + __shfl_xor(send, 8); }
    const float keep = h2 ? b2[1] : b2[0], send = h2 ? b2[0] : b2[1];
    float r = keep + __shfl_xor(send, 4);
    r += __shfl_xor(r, 2); r += __shfl_xor(r, 1);
    return r;
}
#define LDS_WAIT() asm volatile("s_waitcnt lgkmcnt(0)" ::: "memory")
#define VM_WAIT() asm volatile("s_waitcnt vmcnt(0)" ::: "memory")

namespace pg8 {
constexpr int BM = 256, BK = 64, HALF = 128, HTB = HALF * BK * 2, STAGE_BYTES = 8 * HTB, NXCD = 8, WGM = 8;
__host__ __device__ __forceinline__ int lds_byte(int r, int c) { const int st = (r >> 4) * 2 + (c >> 5), rr = r & 15, cc = c & 31, ob = rr * 64 + cc * 2; return st * 1024 + (ob ^ (((ob >> 9) & 1) << 5)); }
__host__ __device__ __forceinline__ void stage_rc(int b, int& R, int& C) { const int st = b / 1024, sb = b % 1024, swz = sb ^ (((sb >> 9) & 1) << 5); R = (st >> 1) * 16 + swz / 64; C = (st & 1) * 32 + (swz % 64) / 2; }
__host__ __device__ __forceinline__ int perm32(int rho) { const int n = rho >> 4, i = rho & 15; return 8 * (i >> 2) + 4 * n + (i & 3); }

struct Unit { int pm, pn; size_t boff; };
struct Gemm { const bf16* A; const bf16* Bt; int K; const int* rowmap; };

struct StaticOrder {
    int nM, nN, nwg, G, c;
    __device__ void init(int M, int N, int G_, int c_) { nM = M / BM; nN = N / BM; nwg = nM * nN; G = G_; c = c_; }
    __device__ bool next(int i, Unit& u) const {
        const long L = (long)i * G + c; if (L >= nwg) return false;
        int wgid = (int)L; { const int q = nwg / NXCD, r = nwg % NXCD, xcd = wgid % NXCD, off = wgid / NXCD; wgid = (xcd < r ? xcd * (q + 1) : r * (q + 1) + (xcd - r) * q) + off; }
        const int nig = WGM * nN, gid = wgid / nig, fm = gid * WGM, gsz = (nM - fm) < WGM ? (nM - fm) : WGM;
        u.pm = fm + ((wgid % nig) % gsz); u.pn = (wgid % nig) / gsz; u.boff = 0; return true;
    }
};
struct PanelOrder {
    int pm, npn; size_t boff;
    __device__ bool next(int i, Unit& u) const { if (i >= npn) return false; u.pm = pm; u.pn = i; u.boff = boff; return true; }
};

template <class Epi, class Sched, bool ALIGN_EPI, bool GATHER>
__device__ __forceinline__ void gemm_phase(LAS unsigned char* lds, const Gemm g, const Sched& S, const Epi& E) {
    const int tid = tid_opaque(), wid = __builtin_amdgcn_readfirstlane(tid >> 6), lane = tid & 63, wr = wid >> 2, wc = wid & 3, fr = lane & 15, fq = lane >> 4;
    const int K = g.K, nt = K / BK;
    Unit cur, nxt; int ui = 0;
    if (!S.next(0, cur)) return;
    const size_t kstep = (size_t)(BK * 2);
    const size_t hstep = (size_t)HALF * K * 2;
    const size_t tstep = 2 * hstep;
    unsigned voffA[2][2], voffB[2];
#pragma unroll
    for (int i = 0; i < 2; ++i) { int R, C; stage_rc(tid * 16 + i * 8192, R, C); const int Rb = Epi::PERM ? ((R & ~31) + perm32(R & 31)) : R;
        voffB[i] = (unsigned)(Rb * K + C) * 2u;
#pragma unroll
        for (int h = 0; h < 2; ++h) {
            if (GATHER) voffA[h][i] = (unsigned)g.rowmap[cur.pm * BM + h * HALF + R] * (unsigned)(K * 2) + (unsigned)C * 2u;
            else voffA[h][i] = (unsigned)(R * K + C) * 2u + (unsigned)(h * hstep);
        } }
    const unsigned ldsw = (unsigned)wid * 1024u;
    const int aoff = lds_byte(wr * 64 + fr, fq * 8), boff = lds_byte(wc * 32 + fr, fq * 8);
#define PG8_SA(b, h) (((b) * 2 + (h)) * HTB)
#define PG8_SB(b, h) ((4 + (b) * 2 + (h)) * HTB)
#define PG8_STAGE_A(bufoff, gbase, h) do { _Pragma("unroll") for (int _i = 0; _i < 2; ++_i) \
        __builtin_amdgcn_global_load_lds((const unsigned*)((const char*)(gbase) + voffA[h][_i]), (LAS unsigned*)(lds + (bufoff) + ldsw + _i * 8192), 16, 0, 0); } while (0)
#define PG8_STAGE_B(bufoff, gbase) do { _Pragma("unroll") for (int _i = 0; _i < 2; ++_i) \
        __builtin_amdgcn_global_load_lds((const unsigned*)((const char*)(gbase) + voffB[_i]), (LAS unsigned*)(lds + (bufoff) + ldsw + _i * 8192), 16, 0, 0); } while (0)
#define PG8_LDA(dst, b, h) do { _Pragma("unroll") for (int m = 0; m < 4; ++m) _Pragma("unroll") for (int k = 0; k < 2; ++k) dst[m][k] = *(const LAS bf16x8*)(lds + PG8_SA(b, h) + aoff + m * 2048 + k * 1024); } while (0)
#define PG8_LDB(dst, b, h) do { _Pragma("unroll") for (int n = 0; n < 2; ++n) _Pragma("unroll") for (int k = 0; k < 2; ++k) dst[n][k] = *(const LAS bf16x8*)(lds + PG8_SB(b, h) + boff + n * 2048 + k * 1024); } while (0)
#define PG8_MMA(ai, bj, At, Bt) do { __builtin_amdgcn_s_setprio(1); _Pragma("unroll") for (int m = 0; m < 4; ++m) _Pragma("unroll") for (int n = 0; n < 2; ++n) _Pragma("unroll") for (int k = 0; k < 2; ++k) \
        acc[ai][bj][m][n] = __builtin_amdgcn_mfma_f32_16x16x32_bf16(Bt[n][k], At[m][k], acc[ai][bj][m][n], 0, 0, 0); __builtin_amdgcn_s_setprio(0); } while (0)
#define PG8_WAIT_V(n) asm volatile("s_waitcnt vmcnt(" #n ")" ::: "memory")
#define PG8_WAIT_L(n) asm volatile("s_waitcnt lgkmcnt(" #n ")" ::: "memory")
#define PG8_BAR __builtin_amdgcn_s_barrier()
#define PG8_SCHED __builtin_amdgcn_sched_barrier(0)
    f32x4 acc[2][2][4][2];
#pragma unroll
    for (int a = 0; a < 2; ++a)
#pragma unroll
        for (int b = 0; b < 2; ++b)
#pragma unroll
            for (int m = 0; m < 4; ++m)
#pragma unroll
                for (int n = 0; n < 2; ++n) acc[a][b][m][n] = (f32x4){0.f, 0.f, 0.f, 0.f};
    bf16x8 At[4][2], B0[2][2], B1[2][2];
    const char* cA = GATHER ? (const char*)g.A : (const char*)g.A + (size_t)cur.pm * tstep;
    const char* cB = (const char*)g.Bt + cur.boff + (size_t)cur.pn * tstep;
    if (GATHER) VM_WAIT();
    PG8_STAGE_B(PG8_SB(0, 0), cB); PG8_STAGE_B(PG8_SB(0, 1), cB + hstep); PG8_STAGE_A(PG8_SA(0, 0), cA, 0); PG8_STAGE_A(PG8_SA(0, 1), cA, 1);
    if (wr == 1) PG8_BAR;
    PG8_WAIT_V(2); PG8_BAR;
    PG8_STAGE_B(PG8_SB(1, 0), cB + kstep); PG8_STAGE_A(PG8_SA(1, 0), cA + kstep, 0); PG8_STAGE_B(PG8_SB(1, 1), cB + hstep + kstep);
    PG8_WAIT_V(6); PG8_BAR;
    for (;;) {
        const bool has_next = S.next(ui + 1, nxt);
        const char* nA = has_next ? (GATHER ? (const char*)g.A : (const char*)g.A + (size_t)nxt.pm * tstep) : cA;
        const char* nB = has_next ? (const char*)g.Bt + nxt.boff + (size_t)nxt.pn * tstep : cB;
        for (int t = 0; t < nt; t += 2) {
            const bool last = (t == nt - 2);
            const char* a1 = cA + (size_t)(t + 1) * kstep;
            const char* a2 = last ? nA : cA + (size_t)(t + 2) * kstep; const char* b2 = last ? nB : cB + (size_t)(t + 2) * kstep;
            const char* a3 = a2 + kstep; const char* b3 = b2 + kstep;
            PG8_LDB(B0, 0, 0); PG8_LDB(B1, 0, 1); PG8_SCHED; PG8_LDA(At, 0, 0); PG8_STAGE_A(PG8_SA(1, 1), a1, 1);
            PG8_WAIT_V(8); PG8_WAIT_L(0); PG8_BAR; PG8_MMA(0, 0, At, B0); PG8_MMA(0, 1, At, B1); PG8_BAR; PG8_SCHED;
            PG8_LDA(At, 0, 1); PG8_STAGE_B(PG8_SB(0, 0), b2); PG8_STAGE_B(PG8_SB(0, 1), b2 + hstep); PG8_STAGE_A(PG8_SA(0, 0), a2, 0);
            PG8_WAIT_V(8); PG8_WAIT_L(0); PG8_BAR; PG8_MMA(1, 0, At, B0); PG8_MMA(1, 1, At, B1); PG8_BAR; PG8_SCHED;
            PG8_LDB(B0, 1, 0); PG8_LDB(B1, 1, 1); PG8_SCHED; PG8_LDA(At, 1, 0); PG8_STAGE_A(PG8_SA(0, 1), a2, 1);
            PG8_WAIT_V(8); PG8_WAIT_L(0); PG8_BAR; PG8_MMA(0, 0, At, B0); PG8_MMA(0, 1, At, B1); PG8_BAR; PG8_SCHED;
            PG8_LDA(At, 1, 1); PG8_STAGE_B(PG8_SB(1, 0), b3); PG8_STAGE_B(PG8_SB(1, 1), b3 + hstep); PG8_STAGE_A(PG8_SA(1, 0), a3, 0);
            PG8_WAIT_V(8); PG8_WAIT_L(0); PG8_BAR; PG8_MMA(1, 0, At, B0); PG8_MMA(1, 1, At, B1); PG8_BAR; PG8_SCHED;
        }
        if constexpr (ALIGN_EPI) { if (wr == 0) PG8_BAR; }
        E(acc, cur, wr, wc, fr, fq);
        if (!has_next) break;
#pragma unroll
        for (int a = 0; a < 2; ++a)
#pragma unroll
            for (int b = 0; b < 2; ++b)
#pragma unroll
                for (int m = 0; m < 4; ++m)
#pragma unroll
                    for (int n = 0; n < 2; ++n) acc[a][b][m][n] = (f32x4){0.f, 0.f, 0.f, 0.f};
        cur = nxt; cA = nA; cB = nB; ++ui;
        if constexpr (ALIGN_EPI) { if (wr == 1) PG8_BAR; }
    }
    PG8_WAIT_V(0);
    if constexpr (!ALIGN_EPI) { if (wr == 0) PG8_BAR; }
    PG8_BAR;
#undef PG8_SA
#undef PG8_SB
#undef PG8_STAGE_A
#undef PG8_STAGE_B
#undef PG8_LDA
#undef PG8_LDB
#undef PG8_MMA
#undef PG8_WAIT_V
#undef PG8_WAIT_L
#undef PG8_BAR
#undef PG8_SCHED
}

struct EpiInProj {
    static constexpr bool PERM = true;
    unsigned char* ws; const float* lb;
    __device__ __forceinline__ void operator()(const f32x4 (&acc)[2][2][4][2], const Unit& u, int wr, int wc, int fr_, int fq) const {
        int fr = fr_; asm volatile("" : "+v"(fr));
        const int pn = u.pn; size_t base; int ld, colbase, act;
        if (pn < 2) { base = WS_HQ; ld = 512; colbase = pn * 256; act = 1; }
        else if (pn < 4) { base = WS_HV; ld = 512; colbase = (pn - 2) * 256; act = 0; }
        else if (pn < 6) { base = WS_HG; ld = 512; colbase = (pn - 4) * 256; act = 1; }
        else if (pn < 10) { base = WS_LF; ld = 1024; colbase = (pn - 6) * 256; act = 3; }
        else if (pn < 14) { base = WS_QK; ld = 1024; colbase = (pn - 10) * 256; act = 0; }
        else if (pn < 16) { base = WS_MV; ld = 512; colbase = (pn - 14) * 256; act = 0; }
        else { base = WS_MO; ld = 512; colbase = (pn - 16) * 256; act = 2; }
        bf16* O = (bf16*)(ws + base);
        const int row0 = u.pm * BM + wr * 64 + fr, col0 = colbase + wc * 32 + 8 * fq;
#pragma unroll
        for (int bj = 0; bj < 2; ++bj) {
            float lbv[8];
            if (act == 3) {
#pragma unroll
                for (int e = 0; e < 8; ++e) lbv[e] = lb[col0 + bj * HALF + e];
            }
#pragma unroll
            for (int ai = 0; ai < 2; ++ai)
#pragma unroll
                for (int m = 0; m < 4; ++m) {
                    float v[8];
#pragma unroll
                    for (int e = 0; e < 4; ++e) { v[e] = acc[ai][bj][m][0][e]; v[4 + e] = acc[ai][bj][m][1][e]; }
                    u32x4 w;
                    if (act == 3) {
#pragma unroll
                        for (int e = 0; e < 8; ++e) v[e] = __logf(lbv[e] + (1.0f - lbv[e]) * sigmoid_(v[e]));
                        w.x = pkh2(v[0], v[1]); w.y = pkh2(v[2], v[3]); w.z = pkh2(v[4], v[5]); w.w = pkh2(v[6], v[7]);
                    } else {
                        if (act == 1) {
#pragma unroll
                            for (int e = 0; e < 8; ++e) v[e] = silu_(v[e]);
                        } else if (act == 2) {
#pragma unroll
                            for (int e = 0; e < 8; ++e) v[e] = sigmoid_(v[e]);
                        }
                        w.x = pk2(v[0], v[1]); w.y = pk2(v[2], v[3]); w.z = pk2(v[4], v[5]); w.w = pk2(v[6], v[7]);
                    }
                    *(u32x4*)(O + (size_t)(row0 + ai * HALF + m * 16) * ld + col0 + bj * HALF) = w;
                }
        }
    }
};
struct EpiOutProj {
    static constexpr bool PERM = false;
    const float* x; float* out; const float* mod;
    __device__ __forceinline__ void operator()(const f32x4 (&acc)[2][2][4][2], const Unit& u, int wr, int wc, int fr_, int fq) const {
        int fr = fr_; asm volatile("" : "+v"(fr));
        const int row0 = u.pm * BM + wr * 64 + fr, col0 = u.pn * BM + wc * 32 + 4 * fq;
        const float* g1 = mod + (size_t)(u.pm / 32) * 6144 + 2048;
#pragma unroll
        for (int bj = 0; bj < 2; ++bj)
#pragma unroll
            for (int n = 0; n < 2; ++n) {
                const int c = col0 + bj * HALF + n * 16; const f32x4 gv = *(const f32x4*)(g1 + c);
#pragma unroll
                for (int ai = 0; ai < 2; ++ai)
#pragma unroll
                    for (int m = 0; m < 4; ++m) { const size_t off = (size_t)(row0 + ai * HALF + m * 16) * D + c;
                        *(f32x4*)(out + off) = *(const f32x4*)(x + off) + gv * acc[ai][bj][m][n]; }
            }
    }
};
struct EpiMoE1 {
    static constexpr bool PERM = true;
    bf16* H;
    __device__ __forceinline__ void operator()(const f32x4 (&acc)[2][2][4][2], const Unit& u, int wr, int wc, int fr_, int fq) const {
        int fr = fr_; asm volatile("" : "+v"(fr));
        const int row0 = u.pm * BM + wr * 64 + fr, col0 = u.pn * HALF + wc * 32 + 8 * fq;
#pragma unroll
        for (int ai = 0; ai < 2; ++ai)
#pragma unroll
            for (int m = 0; m < 4; ++m) {
                float v[8];
#pragma unroll
                for (int e = 0; e < 4; ++e) { v[e] = silu_(acc[ai][0][m][0][e]) * acc[ai][1][m][0][e]; v[4 + e] = silu_(acc[ai][0][m][1][e]) * acc[ai][1][m][1][e]; }
                u32x4 w; w.x = pk2(v[0], v[1]); w.y = pk2(v[2], v[3]); w.z = pk2(v[4], v[5]); w.w = pk2(v[6], v[7]);
                *(u32x4*)(H + (size_t)(row0 + ai * HALF + m * 16) * FF + col0) = w;
            }
    }
};
struct EpiMoE2 {
    static constexpr bool PERM = true;
    bf16* Y; const float* gatev;
    __device__ __forceinline__ void operator()(const f32x4 (&acc)[2][2][4][2], const Unit& u, int wr, int wc, int fr_, int fq) const {
        int fr = fr_; asm volatile("" : "+v"(fr));
        const int row0 = u.pm * BM + wr * 64 + fr, col0 = u.pn * BM + wc * 32 + 8 * fq;
#pragma unroll
        for (int ai = 0; ai < 2; ++ai)
#pragma unroll
            for (int m = 0; m < 4; ++m) { const int row = row0 + ai * HALF + m * 16; const float gt = gatev[row];
#pragma unroll
                for (int bj = 0; bj < 2; ++bj) { const f32x4 a = acc[ai][bj][m][0] * gt, b = acc[ai][bj][m][1] * gt;
                    u32x4 w; w.x = pk2(a[0], a[1]); w.y = pk2(a[2], a[3]); w.z = pk2(b[0], b[1]); w.w = pk2(b[2], b[3]);
                    *(u32x4*)(Y + (size_t)row * D + col0 + bj * HALF) = w; } }
    }
};
}

__device__ __forceinline__ void transpose_item(const float* W, int ldw, int k0, int n0, bf16* dst_row0, LAS float* scr, int lane) {
#pragma unroll 8
    for (int i = 0; i < 32; ++i) { const int kk = 2 * i + (lane >> 5); scr[kk * 33 + (lane & 31)] = W[(size_t)(k0 + kk) * ldw + n0 + (lane & 31)]; }
    LDS_WAIT(); asm volatile("" ::: "memory");
    const int c = lane & 7;
#pragma unroll
    for (int j = 0; j < 4; ++j) { const int n = (lane >> 3) + 8 * j; const LAS float* s = scr + (8 * c) * 33 + n;
        u32x4 o; o.x = pk2(s[0 * 33], s[1 * 33]); o.y = pk2(s[2 * 33], s[3 * 33]); o.z = pk2(s[4 * 33], s[5 * 33]); o.w = pk2(s[6 * 33], s[7 * 33]);
        *(u32x4*)(dst_row0 + (size_t)n * 1024 + k0 + 8 * c) = o; }
    LDS_WAIT(); asm volatile("" ::: "memory");
}
__device__ __forceinline__ void phase_prologue(const Params& p, LAS unsigned char* lds) {
    const int tid = tid_opaque(), lane = tid & 63, wave = tid >> 6;
    const int gw = blockIdx.x * NWAVES + wave, NGW = gridDim.x * NWAVES;
    LAS float* scr = (LAS float*)(lds + wave * 16384);
    constexpr int I_IN = 16 * 144, I_OUT = 16 * 32, I_E = 16 * 512, I_MOD = 24 * 16;
    constexpr int NITEMS = I_IN + I_OUT + 3 * I_E + I_MOD;
    unsigned char* ws = p.ws;
    for (int it = gw; it < NITEMS; it += NGW) {
        int r = it;
        if (r < I_IN) { const int kb = r / 144, nb = r % 144; transpose_item(p.w_in, PROJ, kb * 64, nb * 32, (bf16*)(ws + WS_WIN_T) + (size_t)(nb * 32) * 1024, scr, lane); continue; } r -= I_IN;
        if (r < I_OUT) { const int kb = r / 32, nb = r % 32; transpose_item(p.w_out, D, kb * 64, nb * 32, (bf16*)(ws + WS_WOUT_T) + (size_t)(nb * 32) * 1024, scr, lane); continue; } r -= I_OUT;
        if (r < 2 * I_E) { const int up = r / I_E; r -= up * I_E; const int e = r / 512, q = r % 512, kb = q / 32, nb = q % 32, n0 = nb * 32;
            const int drow = (n0 / 128) * 256 + up * 128 + (n0 % 128);
            transpose_item((up ? p.wu : p.wg) + (size_t)e * D * FF, FF, kb * 64, n0, (bf16*)(ws + WS_WGU_T) + ((size_t)e * 2048 + drow) * 1024, scr, lane); continue; } r -= 2 * I_E;
        if (r < I_E) { const int e = r / 512, q = r % 512, kb = q / 32, nb = q % 32;
            transpose_item(p.wd + (size_t)e * FF * D, D, kb * 64, nb * 32, (bf16*)(ws + WS_WD_T) + ((size_t)e * 1024 + nb * 32) * 1024, scr, lane); continue; } r -= I_E;
        {
            const int cb = r / 16, ks = r % 16; const int col = cb * 256 + lane * 4;
            f32x4 a[5];
            float sv[5];
#pragma unroll
            for (int q = 0; q < 5; ++q) { a[q] = (f32x4){0.f, 0.f, 0.f, 0.f}; const float cv = (q < 4) ? p.c[q * D + ks * 64 + lane] : p.c_ctx[ks * 64 + lane]; sv[q] = silu_(cv); }
#pragma unroll 8
            for (int kk = 0; kk < 64; ++kk) {
                const f32x4 w = *(const f32x4*)(p.ada_w + (size_t)(ks * 64 + kk) * 6144 + col);
#pragma unroll
                for (int q = 0; q < 5; ++q) a[q] += w * __uint_as_float((unsigned)__builtin_amdgcn_readlane((int)__float_as_uint(sv[q]), kk));
            }
            float* mp = (float*)(ws + WS_MODP);
#pragma unroll
            for (int q = 0; q < 5; ++q) *(f32x4*)(mp + ((size_t)ks * 5 + q) * 6144 + col) = a[q];
        }
    }
    const int gt = blockIdx.x * NTHR + tid, NGT = gridDim.x * NTHR;
    for (int i = gt; i < 1024; i += NGT) { const float l0 = p.lb_logits[i], l1 = p.lb_logits[1024 + i]; ((float*)(ws + WS_LB))[i] = 1.0f / (1.0f + __expf(l1 - l0)); }
    for (int i = gt; i < 16 * 1024; i += NGT) { const int g = i >> 10, k = i & 1023; ((float*)(ws + WS_WGT))[i] = p.w_in[(size_t)k * PROJ + NPROJ + g]; ((float*)(ws + WS_RWT))[i] = p.router_w[k * 16 + g]; }
}

__device__ __forceinline__ void phase_u(const Params& p, LAS unsigned char* lds) {
    const int tid = tid_opaque(), lane = tid & 63, wave = tid >> 6;
    unsigned char* ws = p.ws;
    LAS float* Lsh = (LAS float*)lds;
    LAS float* Lsc = Lsh + 5 * 1024;
    LAS float* Lnw = Lsc + 5 * 1024;
    LAS float* Lwg = Lnw + 1024;
    const float* modp = (const float*)(ws + WS_MODP);
    for (int idx = tid; idx < 5 * 2048; idx += NTHR) { const int r = idx / 2048, col = idx % 2048; float s = p.ada_b[col];
        for (int ks = 0; ks < 16; ++ks) s += modp[((size_t)ks * 5 + r) * 6144 + col];
        if (col < 1024) Lsh[r * 1024 + col] = s; else Lsc[r * 1024 + col - 1024] = s; }
    for (int e = blockIdx.x * NTHR + tid; e < 5 * 6144; e += gridDim.x * NTHR) { const int r = e / 6144, col = e % 6144; float s = p.ada_b[col];
        for (int ks = 0; ks < 16; ++ks) s += modp[((size_t)ks * 5 + r) * 6144 + col];
        ((float*)(ws + WS_MOD))[e] = s; }
    for (int i = tid; i < 1024; i += NTHR) Lnw[i] = p.norm1_w[i];
    for (int i = tid; i < 16 * 1024; i += NTHR) Lwg[i] = ((const float*)(ws + WS_WGT))[i];
    __syncthreads();
    const int gw = blockIdx.x * NWAVES + wave, NGW = gridDim.x * NWAVES;
    for (int row = gw; row < R_ALL; row += NGW) {
        const int b = row / SROW, s = row % SROW;
        const float* src = (s < CTX) ? p.ctx + ((size_t)b * CTX + s) * D : p.x + ((size_t)b * SEQ + (s - CTX)) * D;
        const int r = (s < CTX) ? 4 : b;
        f32x4 v[4]; float ss = 0.f;
#pragma unroll
        for (int j = 0; j < 4; ++j) { v[j] = *(const f32x4*)(src + j * 256 + lane * 4); ss += (v[j].x * v[j].x + v[j].y * v[j].y) + (v[j].z * v[j].z + v[j].w * v[j].w); }
        const float rstd = rsqrtf(wave_sum(ss) * (1.0f / D) + EPS);
        bf16* urow = (bf16*)(ws + WS_U) + (size_t)row * D;
#pragma unroll
        for (int j = 0; j < 4; ++j) { const int c0 = j * 256 + lane * 4;
            const f32x4 nw = *(const LAS f32x4*)(Lnw + c0), sc = *(const LAS f32x4*)(Lsc + r * 1024 + c0), sh = *(const LAS f32x4*)(Lsh + r * 1024 + c0);
            v[j] = v[j] * rstd * nw * (1.0f + sc) + sh;
            u32x2 w; w.x = pk2(v[j].x, v[j].y); w.y = pk2(v[j].z, v[j].w); *(u32x2*)(urow + c0) = w; }
        float pa[16];
#pragma unroll
        for (int g = 0; g < 16; ++g) { float a = 0.f;
#pragma unroll
            for (int j = 0; j < 4; ++j) { const f32x4 w = *(const LAS f32x4*)(Lwg + g * 1024 + j * 256 + lane * 4); a += (v[j].x * w.x + v[j].y * w.y) + (v[j].z * w.z + v[j].w * w.w); }
            pa[g] = a; if (g & 1) __builtin_amdgcn_sched_barrier(0); }
        const float mine = butterfly16(pa, lane);
        if ((lane & 3) == 0) { const int gi = lane >> 2; float gv = mine + p.ml_gate_b[gi];
            if ((gi >> 2) & 1) gv = fminf(gv, 0.f) - log1pf(__expf(-fabsf(gv)));
            ((float*)(ws + WS_GATES))[(size_t)row * 16 + gi] = gv; }
    }
}

__device__ __forceinline__ void phase_conv(const Params& p) {
    unsigned char* ws = p.ws;
    const bf16* QK = (const bf16*)(ws + WS_QK); bf16* QKC = (bf16*)(ws + WS_QKC);
    const long total = (long)R_ALL * 128;
    const int tid0 = tid_opaque();
    for (long it = (long)blockIdx.x * NTHR + tid0; it < total; it += (long)gridDim.x * NTHR) {
        const int row = (int)(it >> 7), ch = (int)(it & 127) * 8;
        const int b = row / SROW, s = row % SROW;
        float a[8];
#pragma unroll
        for (int e = 0; e < 8; ++e) a[e] = p.conv_b[ch + e];
        if (s < CTX) {
#pragma unroll
            for (int j = 0; j < 3; ++j) { const int s2 = s + j - 1; if (s2 < 0 || s2 >= CTX) continue;
                const u32x4 w = *(const u32x4*)(QK + ((size_t)b * SROW + s2) * 1024 + ch); const float* cw = p.conv_w + (size_t)(3 + j) * 1024 + ch;
                a[0] += bflo(w.x) * cw[0]; a[1] += bfhi(w.x) * cw[1]; a[2] += bflo(w.y) * cw[2]; a[3] += bfhi(w.y) * cw[3];
                a[4] += bflo(w.z) * cw[4]; a[5] += bfhi(w.z) * cw[5]; a[6] += bflo(w.w) * cw[6]; a[7] += bfhi(w.w) * cw[7]; }
        } else {
            const int t = s - CTX, gr = t >> 6, gc = t & 63;
#pragma unroll
            for (int i = 0; i < 3; ++i) { const int r2 = gr + i - 1; if (r2 < 0 || r2 >= 128) continue;
#pragma unroll
                for (int j = 0; j < 3; ++j) { const int c2 = gc + j - 1; if (c2 < 0 || c2 >= 64) continue;
                    const u32x4 w = *(const u32x4*)(QK + ((size_t)b * SROW + CTX + r2 * 64 + c2) * 1024 + ch); const float* cw = p.conv_w + (size_t)(i * 3 + j) * 1024 + ch;
                    a[0] += bflo(w.x) * cw[0]; a[1] += bfhi(w.x) * cw[1]; a[2] += bflo(w.y) * cw[2]; a[3] += bfhi(w.y) * cw[3];
                    a[4] += bflo(w.z) * cw[4]; a[5] += bfhi(w.z) * cw[5]; a[6] += bflo(w.w) * cw[6]; a[7] += bfhi(w.w) * cw[7]; } }
        }
        const float sc = (ch >= 512) ? 0.08838834764831845f : 1.0f;
#pragma unroll
        for (int e = 0; e < 8; ++e) a[e] = silu_(a[e]) * sc;
        u32x4 o; o.x = pk2(a[0], a[1]); o.y = pk2(a[2], a[3]); o.z = pk2(a[4], a[5]); o.w = pk2(a[6], a[7]);
        *(u32x4*)(QKC + (size_t)row * 1024 + ch) = o;
    }
}

template <bool ML>
__device__ __forceinline__ void scan_chain(const Params& p, LAS unsigned char* lds, int dir, int b, int h) {
    const int tid = tid_opaque(), v = tid & 127, cq = tid >> 7;
    unsigned char* ws = p.ws;
    LAS float* Fd = (LAS float*)lds;
    LAS float* Kd = Fd + 1024, *Qd = Kd + 1024, *Vd = Qd + 1024;
    LAS float* Pn = Vd + 1024;
    LAS float* Pd = Pn + 4096;
    LAS float* Li = Pd + 32, *Lf = Li + 8, *Em = Lf + 8;
    float S[32], nn[32];
#pragma unroll
    for (int i = 0; i < 32; ++i) { S[i] = 0.f; nn[i] = 0.f; }
    float m = 0.f;
    const int st = tid >> 6, sp = tid & 63;
    float rf0, rf1, rk0, rk1, rq0, rq1, rv0, rv1, rli = 0.f, rlf = 0.f;
#define ROW_OF(n) (b * SROW + (dir ? ((n) < CTX ? CTX - 1 - (n) : CTX + (SROW - 1 - (n))) : (n)))
#define STAGE_LOAD(n0_) do { const int row = ROW_OF((n0_) + st); const int c = h * 128 + 2 * sp; \
        if (!ML) { \
            const unsigned lf = *(const unsigned*)((const bf16*)(ws + WS_LF) + (size_t)row * 1024 + dir * 512 + c); \
            const unsigned q = *(const unsigned*)((const bf16*)(ws + WS_HQ) + (size_t)row * 512 + c); \
            const unsigned vv = *(const unsigned*)((const bf16*)(ws + WS_HV) + (size_t)row * 512 + c); \
            rf0 = __expf(h2f((unsigned short)(lf & 0xffff))); rf1 = __expf(h2f((unsigned short)(lf >> 16))); rk0 = 1.0f - rf0; rk1 = 1.0f - rf1; \
            rq0 = bflo(q); rq1 = bfhi(q); rv0 = bflo(vv); rv1 = bfhi(vv); \
        } else { \
            const unsigned q = *(const unsigned*)((const bf16*)(ws + WS_QKC) + (size_t)row * 1024 + c); \
            const unsigned k = *(const unsigned*)((const bf16*)(ws + WS_QKC) + (size_t)row * 1024 + 512 + c); \
            const unsigned vv = *(const unsigned*)((const bf16*)(ws + WS_MV) + (size_t)row * 512 + c); \
            rf0 = rf1 = 0.f; rk0 = bflo(k); rk1 = bfhi(k); rq0 = bflo(q); rq1 = bfhi(q); rv0 = bflo(vv); rv1 = bfhi(vv); \
            if (sp == 0) { const float* gp = (const float*)(ws + WS_GATES) + (size_t)row * 16 + dir * 8 + h; rli = gp[0]; rlf = gp[4]; } \
        } } while (0)
#define STAGE_WRITE() do { const int o_ = st * 128 + 2 * sp; \
        Fd[o_] = rf0; Fd[o_ + 1] = rf1; Kd[o_] = rk0; Kd[o_ + 1] = rk1; Qd[o_] = rq0; Qd[o_ + 1] = rq1; Vd[o_] = rv0; Vd[o_ + 1] = rv1; \
        if (ML && sp == 0) { Li[st] = rli; Lf[st] = rlf; } } while (0)
    STAGE_LOAD(0); STAGE_WRITE(); __syncthreads();
    for (int n0 = 0; n0 < SROW; n0 += 8) {
        if (n0 + 8 < SROW) STAGE_LOAD(n0 + 8);
#pragma unroll 1
        for (int t = 0; t < 8; ++t) {
            const float vv = Vd[t * 128 + v];
            float o = 0.f, dn = 0.f, fa = 0.f, ia = 0.f;
            if (ML) { const float li = Li[t], lf = Lf[t]; const float mn = fmaxf(lf + m, li); fa = __expf(lf + m - mn); ia = __expf(li - mn); m = mn; if (tid == 0) Em[t] = __expf(-mn); }
#pragma unroll
            for (int c4 = 0; c4 < 8; ++c4) {
                const f32x4 kk = *(const LAS f32x4*)(Kd + t * 128 + cq * 32 + c4 * 4), qq = *(const LAS f32x4*)(Qd + t * 128 + cq * 32 + c4 * 4);
                f32x4 ff; if (!ML) ff = *(const LAS f32x4*)(Fd + t * 128 + cq * 32 + c4 * 4);
#pragma unroll
                for (int e = 0; e < 4; ++e) { const int i = c4 * 4 + e;
                    if (!ML) { S[i] = ff[e] * S[i] + kk[e] * vv; o += S[i] * qq[e]; }
                    else { const float ik = ia * kk[e]; S[i] = fa * S[i] + ik * vv; nn[i] = fa * nn[i] + ik; o += S[i] * qq[e]; dn += nn[i] * qq[e]; } }
            }
            Pn[(t * 4 + cq) * 128 + v] = o;
            if (ML && v == 0) Pd[t * 4 + cq] = dn;
        }
        __syncthreads();
        if (n0 >= CTX) {
            const int t = tid >> 6, v0 = 2 * (tid & 63);
            float o0 = (Pn[(t * 4 + 0) * 128 + v0] + Pn[(t * 4 + 1) * 128 + v0]) + (Pn[(t * 4 + 2) * 128 + v0] + Pn[(t * 4 + 3) * 128 + v0]);
            float o1 = (Pn[(t * 4 + 0) * 128 + v0 + 1] + Pn[(t * 4 + 1) * 128 + v0 + 1]) + (Pn[(t * 4 + 2) * 128 + v0 + 1] + Pn[(t * 4 + 3) * 128 + v0 + 1]);
            if (ML) { const float den = (Pd[t * 4 + 0] + Pd[t * 4 + 1]) + (Pd[t * 4 + 2] + Pd[t * 4 + 3]); const float dd = fmaxf(fabsf(den), Em[t]); o0 = o0 / dd; o1 = o1 / dd; }
            const int row = ROW_OF(n0 + t); const int xrow = b * SEQ + (row - b * SROW - CTX);
            bf16* O = (bf16*)p.out + ((size_t)dir * R_X + xrow) * 1024 + (ML ? 512 : 0) + h * 128 + v0;
            *(unsigned*)O = pk2(o0, o1);
        }
        if (n0 + 8 < SROW) STAGE_WRITE();
        __syncthreads();
    }
}

namespace sc {
typedef short v4i16_t __attribute__((ext_vector_type(4)));
constexpr int PQ = 272, PK = 144;
constexpr int L_QT = 0, L_KT = 17408, L_K2T = 34816, L_V = 53248, L_P = 70656, L_O = 79872, L_ST = 97280, L_TOT = 132096, L_DVEC = 136192, L_EREF = 136704,
              L_N = 137216, L_DV = 137728, L_FL = 137984, L_END = 138240;
constexpr size_t SEG_STRIDE = 66560;

__device__ __forceinline__ int row_of(int dir, int b, int n) { const int s = dir ? (n < CTX ? CTX - 1 - n : CTX + (SROW - 1 - n)) : n; return b * SROW + s; }
__device__ __forceinline__ bf16x8 ld8(LAS unsigned char* lds, int off) { return *(const LAS bf16x8*)(lds + off); }
__device__ __forceinline__ bf16x8 trB(LAS unsigned char* lds, int off) {
    const v4i16_t a = __builtin_amdgcn_ds_read_tr16_b64_v4i16((LAS v4i16_t*)(lds + off));
    const v4i16_t b = __builtin_amdgcn_ds_read_tr16_b64_v4i16((LAS v4i16_t*)(lds + off + 4 * PQ));
    return (bf16x8){a[0], a[1], a[2], a[3], b[0], b[1], b[2], b[3]};
}
__device__ __forceinline__ float rdlane(float v, int idx) { return __uint_as_float((unsigned)__builtin_amdgcn_readlane((int)__float_as_uint(v), idx)); }
#define SC_MFMA(a, b, c) __builtin_amdgcn_mfma_f32_16x16x32_bf16((a), (b), (c), 0, 0, 0)

template <bool ML>
__device__ __forceinline__ void pc_step(LAS unsigned char* lds, int w, int li, int g, int offA, int offB) {
    for (int ti = w; ti < 10; ti += 8) {
        const int ib = (ti >= 6) ? 3 : (ti >= 3) ? 2 : (ti >= 1) ? 1 : 0, jb = ti - (ib * (ib + 1)) / 2;
        f32x4 acc = (f32x4){0.f, 0.f, 0.f, 0.f};
#pragma unroll
        for (int s = 0; s < 4; ++s) acc = SC_MFMA(ld8(lds, offA + (16 * jb + li) * PQ + (32 * s + 8 * g) * 2), ld8(lds, offB + (16 * ib + li) * PQ + (32 * s + 8 * g) * 2), acc);
        const int i = 16 * ib + li, j0 = 16 * jb + 4 * g;
        const float v0 = (j0 + 0 <= i) ? acc[0] : 0.f, v1 = (j0 + 1 <= i) ? acc[1] : 0.f, v2 = (j0 + 2 <= i) ? acc[2] : 0.f, v3 = (j0 + 3 <= i) ? acc[3] : 0.f;
        u32x2 pw; pw.x = pk2(v0, v1); pw.y = pk2(v2, v3);
        *(LAS u32x2*)(lds + L_P + i * PK + j0 * 2) = pw;
        if (ML) { float ps = (bflo(pw.x) + bfhi(pw.x)) + (bflo(pw.y) + bfhi(pw.y)); ps += __shfl_xor(ps, 16); ps += __shfl_xor(ps, 32);
            if (g == 0) __hip_atomic_fetch_add((LAS float*)(lds + L_DV) + i, ps, __ATOMIC_RELAXED, __HIP_MEMORY_SCOPE_WORKGROUP); }
    }
}
__device__ __forceinline__ void w_step(const Params& p, LAS unsigned char* lds, int tid, int dir, int b, int nbase, int col0) {
#pragma unroll
    for (int q = 0; q < 2; ++q) { const int idx = tid + q * NTHR, i = idx >> 4, ch = idx & 15;
        const u32x4 val = *(const LAS u32x4*)(lds + L_O + i * PQ + ch * 16);
        const int row = row_of(dir, b, nbase + i), xrow = b * SEQ + (row - b * SROW - CTX);
        *(u32x4*)((bf16*)p.out + ((size_t)dir * R_X + xrow) * 1024 + col0 + ch * 8) = val; }
}
__device__ __forceinline__ void save_tiles(float* dst, const f32x4 (&S)[8], int w, int lane) {
#pragma unroll
    for (int t = 0; t < 8; ++t) *(f32x4*)(dst + ((size_t)(w * 8 + t) * 64 + lane) * 4) = S[t];
}

struct HgIn { unsigned lf[8], q[8], v[8]; };
template <bool OUT>
__device__ __forceinline__ void hg_load(const Params& p, HgIn& r, int dir, int b, int h, int nbase, int w, int l) {
    const unsigned char* ws = p.ws;
#pragma unroll
    for (int t = 0; t < 8; ++t) { const size_t row = (size_t)row_of(dir, b, nbase + 8 * w + t);
        r.lf[t] = *(const unsigned*)((const bf16*)(ws + WS_LF) + row * 1024 + dir * 512 + h * 128 + 2 * l);
        r.v[t] = *(const unsigned*)((const bf16*)(ws + WS_HV) + row * 512 + h * 128 + 2 * l);
        if (OUT) r.q[t] = *(const unsigned*)((const bf16*)(ws + WS_HQ) + row * 512 + h * 128 + 2 * l); else r.q[t] = 0u; }
}
template <bool OUT>
__device__ __forceinline__ void hg_run(const Params& p, LAS unsigned char* lds, int dir, int b, int h, int n0, int nch, f32x4 (&S)[8], float& lt0, float& lt1) {
    const int tid = tid_opaque(), w = __builtin_amdgcn_readfirstlane(tid >> 6), l = tid & 63, li = l & 15, g = l >> 4;
    HgIn cur, nxt;
    hg_load<OUT>(p, cur, dir, b, h, n0, w, l);
    for (int c = 0; c < nch; ++c) {
        const int nbase = n0 + 64 * c;
        float a0[8], a1[8], f0[8], f1[8]; float c0 = 0.f, c1 = 0.f;
#pragma unroll
        for (int t = 0; t < 8; ++t) { f0[t] = h2f((unsigned short)(cur.lf[t] & 0xffffu)); f1[t] = h2f((unsigned short)(cur.lf[t] >> 16)); c0 += f0[t]; c1 += f1[t]; a0[t] = c0; a1[t] = c1; }
        *(LAS f32x2*)(lds + L_TOT + (w * 128 + 2 * l) * 4) = (f32x2){c0, c1};
        __syncthreads();
        float pre0 = 0.f, pre1 = 0.f, ar0 = 0.f, ar1 = 0.f, al0 = 0.f, al1 = 0.f;
#pragma unroll
        for (int w2 = 0; w2 < 8; ++w2) { const f32x2 tt = *(const LAS f32x2*)(lds + L_TOT + (w2 * 128 + 2 * l) * 4);
            if (w2 < w) { pre0 += tt.x; pre1 += tt.y; } if (w2 < 4) { ar0 += tt.x; ar1 += tt.y; } al0 += tt.x; al1 += tt.y; }
        unsigned k2a[8], k2b[8];
#pragma unroll
        for (int t = 0; t < 8; ++t) { const int j = 8 * w + t;
            const float A0 = a0[t] + pre0, A1 = a1[t] + pre1;
            const float k0 = 1.0f - __expf(f0[t]), k1 = 1.0f - __expf(f1[t]);
            const float kt0 = k0 * __expf(fminf(ar0 - A0, 60.f)), kt1 = k1 * __expf(fminf(ar1 - A1, 60.f));
            const float kk0 = k0 * __expf(al0 - A0), kk1 = k1 * __expf(al1 - A1);
            *(LAS unsigned*)(lds + L_KT + j * PQ + 4 * l) = pk2(kt0, kt1);
            *(LAS unsigned*)(lds + L_V + j * PQ + 4 * l) = cur.v[t];
            if (OUT) { const float q0 = bflo(cur.q[t]) * __expf(fminf(A0 - ar0, 60.f)), q1 = bfhi(cur.q[t]) * __expf(fminf(A1 - ar1, 60.f));
                *(LAS unsigned*)(lds + L_QT + j * PQ + 4 * l) = pk2(q0, q1); }
            const unsigned kk = pk2(kk0, kk1);
            if (t & 1) { k2a[t >> 1] = (k2a[t >> 1] & 0xffffu) | (kk << 16); k2b[t >> 1] = (k2b[t >> 1] & 0xffffu) | (kk & 0xffff0000u); }
            else { k2a[t >> 1] = kk & 0xffffu; k2b[t >> 1] = kk >> 16; } }
        *(LAS u32x4*)(lds + L_K2T + (2 * l) * PK + 16 * w) = (u32x4){k2a[0], k2a[1], k2a[2], k2a[3]};
        *(LAS u32x4*)(lds + L_K2T + (2 * l + 1) * PK + 16 * w) = (u32x4){k2b[0], k2b[1], k2b[2], k2b[3]};
        if (w == 0) { *(LAS f32x2*)(lds + L_DVEC + 8 * l) = (f32x2){__expf(al0), __expf(al1)}; *(LAS f32x2*)(lds + L_EREF + 8 * l) = (f32x2){__expf(ar0), __expf(ar1)}; }
        lt0 += al0; lt1 += al1;
        __syncthreads();
        if (c + 1 < nch) hg_load<OUT>(p, nxt, dir, b, h, nbase + 64, w, l);
        if (OUT) { pc_step<false>(lds, w, li, g, L_KT, L_QT); __syncthreads(); }
        bf16x8 bv[2];
#pragma unroll
        for (int s = 0; s < 2; ++s) bv[s] = trB(lds, L_V + (32 * s + 8 * g + (li >> 2)) * PQ + (16 * w + 4 * (li & 3)) * 2);
        if (OUT) {
#pragma unroll
            for (int t = 0; t < 8; ++t) { const f32x4 er = *(const LAS f32x4*)(lds + L_EREF + (16 * t + 4 * g) * 4); const f32x4 sv = S[t] * er;
                u32x2 pw; pw.x = pk2(sv[0], sv[1]); pw.y = pk2(sv[2], sv[3]); *(LAS u32x2*)(lds + L_ST + (16 * w + li) * PQ + (16 * t + 4 * g) * 2) = pw; }
            bf16x8 bs[4];
#pragma unroll
            for (int s = 0; s < 4; ++s) bs[s] = ld8(lds, L_ST + (16 * w + li) * PQ + (32 * s + 8 * g) * 2);
#pragma unroll
            for (int it = 0; it < 4; ++it) { f32x4 acc = (f32x4){0.f, 0.f, 0.f, 0.f};
#pragma unroll
                for (int s = 0; s < 2; ++s) if (32 * s <= 16 * it + 15) acc = SC_MFMA(bv[s], ld8(lds, L_P + (16 * it + li) * PK + (32 * s + 8 * g) * 2), acc);
#pragma unroll
                for (int s = 0; s < 4; ++s) acc = SC_MFMA(bs[s], ld8(lds, L_QT + (16 * it + li) * PQ + (32 * s + 8 * g) * 2), acc);
                u32x2 pw; pw.x = pk2(acc[0], acc[1]); pw.y = pk2(acc[2], acc[3]); *(LAS u32x2*)(lds + L_O + (16 * it + li) * PQ + (16 * w + 4 * g) * 2) = pw; }
        }
#pragma unroll
        for (int t = 0; t < 8; ++t) { const f32x4 dv = *(const LAS f32x4*)(lds + L_DVEC + (16 * t + 4 * g) * 4); S[t] = S[t] * dv;
#pragma unroll
            for (int s = 0; s < 2; ++s) S[t] = SC_MFMA(ld8(lds, L_K2T + (16 * t + li) * PK + (32 * s + 8 * g) * 2), bv[s], S[t]); }
        __syncthreads();
        if (OUT) w_step(p, lds, tid, dir, b, nbase, h * 128);
        cur = nxt;
    }
}

struct MlIn { unsigned q[8], k[8], v[8]; float li, lf; };
template <bool OUT>
__device__ __forceinline__ void ml_load(const Params& p, MlIn& r, int dir, int b, int h, int nbase, int w, int l) {
    const unsigned char* ws = p.ws;
#pragma unroll
    for (int t = 0; t < 8; ++t) { const size_t row = (size_t)row_of(dir, b, nbase + 8 * w + t);
        r.k[t] = *(const unsigned*)((const bf16*)(ws + WS_QKC) + row * 1024 + 512 + h * 128 + 2 * l);
        r.v[t] = *(const unsigned*)((const bf16*)(ws + WS_MV) + row * 512 + h * 128 + 2 * l);
        if (OUT) r.q[t] = *(const unsigned*)((const bf16*)(ws + WS_QKC) + row * 1024 + h * 128 + 2 * l); else r.q[t] = 0u; }
    const float* gp = (const float*)(ws + WS_GATES) + (size_t)row_of(dir, b, nbase + l) * 16 + dir * 8 + h; r.li = gp[0]; r.lf = gp[4];
}
template <bool OUT>
__device__ __forceinline__ void ml_run(const Params& p, LAS unsigned char* lds, int dir, int b, int h, int n0, int nch, f32x4 (&S)[8], float& m_prev, float& btot) {
    const int tid = tid_opaque(), w = __builtin_amdgcn_readfirstlane(tid >> 6), l = tid & 63, li = l & 15, g = l >> 4;
    MlIn cur, nxt;
    ml_load<OUT>(p, cur, dir, b, h, n0, w, l);
    for (int c = 0; c < nch; ++c) {
        const int nbase = n0 + 64 * c;
        float bs_ = cur.lf;
#pragma unroll
        for (int o = 1; o < 64; o <<= 1) { const float t = __shfl_up(bs_, o); if (l >= o) bs_ += t; }
        const float gg = cur.li - bs_;
        float gm = gg;
#pragma unroll
        for (int o = 1; o < 64; o <<= 1) gm = fmaxf(gm, __shfl_xor(gm, o));
        const float G = fmaxf(m_prev, gm), s_in = __expf(m_prev - G), eg = __expf(gg - G), b63 = rdlane(bs_, 63);
        if (w == 0 && OUT) *(LAS float*)(lds + L_FL + 4 * l) = __expf(-(bs_ + G));
        float n0v = 0.f, n1v = 0.f;
        if (OUT) { const f32x2 nn = *(const LAS f32x2*)(lds + L_N + 8 * l); n0v = nn.x * s_in; n1v = nn.y * s_in; }
        float ks0 = 0.f, ks1 = 0.f; unsigned k2a[8], k2b[8];
#pragma unroll
        for (int t = 0; t < 8; ++t) { const int j = 8 * w + t; const float egj = rdlane(eg, j);
            const float kh0 = bflo(cur.k[t]) * egj, kh1 = bfhi(cur.k[t]) * egj; ks0 += kh0; ks1 += kh1;
            const unsigned kk = pk2(kh0, kh1);
            *(LAS unsigned*)(lds + L_V + j * PQ + 4 * l) = cur.v[t];
            if (OUT) { *(LAS unsigned*)(lds + L_KT + j * PQ + 4 * l) = kk; *(LAS unsigned*)(lds + L_QT + j * PQ + 4 * l) = cur.q[t];
                const float qd = wave_sum(bflo(cur.q[t]) * n0v + bfhi(cur.q[t]) * n1v); if (l == 0) *(LAS float*)(lds + L_DV + 4 * j) = qd; }
            if (t & 1) { k2a[t >> 1] = (k2a[t >> 1] & 0xffffu) | (kk << 16); k2b[t >> 1] = (k2b[t >> 1] & 0xffffu) | (kk & 0xffff0000u); }
            else { k2a[t >> 1] = kk & 0xffffu; k2b[t >> 1] = kk >> 16; } }
        *(LAS u32x4*)(lds + L_K2T + (2 * l) * PK + 16 * w) = (u32x4){k2a[0], k2a[1], k2a[2], k2a[3]};
        *(LAS u32x4*)(lds + L_K2T + (2 * l + 1) * PK + 16 * w) = (u32x4){k2b[0], k2b[1], k2b[2], k2b[3]};
        *(LAS f32x2*)(lds + L_TOT + (w * 128 + 2 * l) * 4) = (f32x2){ks0, ks1};
        __syncthreads();
        if (tid < 128) { float s = *(const LAS float*)(lds + L_N + 4 * tid) * s_in;
#pragma unroll
            for (int w2 = 0; w2 < 8; ++w2) s += *(const LAS float*)(lds + L_TOT + (w2 * 128 + tid) * 4);
            *(LAS float*)(lds + L_N + 4 * tid) = s; }
        if (c + 1 < nch) ml_load<OUT>(p, nxt, dir, b, h, nbase + 64, w, l);
        if (OUT) { pc_step<true>(lds, w, li, g, L_KT, L_QT); __syncthreads(); }
        bf16x8 bv[2];
#pragma unroll
        for (int s = 0; s < 2; ++s) bv[s] = trB(lds, L_V + (32 * s + 8 * g + (li >> 2)) * PQ + (16 * w + 4 * (li & 3)) * 2);
#pragma unroll
        for (int t = 0; t < 8; ++t) S[t] = S[t] * s_in;
        if (OUT) {
#pragma unroll
            for (int t = 0; t < 8; ++t) { u32x2 pw; pw.x = pk2(S[t][0], S[t][1]); pw.y = pk2(S[t][2], S[t][3]); *(LAS u32x2*)(lds + L_ST + (16 * w + li) * PQ + (16 * t + 4 * g) * 2) = pw; }
            bf16x8 bs[4];
#pragma unroll
            for (int s = 0; s < 4; ++s) bs[s] = ld8(lds, L_ST + (16 * w + li) * PQ + (32 * s + 8 * g) * 2);
#pragma unroll
            for (int it = 0; it < 4; ++it) { f32x4 acc = (f32x4){0.f, 0.f, 0.f, 0.f};
#pragma unroll
                for (int s = 0; s < 2; ++s) if (32 * s <= 16 * it + 15) acc = SC_MFMA(bv[s], ld8(lds, L_P + (16 * it + li) * PK + (32 * s + 8 * g) * 2), acc);
#pragma unroll
                for (int s = 0; s < 4; ++s) acc = SC_MFMA(bs[s], ld8(lds, L_QT + (16 * it + li) * PQ + (32 * s + 8 * g) * 2), acc);
                const int i = 16 * it + li; const float den = *(const LAS float*)(lds + L_DV + 4 * i), fl = *(const LAS float*)(lds + L_FL + 4 * i);
                const float rd = 1.0f / fmaxf(fabsf(den), fl); acc = acc * rd;
                u32x2 pw; pw.x = pk2(acc[0], acc[1]); pw.y = pk2(acc[2], acc[3]); *(LAS u32x2*)(lds + L_O + i * PQ + (16 * w + 4 * g) * 2) = pw; }
        }
#pragma unroll
        for (int t = 0; t < 8; ++t) {
#pragma unroll
            for (int s = 0; s < 2; ++s) S[t] = SC_MFMA(ld8(lds, L_K2T + (16 * t + li) * PK + (32 * s + 8 * g) * 2), bv[s], S[t]); }
        m_prev = b63 + G; btot += b63;
        __syncthreads();
        if (OUT) w_step(p, lds, tid, dir, b, nbase, 512 + h * 128);
        cur = nxt;
    }
}

__device__ __forceinline__ void pass_a(const Params& p, LAS unsigned char* lds, int item) {
    const int tid = tid_opaque(), w = __builtin_amdgcn_readfirstlane(tid >> 6), l = tid & 63;
    const int chain = item >> 2, sa = item & 3, type = chain >> 5, dir = (chain >> 4) & 1, b = (chain >> 2) & 3, h = chain & 3;
    const int n0 = sa == 0 ? 0 : CTX + (sa - 1) * 2048, nch = sa == 0 ? 4 : 32;
    float* rec = (float*)(p.ws + WS_SEG + (size_t)item * SEG_STRIDE);
    f32x4 S[8];
#pragma unroll
    for (int t = 0; t < 8; ++t) S[t] = (f32x4){0.f, 0.f, 0.f, 0.f};
    if (type == 0) { float lt0 = 0.f, lt1 = 0.f; hg_run<false>(p, lds, dir, b, h, n0, nch, S, lt0, lt1);
        save_tiles(rec, S, w, l); if (w == 0) *(f32x2*)(rec + 16384 + 2 * l) = (f32x2){lt0, lt1}; }
    else { float m_prev = -1.0e30f, btot = 0.f;
        if (tid < 128) *(LAS float*)(lds + L_N + 4 * tid) = 0.f;
        __syncthreads();
        ml_run<false>(p, lds, dir, b, h, n0, nch, S, m_prev, btot);
        save_tiles(rec, S, w, l); if (tid < 128) rec[16384 + tid] = *(const LAS float*)(lds + L_N + 4 * tid);
        if (tid == 0) { rec[16384 + 128] = m_prev; rec[16384 + 129] = btot; } }
    __syncthreads();
}
__device__ __forceinline__ void pass_b(const Params& p, LAS unsigned char* lds, int item) {
    const int tid = tid_opaque(), w = __builtin_amdgcn_readfirstlane(tid >> 6), l = tid & 63, g = l >> 4;
    const int chain = item >> 2, k = item & 3, type = chain >> 5, dir = (chain >> 4) & 1, b = (chain >> 2) & 3, h = chain & 3;
    const int n0 = CTX + k * 2048;
    for (int i = tid; i < 64 * PK / 4; i += NTHR) *(LAS unsigned*)(lds + L_P + 4 * i) = 0u;
    f32x4 S[8];
#pragma unroll
    for (int t = 0; t < 8; ++t) S[t] = (f32x4){0.f, 0.f, 0.f, 0.f};
    if (type == 0) {
        for (int j = 0; j <= k; ++j) { const float* rec = (const float*)(p.ws + WS_SEG + (size_t)(chain * 4 + j) * SEG_STRIDE);
#pragma unroll
            for (int t = 0; t < 8; ++t) { const f32x4 lt = *(const f32x4*)(rec + 16384 + 16 * t + 4 * g); const f32x4 u = *(const f32x4*)(rec + ((size_t)(w * 8 + t) * 64 + l) * 4);
                S[t][0] = S[t][0] * __expf(lt[0]) + u[0]; S[t][1] = S[t][1] * __expf(lt[1]) + u[1]; S[t][2] = S[t][2] * __expf(lt[2]) + u[2]; S[t][3] = S[t][3] * __expf(lt[3]) + u[3]; } }
        __syncthreads();
        float lt0 = 0.f, lt1 = 0.f; hg_run<true>(p, lds, dir, b, h, n0, 32, S, lt0, lt1);
    } else {
        float m_in = -1.0e30f, nacc = 0.f;
        for (int j = 0; j <= k; ++j) { const float* rec = (const float*)(p.ws + WS_SEG + (size_t)(chain * 4 + j) * SEG_STRIDE);
            const float m_loc = rec[16384 + 128], bj = rec[16384 + 129]; const float mn = fmaxf(bj + m_in, m_loc), sa_ = __expf(bj + m_in - mn), sb_ = __expf(m_loc - mn);
#pragma unroll
            for (int t = 0; t < 8; ++t) { const f32x4 u = *(const f32x4*)(rec + ((size_t)(w * 8 + t) * 64 + l) * 4); S[t] = S[t] * sa_ + u * sb_; }
            if (tid < 128) nacc = nacc * sa_ + rec[16384 + tid] * sb_;
            m_in = mn; }
        if (tid < 128) *(LAS float*)(lds + L_N + 4 * tid) = nacc;
        __syncthreads();
        float btot = 0.f; ml_run<true>(p, lds, dir, b, h, n0, 32, S, m_in, btot);
    }
    __syncthreads();
}
#undef SC_MFMA
}

__device__ __forceinline__ void phase_mixprep(const Params& p) {
    unsigned char* ws = p.ws;
    const int tid = tid_opaque(), lane = tid & 63, wave = tid >> 6;
    const int gw = blockIdx.x * NWAVES + wave, NGW = gridDim.x * NWAVES;
    for (int xr = gw; xr < R_X; xr += NGW) {
        const int b = xr / SEQ, t = xr % SEQ; const size_t row = (size_t)b * SROW + CTX + t;
        const bf16* of = (const bf16*)p.out + (size_t)xr * 1024 + lane * 16;
        const bf16* ob = (const bf16*)p.out + ((size_t)R_X + xr) * 1024 + lane * 16;
        float v[16];
#pragma unroll
        for (int q = 0; q < 2; ++q) { const u32x4 a = *(const u32x4*)(of + q * 8), c = *(const u32x4*)(ob + q * 8);
            v[q * 8 + 0] = bflo(a.x) + bflo(c.x); v[q * 8 + 1] = bfhi(a.x) + bfhi(c.x); v[q * 8 + 2] = bflo(a.y) + bflo(c.y); v[q * 8 + 3] = bfhi(a.y) + bfhi(c.y);
            v[q * 8 + 4] = bflo(a.z) + bflo(c.z); v[q * 8 + 5] = bfhi(a.z) + bfhi(c.z); v[q * 8 + 6] = bflo(a.w) + bflo(c.w); v[q * 8 + 7] = bfhi(a.w) + bfhi(c.w); }
        float s = 0.f;
#pragma unroll
        for (int e = 0; e < 16; ++e) s += v[e];
        s += __shfl_xor(s, 1); s += __shfl_xor(s, 2); s += __shfl_xor(s, 4);
        const bool ml = lane >= 32;
        const float mean = ml ? s * (1.0f / 128.0f) : 0.f;
        float q2 = 0.f;
#pragma unroll
        for (int e = 0; e < 16; ++e) { v[e] -= mean; q2 += v[e] * v[e]; }
        q2 += __shfl_xor(q2, 1); q2 += __shfl_xor(q2, 2); q2 += __shfl_xor(q2, 4);
        const float rstd = rsqrtf(q2 * (1.0f / 128.0f) + EPS);
        const int c0 = (lane & 31) * 16;
        const float* nw = (ml ? p.ml_norm_w : p.hg_norm_w) + c0;
        const bf16* gt = (const bf16*)(ws + (ml ? WS_MO : WS_HG)) + row * 512 + c0;
        const u32x4 g0 = *(const u32x4*)gt, g1 = *(const u32x4*)(gt + 8);
        float g[16] = {bflo(g0.x), bfhi(g0.x), bflo(g0.y), bfhi(g0.y), bflo(g0.z), bfhi(g0.z), bflo(g0.w), bfhi(g0.w),
                       bflo(g1.x), bfhi(g1.x), bflo(g1.y), bfhi(g1.y), bflo(g1.z), bfhi(g1.z), bflo(g1.w), bfhi(g1.w)};
#pragma unroll
        for (int e = 0; e < 16; ++e) v[e] = v[e] * rstd * nw[e] * g[e];
        u32x4 o0, o1; o0.x = pk2(v[0], v[1]); o0.y = pk2(v[2], v[3]); o0.z = pk2(v[4], v[5]); o0.w = pk2(v[6], v[7]);
        o1.x = pk2(v[8], v[9]); o1.y = pk2(v[10], v[11]); o1.z = pk2(v[12], v[13]); o1.w = pk2(v[14], v[15]);
        bf16* am = (bf16*)(ws + WS_AMIX2) + (size_t)xr * 1024 + lane * 16;
        *(u32x4*)am = o0; *(u32x4*)(am + 8) = o1;
    }
}

__device__ __forceinline__ void phase_vx(const Params& p, LAS unsigned char* lds) {
    unsigned char* ws = p.ws;
    const int tid = tid_opaque(), lane = tid & 63, wave = tid >> 6;
    LAS float* Lrw = (LAS float*)lds;
    LAS float* Lnw = Lrw + 16 * 1024;
    LAS float* Lsh = Lnw + 1024;
    LAS float* Lsc = Lsh + 4096;
    const float* mod = (const float*)(ws + WS_MOD);
    for (int i = tid; i < 16 * 1024; i += NTHR) Lrw[i] = ((const float*)(ws + WS_RWT))[i];
    for (int i = tid; i < 1024; i += NTHR) Lnw[i] = p.norm2_w[i];
    for (int i = tid; i < 4096; i += NTHR) { const int b = i >> 10, c = i & 1023; Lsh[i] = mod[(size_t)b * 6144 + 3072 + c]; Lsc[i] = mod[(size_t)b * 6144 + 4096 + c]; }
    __syncthreads();
    const int gw = blockIdx.x * NWAVES + wave, NGW = gridDim.x * NWAVES;
    for (int xr = gw; xr < R_X; xr += NGW) {
        const int b = xr / SEQ, t = xr % SEQ;
        const float* src = p.out + (size_t)xr * D;
        f32x4 v[4]; float ss = 0.f;
#pragma unroll
        for (int j = 0; j < 4; ++j) { v[j] = *(const f32x4*)(src + j * 256 + lane * 4); ss += (v[j].x * v[j].x + v[j].y * v[j].y) + (v[j].z * v[j].z + v[j].w * v[j].w); }
        const float rstd = rsqrtf(wave_sum(ss) * (1.0f / D) + EPS);
        bf16* vrow = (bf16*)(ws + WS_VX) + (size_t)xr * D;
#pragma unroll
        for (int j = 0; j < 4; ++j) { const int c0 = j * 256 + lane * 4;
            const f32x4 nw = *(const LAS f32x4*)(Lnw + c0), sc = *(const LAS f32x4*)(Lsc + b * 1024 + c0), sh = *(const LAS f32x4*)(Lsh + b * 1024 + c0);
            v[j] = v[j] * rstd * nw * (1.0f + sc) + sh;
            u32x2 w; w.x = pk2(v[j].x, v[j].y); w.y = pk2(v[j].z, v[j].w); *(u32x2*)(vrow + c0) = w; }
        float pa[16];
#pragma unroll
        for (int g = 0; g < 16; ++g) { float a = 0.f;
#pragma unroll
            for (int j = 0; j < 4; ++j) { const f32x4 w = *(const LAS f32x4*)(Lrw + g * 1024 + j * 256 + lane * 4); a += (v[j].x * w.x + v[j].y * w.y) + (v[j].z * w.z + v[j].w * w.w); }
            pa[g] = a; if (g & 1) __builtin_amdgcn_sched_barrier(0); }
        const float mine = butterfly16(pa, lane);
        float mx = mine;
        mx = fmaxf(mx, __shfl_xor(mx, 4)); mx = fmaxf(mx, __shfl_xor(mx, 8)); mx = fmaxf(mx, __shfl_xor(mx, 16)); mx = fmaxf(mx, __shfl_xor(mx, 32));
        const float ex = __expf(mine - mx);
        float sm = ex; sm += __shfl_xor(sm, 4); sm += __shfl_xor(sm, 8); sm += __shfl_xor(sm, 16); sm += __shfl_xor(sm, 32);
        if ((lane & 3) == 0) ((float*)(ws + WS_AFF))[((size_t)b * 16 + (lane >> 2)) * SEQ + t] = ex / sm;
    }
}

__device__ __forceinline__ void phase_topk(const Params& p, LAS unsigned char* lds) {
    unsigned char* ws = p.ws;
    const int tid = tid_opaque(), lane = tid & 63, w = __builtin_amdgcn_readfirstlane(tid >> 6);
    LAS int* wc = (LAS int*)lds;
    for (int item = blockIdx.x; item < 256; item += gridDim.x) {
        const int be = item >> 2, qtr = item & 3, b = be >> 4, e = be & 15;
        const float* aff = (const float*)(ws + WS_AFF) + (size_t)be * SEQ + tid * 16;
        unsigned u[16];
#pragma unroll
        for (int q = 0; q < 4; ++q) { const f32x4 v = *(const f32x4*)(aff + 4 * q); u[4 * q] = __float_as_uint(v.x); u[4 * q + 1] = __float_as_uint(v.y); u[4 * q + 2] = __float_as_uint(v.z); u[4 * q + 3] = __float_as_uint(v.w); }
        unsigned T = 0u; int par = 0;
        for (int bit = 30; bit >= -1; --bit) {
            const unsigned cand = (bit >= 0) ? (T | (1u << bit)) : (T + 1u);
            int c = 0;
#pragma unroll
            for (int i = 0; i < 16; ++i) c += (int)__popcll(__ballot(u[i] >= cand));
            if (lane == 0) wc[par * 8 + w] = c;
            __syncthreads();
            int tot = 0;
#pragma unroll
            for (int w2 = 0; w2 < 8; ++w2) tot += wc[par * 8 + w2];
            if (bit >= 0) { if (tot >= CAP) T = cand; } else wc[32] = tot;
            par ^= 1;
        }
        int ngt = 0, neq = 0;
#pragma unroll
        for (int i = 0; i < 16; ++i) { ngt += (u[i] > T) ? 1 : 0; neq += (u[i] == T) ? 1 : 0; }
        int pk = (ngt << 16) | neq, inc = pk;
#pragma unroll
        for (int o = 1; o < 64; o <<= 1) { const int t = __shfl_up(inc, o); if (lane >= o) inc += t; }
        if (lane == 63) wc[16 + w] = inc;
        __syncthreads();
        const int cgt = wc[32];
        int base = inc - pk;
#pragma unroll
        for (int w2 = 0; w2 < 8; ++w2) if (w2 < w) base += wc[16 + w2];
        int gtb = base >> 16, eqb = base & 0xffff; const int need_eq = CAP - cgt;
        if ((tid >> 7) == qtr) {
            int sl[16];
#pragma unroll
            for (int i = 0; i < 16; ++i) { int s_ = -1;
                if (u[i] > T) { s_ = gtb; ++gtb; } else if (u[i] == T) { if (eqb < need_eq) s_ = cgt + eqb; ++eqb; }
                sl[i] = s_;
                if (s_ >= 0) { const int mrow = (e * NB + b) * CAP + s_; ((int*)(ws + WS_ROWMAP))[mrow] = b * SEQ + tid * 16 + i; ((float*)(ws + WS_GATEV))[mrow] = __uint_as_float(u[i]); } }
            int* so = (int*)(ws + WS_SLOT) + (size_t)be * SEQ + tid * 16;
#pragma unroll
            for (int q = 0; q < 4; ++q) *(int4*)(so + 4 * q) = make_int4(sl[4 * q], sl[4 * q + 1], sl[4 * q + 2], sl[4 * q + 3]);
        }
        __syncthreads();
    }
}

__device__ __forceinline__ void phase_final(const Params& p) {
    unsigned char* ws = p.ws;
    const int tid = tid_opaque(), lane = tid & 63, wave = tid >> 6;
    const int gw = blockIdx.x * NWAVES + wave, NGW = gridDim.x * NWAVES;
    const float* mod = (const float*)(ws + WS_MOD);
    for (int blk = gw; blk < R_X / 16; blk += NGW) {
        const int xr0 = blk * 16, b = xr0 / SEQ, t0 = xr0 % SEQ;
        const int4 sl4 = *(const int4*)((const int*)(ws + WS_SLOT) + ((size_t)b * 16 + (lane & 15)) * SEQ + t0 + 4 * (lane >> 4));
#pragma unroll 1
        for (int rq = 0; rq < 4; ++rq)
#pragma unroll 1
            for (int rr = 0; rr < 4; ++rr) {
                const int xr = xr0 + rq * 4 + rr; const int myv = (rr == 0) ? sl4.x : (rr == 1) ? sl4.y : (rr == 2) ? sl4.z : sl4.w;
                float* row = p.out + (size_t)xr * D;
                f32x4 acc[4];
#pragma unroll
                for (int j = 0; j < 4; ++j) acc[j] = (f32x4){0.f, 0.f, 0.f, 0.f};
                for (int e = 0; e < 16; ++e) { const int sl = __shfl(myv, e + 16 * rq); if (sl < 0) continue;
                    const bf16* y = (const bf16*)(ws + WS_Y) + ((size_t)(e * NB + b) * CAP + sl) * D;
#pragma unroll
                    for (int j = 0; j < 4; ++j) { const u32x2 wv = *(const u32x2*)(y + j * 256 + lane * 4); acc[j].x += bflo(wv.x); acc[j].y += bfhi(wv.x); acc[j].z += bflo(wv.y); acc[j].w += bfhi(wv.y); } }
                f32x4 v[4]; float ss = 0.f;
#pragma unroll
                for (int j = 0; j < 4; ++j) { const int c0 = j * 256 + lane * 4; const f32x4 g2 = *(const f32x4*)(mod + (size_t)b * 6144 + 5120 + c0);
                    v[j] = *(const f32x4*)(row + c0) + g2 * acc[j]; ss += (v[j].x * v[j].x + v[j].y * v[j].y) + (v[j].z * v[j].z + v[j].w * v[j].w); }
                const float rstd = rsqrtf(wave_sum(ss) * (1.0f / D) + EPS);
#pragma unroll
                for (int j = 0; j < 4; ++j) { const int c0 = j * 256 + lane * 4; const f32x4 fw = *(const f32x4*)(p.final_w + c0); *(f32x4*)(row + c0) = v[j] * rstd * fw; }
            }
    }
}

#define XB_TMO      128
#define XB_XCNT(j)  (256  + 64 * (j))
#define XB_XSUB(j)  (1280 + 64 * (j))
#define XB_XGEN(j)  (2304 + 64 * (j))
#define XB_TOP      3328
#define XB_TOPGEN   3392
#define XCD_BAR_WORDS 3456
#define XB_SPIN_CAP (1u << 20)
__device__ __forceinline__ unsigned xb_ld(unsigned* p)              { return __hip_atomic_load(p, __ATOMIC_RELAXED, __HIP_MEMORY_SCOPE_AGENT); }
__device__ __forceinline__ unsigned xb_add(unsigned* p, unsigned v) { return __hip_atomic_fetch_add(p, v, __ATOMIC_RELAXED, __HIP_MEMORY_SCOPE_AGENT); }
__device__ __forceinline__ unsigned xb_xcc_id() { return (unsigned)__builtin_amdgcn_s_getreg((3 << 11) | 20) & 0xFu; }
#define XB_SPIN(cond, bar) do { unsigned _sp = 0; while (cond) { __builtin_amdgcn_s_sleep(1); \
    if ((++_sp & 255u) == 0u) { if (xb_ld(&(bar)[XB_TMO])) break; if (_sp > XB_SPIN_CAP) { atomicAdd(&(bar)[XB_TMO], 1u); break; } } } } while (0)
struct XcdBarrier { unsigned* bar; unsigned x; volatile LAS unsigned* st; };
__device__ __forceinline__ XcdBarrier xcd_barrier_post(unsigned* bar, volatile LAS unsigned* st) {
    XcdBarrier b; b.bar = bar; b.x = xb_xcc_id(); b.st = st;
    if (threadIdx.x == 0) (void)xb_add(&bar[XB_XCNT(b.x)], 1u);
    return b;
}
__device__ __forceinline__ void xcd_barrier_complete(unsigned* bar, unsigned x, unsigned& nloc, unsigned& nx) {
    const unsigned G = gridDim.x * gridDim.y * gridDim.z;
    unsigned sum, cnt, mine, sp = 0u;
    for (;;) {
        sum = 0u; cnt = 0u; mine = 0u;
#pragma unroll
        for (unsigned j = 0; j < 16; ++j) { const unsigned c = xb_ld(&bar[XB_XCNT(j)]); sum += c; cnt += (c > 0u) ? 1u : 0u; mine = (j == x) ? c : mine; }
        if (sum == G) break;
        __builtin_amdgcn_s_sleep(1);
        if ((++sp & 255u) == 0u) { if (xb_ld(&bar[XB_TMO])) break; if (sp > XB_SPIN_CAP) { atomicAdd(&bar[XB_TMO], 1u); break; } }
    }
    nloc = mine > 0u ? mine : 1u; nx = cnt > 0u ? cnt : 1u;
}
__device__ __forceinline__ void xcd_barrier(const XcdBarrier& b) {
    asm volatile("s_waitcnt vmcnt(0)" ::: "memory");
    __syncthreads();
    if (threadIdx.x == 0) {
        unsigned* bar = b.bar;
        __builtin_amdgcn_s_waitcnt(0);
        unsigned nloc = b.st[0], nx = b.st[1];
        if (nloc == 0u) { xcd_barrier_complete(bar, b.x, nloc, nx); b.st[0] = nloc; b.st[1] = nx; }
        const unsigned old = xb_add(&bar[XB_XSUB(b.x)], 1u);
        const unsigned gen = old / nloc;
        if (old + 1u == (gen + 1u) * nloc) {
            __builtin_amdgcn_fence(__ATOMIC_RELEASE, "agent");
            asm volatile("s_waitcnt vmcnt(0)" ::: "memory");
            const unsigned og = xb_add(&bar[XB_TOP], 1u);
            const unsigned tg = og / nx;
            if (og + 1u == (tg + 1u) * nx) xb_add(&bar[XB_TOPGEN], 1u);
            else XB_SPIN(xb_ld(&bar[XB_TOPGEN]) == tg, bar);
            __builtin_amdgcn_fence(__ATOMIC_ACQUIRE, "agent");
            xb_add(&bar[XB_XGEN(b.x)], 1u);
            asm volatile("s_waitcnt vmcnt(0)" ::: "memory");
        } else {
            XB_SPIN(xb_ld(&bar[XB_XGEN(b.x)]) == gen, bar);
            __builtin_amdgcn_fence(__ATOMIC_ACQUIRE, "agent");
            asm volatile("s_waitcnt vmcnt(0)" ::: "memory");
        }
    }
    __syncthreads();
}

constexpr int MISC_OFF = LDS_BYTES - 256;
constexpr int CW_BAR = 4096;
constexpr size_t CTL_ZERO_BYTES = 65536;
constexpr unsigned REPEAT_MASK = 0x0u;

__global__ void __launch_bounds__(NTHR, 2) mega_fwd(Params p) {
    extern __shared__ __attribute__((aligned(16))) unsigned char lds_raw[];
    LAS unsigned char* lds = (LAS unsigned char*)lds_raw;
    for (int u = threadIdx.x; u < 64; u += NTHR) ((LAS unsigned*)(lds + MISC_OFF))[u] = 0u;
    __syncthreads();
    XcdBarrier bar = xcd_barrier_post((unsigned*)(p.ws + WS_CTL) + CW_BAR, (volatile LAS unsigned*)(lds + MISC_OFF) + 8);
#define GRID_BAR() xcd_barrier(bar)
#define PHASE(k, ...) for (int rep_ = 0; rep_ <= (int)((REPEAT_MASK >> (k)) & 1u); ++rep_) { __VA_ARGS__; GRID_BAR(); }
    PHASE(0, phase_prologue(p, lds))
    PHASE(1, phase_u(p, lds))
    PHASE(2, { pg8::Gemm g{(const bf16*)(p.ws + WS_U), (const bf16*)(p.ws + WS_WIN_T), D, nullptr}; pg8::StaticOrder S; S.init(R_ALL, NPROJ, gridDim.x, blockIdx.x);
        pg8::EpiInProj E{p.ws, (const float*)(p.ws + WS_LB)};
        pg8::gemm_phase<pg8::EpiInProj, pg8::StaticOrder, true, false>(lds, g, S, E); })
    PHASE(3, phase_conv(p))
    PHASE(4, for (int item = blockIdx.x; item < 256; item += gridDim.x) sc::pass_a(p, lds, item))
    PHASE(5, for (int item = blockIdx.x; item < 256; item += gridDim.x) sc::pass_b(p, lds, item))
    PHASE(6, phase_mixprep(p))
    PHASE(7, { pg8::Gemm g{(const bf16*)(p.ws + WS_AMIX2), (const bf16*)(p.ws + WS_WOUT_T), D, nullptr}; pg8::StaticOrder S; S.init(R_X, D, gridDim.x, blockIdx.x);
        pg8::EpiOutProj E{p.x, p.out, (const float*)(p.ws + WS_MOD)};
        pg8::gemm_phase<pg8::EpiOutProj, pg8::StaticOrder, true, false>(lds, g, S, E); })
    PHASE(8, phase_vx(p, lds))
    PHASE(9, phase_topk(p, lds))
    PHASE(10, for (int w = blockIdx.x; w < 256; w += gridDim.x) {
        const int xcd = w & 7, idx = w >> 3, e = xcd * 2 + (idx >> 4), pm = e * 16 + (idx & 15);
        {   pg8::Gemm g{(const bf16*)(p.ws + WS_VX), (const bf16*)(p.ws + WS_WGU_T), D, (const int*)(p.ws + WS_ROWMAP)};
            pg8::PanelOrder S{pm, 8, (size_t)e * 2048 * 1024 * 2}; pg8::EpiMoE1 E{(bf16*)(p.ws + WS_H)};
            pg8::gemm_phase<pg8::EpiMoE1, pg8::PanelOrder, true, true>(lds, g, S, E); }
        VM_WAIT(); __syncthreads();
        if (threadIdx.x == 0) { __builtin_amdgcn_fence(__ATOMIC_ACQUIRE, "agent"); VM_WAIT(); }
        __syncthreads();
        {   pg8::Gemm g{(const bf16*)(p.ws + WS_H), (const bf16*)(p.ws + WS_WD_T), FF, nullptr};
            pg8::PanelOrder S{pm, 4, (size_t)e * 1024 * 1024 * 2}; pg8::EpiMoE2 E{(bf16*)(p.ws + WS_Y), (const float*)(p.ws + WS_GATEV)};
            pg8::gemm_phase<pg8::EpiMoE2, pg8::PanelOrder, true, false>(lds, g, S, E); }
    })
    phase_final(p);
}

extern "C" void kernel_launch(void* const* d_in, const int* in_sizes, int n_in, void* d_out, int out_size, void* d_ws, size_t ws_size, hipStream_t stream) {
    static int grid = 0;
    if (grid == 0) {
        if (n_in != 21 || out_size != R_X * D || ws_size < WS_END) { fprintf(stderr, "kernel_launch: unexpected shapes: n_in %d out %d ws %zu\n", n_in, out_size, ws_size); grid = -1; return; }
        int dev = 0, cus = 0, per_cu = 0;
        if (hipGetDevice(&dev) != hipSuccess || hipDeviceGetAttribute(&cus, hipDeviceAttributeMultiprocessorCount, dev) != hipSuccess) { grid = -1; return; }
        if (hipFuncSetAttribute((const void*)mega_fwd, hipFuncAttributeMaxDynamicSharedMemorySize, LDS_BYTES) != hipSuccess) { fprintf(stderr, "kernel_launch: hipFuncSetAttribute failed\n"); grid = -1; return; }
        if (hipOccupancyMaxActiveBlocksPerMultiprocessor(&per_cu, (const void*)mega_fwd, NTHR, LDS_BYTES) != hipSuccess || per_cu < 1) { fprintf(stderr, "kernel_launch: occupancy query says %d blocks/CU; nothing launched\n", per_cu); (void)hipGetLastError(); grid = -1; return; }
        grid = cus;
    }
    if (grid < 0) return;
    (void)hipMemsetAsync((char*)d_ws + WS_CTL, 0, CTL_ZERO_BYTES, stream);
    Params p{};
    const float** pp = (const float**)&p;
    for (int i = 0; i < 21; ++i) pp[i] = (const float*)d_in[i];
    p.out = (float*)d_out; p.ws = (unsigned char*)d_ws;
    hipLaunchKernelGGL(mega_fwd, dim3(grid), dim3(NTHR), LDS_BYTES, stream, p);
}
```

```cpp
#include <hip/hip_runtime.h>
#include <cstdio>
#include <cstdint>

#define GAS __attribute__((address_space(1)))
#define LAS __attribute__((address_space(3)))
typedef unsigned short bf16;
typedef float f32x4 __attribute__((ext_vector_type(4)));
typedef float f32x2 __attribute__((ext_vector_type(2)));
typedef unsigned u32x4 __attribute__((ext_vector_type(4)));
typedef unsigned u32x2 __attribute__((ext_vector_type(2)));
typedef short bf16x8 __attribute__((ext_vector_type(8)));
typedef __bf16 bf16x2_t __attribute__((ext_vector_type(2)));
typedef _Float16 f16x2_t __attribute__((ext_vector_type(2)));

constexpr int D = 1024, NB = 4, SEQ = 8192, CTX = 256, SROW = SEQ + CTX, R_ALL = NB * SROW, R_X = NB * SEQ;
constexpr int PROJ = 4624, NPROJ = 4608;
constexpr int NE = 16, CAP = 1024, FF = 1024, R_MOE = NE * NB * CAP;
constexpr float EPS = 1e-6f;
constexpr int NTHR = 512, NWAVES = 8;
constexpr int LDS_BYTES = 147456;

constexpr size_t MiB = 1u << 20;
constexpr size_t WS_CTL = 0;
constexpr size_t WS_MODP = 1 * MiB;
constexpr size_t WS_MOD = 3 * MiB;
constexpr size_t WS_LB = WS_MOD + 128 * 1024;
constexpr size_t WS_WGT = WS_LB + 4096;
constexpr size_t WS_RWT = WS_WGT + 65536;
constexpr size_t WS_WIN_T = 4 * MiB;
constexpr size_t WS_WOUT_T = 13 * MiB;
constexpr size_t WS_GATES = 15 * MiB;
constexpr size_t WS_WGU_T = 18 * MiB;
constexpr size_t WS_WD_T = 82 * MiB;
constexpr size_t WS_U = 114 * MiB;
constexpr size_t WS_HQ = 180 * MiB;
constexpr size_t WS_HV = 213 * MiB;
constexpr size_t WS_HG = 246 * MiB;
constexpr size_t WS_LF = 279 * MiB;
constexpr size_t WS_QK = 345 * MiB;
constexpr size_t WS_MV = 411 * MiB;
constexpr size_t WS_MO = 444 * MiB;
constexpr size_t WS_AFF = 477 * MiB;
constexpr size_t WS_ROWMAP = 479 * MiB;
constexpr size_t WS_GATEV = WS_ROWMAP + 262144;
constexpr size_t WS_SLOT = 480 * MiB;
constexpr size_t WS_SEG = 484 * MiB;
constexpr size_t WS_SCB = 502 * MiB;
constexpr size_t WS_SCG = 504 * MiB;
constexpr size_t WS_SCM = 506 * MiB;
constexpr size_t WS_END = 512 * MiB;
constexpr size_t WS_QKC = WS_U;
constexpr size_t WS_AMIX2 = WS_LF;
constexpr size_t WS_VX = WS_U;
constexpr size_t WS_H = WS_HQ;
constexpr size_t WS_Y = 308 * MiB;

struct Params {
    const float *x, *c, *ctx, *c_ctx, *ada_w, *ada_b, *norm1_w, *w_in, *conv_w, *conv_b, *lb_logits, *ml_gate_b, *hg_norm_w, *ml_norm_w, *w_out, *norm2_w,
        *router_w, *wg, *wu, *wd, *final_w;
    float* out; unsigned char* ws;
};

__device__ __forceinline__ unsigned pk2(float lo, float hi) { f32x2 v = {lo, hi}; bf16x2_t b = __builtin_convertvector(v, bf16x2_t); return __builtin_bit_cast(unsigned, b); }
__device__ __forceinline__ unsigned pkh2(float lo, float hi) { f32x2 v = {lo, hi}; f16x2_t b = __builtin_convertvector(v, f16x2_t); return __builtin_bit_cast(unsigned, b); }
__device__ __forceinline__ float bf2f(unsigned short b) { return __uint_as_float((unsigned)b << 16); }
__device__ __forceinline__ float bflo(unsigned w) { return __uint_as_float(w << 16); }
__device__ __forceinline__ float bfhi(unsigned w) { return __uint_as_float(w & 0xffff0000u); }
__device__ __forceinline__ float h2f(unsigned short h) { return (float)__builtin_bit_cast(_Float16, h); }
__device__ __forceinline__ float sigmoid_(float x) { return __builtin_amdgcn_rcpf(1.0f + __expf(-x)); }
__device__ __forceinline__ float silu_(float x) { return x * sigmoid_(x); }
__device__ __forceinline__ float wave_sum(float v) {
#pragma unroll
    for (int o = 1; o < 64; o <<= 1) v += __shfl_xor(v, o);
    return v;
}
__device__ __forceinline__ int tid_opaque() { int t = threadIdx.x; asm volatile("" : "+v"(t)); return t; }
__device__ __forceinline__ float butterfly16(const float (&a)[16], int lane) {
    const bool h5 = (lane & 32) != 0, h4 = (lane & 16) != 0, h3 = (lane & 8) != 0, h2 = (lane & 4) != 0;
    float b8[8], b4[4], b2[2];
#pragma unroll
    for (int e = 0; e < 8; ++e) { const float keep = h5 ? a[e + 8] : a[e], send = h5 ? a[e] : a[e + 8]; b8[e] = keep + __shfl_xor(send, 32); }
#pragma unroll
    for (int e = 0; e < 4; ++e) { const float keep = h4 ? b8[e + 4] : b8[e], send = h4 ? b8[e] : b8[e + 4]; b4[e] = keep + __shfl_xor(send, 16); }
#pragma unroll
    for (int e = 0; e < 2; ++e) { const float keep = h3 ? b4[e + 2] : b4[e], send = h3 ? b4[e] : b4[e + 2]; b2[e] = keep + __shfl_xor(send, 8); }
    const float keep = h2 ? b2[1] : b2[0], send = h2 ? b2[0] : b2[1];
    float r = keep + __shfl_xor(send, 4);
    r += __shfl_xor(r, 2); r += __shfl_xor(r, 1);
    return r;
}
#define LDS_WAIT() asm volatile("s_waitcnt lgkmcnt(0)" ::: "memory")
#define VM_WAIT() asm volatile("s_waitcnt vmcnt(0)" ::: "memory")

namespace pg8 {
constexpr int BM = 256, BK = 64, HALF = 128, HTB = HALF * BK * 2, STAGE_BYTES = 8 * HTB, NXCD = 8, WGM = 8;
__host__ __device__ __forceinline__ int lds_byte(int r, int c) { const int st = (r >> 4) * 2 + (c >> 5), rr = r & 15, cc = c & 31, ob = rr * 64 + cc * 2; return st * 1024 + (ob ^ (((ob >> 9) & 1) << 5)); }
__host__ __device__ __forceinline__ void stage_rc(int b, int& R, int& C) { const int st = b / 1024, sb = b % 1024, swz = sb ^ (((sb >> 9) & 1) << 5); R = (st >> 1) * 16 + swz / 64; C = (st & 1) * 32 + (swz % 64) / 2; }
__host__ __device__ __forceinline__ int perm32(int rho) { const int n = rho >> 4, i = rho & 15; return 8 * (i >> 2) + 4 * n + (i & 3); }

struct Unit { int pm, pn; size_t boff; };
struct Gemm { const bf16* A; const bf16* Bt; int K; const int* rowmap; };

struct StaticOrder {
    int nM, nN, nwg, G, c;
    __device__ void init(int M, int N, int G_, int c_) { nM = M / BM; nN = N / BM; nwg = nM * nN; G = G_; c = c_; }
    __device__ bool next(int i, Unit& u) const {
        const long L = (long)i * G + c; if (L >= nwg) return false;
        int wgid = (int)L; { const int q = nwg / NXCD, r = nwg % NXCD, xcd = wgid % NXCD, off = wgid / NXCD; wgid = (xcd < r ? xcd * (q + 1) : r * (q + 1) + (xcd - r) * q) + off; }
        const int nig = WGM * nN, gid = wgid / nig, fm = gid * WGM, gsz = (nM - fm) < WGM ? (nM - fm) : WGM;
        u.pm = fm + ((wgid % nig) % gsz); u.pn = (wgid % nig) / gsz; u.boff = 0; return true;
    }
};
struct PanelOrder {
    int pm, npn; size_t boff;
    __device__ bool next(int i, Unit& u) const { if (i >= npn) return false; u.pm = pm; u.pn = i; u.boff = boff; return true; }
};

template <class Epi, class Sched, bool ALIGN_EPI, bool GATHER>
__device__ __forceinline__ void gemm_phase(LAS unsigned char* lds, const Gemm g, const Sched& S, const Epi& E) {
    const int tid = tid_opaque(), wid = __builtin_amdgcn_readfirstlane(tid >> 6), lane = tid & 63, wr = wid >> 2, wc = wid & 3, fr = lane & 15, fq = lane >> 4;
    const int K = g.K, nt = K / BK;
    Unit cur, nxt; int ui = 0;
    if (!S.next(0, cur)) return;
    const size_t kstep = (size_t)(BK * 2);
    const size_t hstep = (size_t)HALF * K * 2;
    const size_t tstep = 2 * hstep;
    unsigned voffA[2][2], voffB[2];
#pragma unroll
    for (int i = 0; i < 2; ++i) { int R, C; stage_rc(tid * 16 + i * 8192, R, C); const int Rb = Epi::PERM ? ((R & ~31) + perm32(R & 31)) : R;
        voffB[i] = (unsigned)(Rb * K + C) * 2u;
#pragma unroll
        for (int h = 0; h < 2; ++h) {
            if (GATHER) voffA[h][i] = (unsigned)g.rowmap[cur.pm * BM + h * HALF + R] * (unsigned)(K * 2) + (unsigned)C * 2u;
            else voffA[h][i] = (unsigned)(R * K + C) * 2u + (unsigned)(h * hstep);
        } }
    const unsigned ldsw = (unsigned)wid * 1024u;
    const int aoff = lds_byte(wr * 64 + fr, fq * 8), boff = lds_byte(wc * 32 + fr, fq * 8);
#define PG8_SA(b, h) (((b) * 2 + (h)) * HTB)
#define PG8_SB(b, h) ((4 + (b) * 2 + (h)) * HTB)
#define PG8_STAGE_A(bufoff, gbase, h) do { _Pragma("unroll") for (int _i = 0; _i < 2; ++_i) \
        __builtin_amdgcn_global_load_lds((const unsigned*)((const char*)(gbase) + voffA[h][_i]), (LAS unsigned*)(lds + (bufoff) + ldsw + _i * 8192), 16, 0, 0); } while (0)
#define PG8_STAGE_B(bufoff, gbase) do { _Pragma("unroll") for (int _i = 0; _i < 2; ++_i) \
        __builtin_amdgcn_global_load_lds((const unsigned*)((const char*)(gbase) + voffB[_i]), (LAS unsigned*)(lds + (bufoff) + ldsw + _i * 8192), 16, 0, 0); } while (0)
#define PG8_LDA(dst, b, h) do { _Pragma("unroll") for (int m = 0; m < 4; ++m) _Pragma("unroll") for (int k = 0; k < 2; ++k) dst[m][k] = *(const LAS bf16x8*)(lds + PG8_SA(b, h) + aoff + m * 2048 + k * 1024); } while (0)
#define PG8_LDB(dst, b, h) do { _Pragma("unroll") for (int n = 0; n < 2; ++n) _Pragma("unroll") for (int k = 0; k < 2; ++k) dst[n][k] = *(const LAS bf16x8*)(lds + PG8_SB(b, h) + boff + n * 2048 + k * 1024); } while (0)
#define PG8_MMA(ai, bj, At, Bt) do { __builtin_amdgcn_s_setprio(1); _Pragma("unroll") for (int m = 0; m < 4; ++m) _Pragma("unroll") for (int n = 0; n < 2; ++n) _Pragma("unroll") for (int k = 0; k < 2; ++k) \
        acc[ai][bj][m][n] = __builtin_amdgcn_mfma_f32_16x16x32_bf16(Bt[n][k], At[m][k], acc[ai][bj][m][n], 0, 0, 0); __builtin_amdgcn_s_setprio(0); } while (0)
#define PG8_WAIT_V(n) asm volatile("s_waitcnt vmcnt(" #n ")" ::: "memory")
#define PG8_WAIT_L(n) asm volatile("s_waitcnt lgkmcnt(" #n ")" ::: "memory")
#define PG8_BAR __builtin_amdgcn_s_barrier()
#define PG8_SCHED __builtin_amdgcn_sched_barrier(0)
    f32x4 acc[2][2][4][2];
#pragma unroll
    for (int a = 0; a < 2; ++a)
#pragma unroll
        for (int b = 0; b < 2; ++b)
#pragma unroll
            for (int m = 0; m < 4; ++m)
#pragma unroll
                for (int n = 0; n < 2; ++n) acc[a][b][m][n] = (f32x4){0.f, 0.f, 0.f, 0.f};
    bf16x8 At[4][2], B0[2][2], B1[2][2];
    const char* cA = GATHER ? (const char*)g.A : (const char*)g.A + (size_t)cur.pm * tstep;
    const char* cB = (const char*)g.Bt + cur.boff + (size_t)cur.pn * tstep;
    if (GATHER) VM_WAIT();
    PG8_STAGE_B(PG8_SB(0, 0), cB); PG8_STAGE_B(PG8_SB(0, 1), cB + hstep); PG8_STAGE_A(PG8_SA(0, 0), cA, 0); PG8_STAGE_A(PG8_SA(0, 1), cA, 1);
    if (wr == 1) PG8_BAR;
    PG8_WAIT_V(2); PG8_BAR;
    PG8_STAGE_B(PG8_SB(1, 0), cB + kstep); PG8_STAGE_A(PG8_SA(1, 0), cA + kstep, 0); PG8_STAGE_B(PG8_SB(1, 1), cB + hstep + kstep);
    PG8_WAIT_V(6); PG8_BAR;
    for (;;) {
        const bool has_next = S.next(ui + 1, nxt);
        const char* nA = has_next ? (GATHER ? (const char*)g.A : (const char*)g.A + (size_t)nxt.pm * tstep) : cA;
        const char* nB = has_next ? (const char*)g.Bt + nxt.boff + (size_t)nxt.pn * tstep : cB;
        for (int t = 0; t < nt; t += 2) {
            const bool last = (t == nt - 2);
            const char* a1 = cA + (size_t)(t + 1) * kstep;
            const char* a2 = last ? nA : cA + (size_t)(t + 2) * kstep; const char* b2 = last ? nB : cB + (size_t)(t + 2) * kstep;
            const char* a3 = a2 + kstep; const char* b3 = b2 + kstep;
            PG8_LDB(B0, 0, 0); PG8_LDB(B1, 0, 1); PG8_SCHED; PG8_LDA(At, 0, 0); PG8_STAGE_A(PG8_SA(1, 1), a1, 1);
            PG8_WAIT_V(8); PG8_WAIT_L(0); PG8_BAR; PG8_MMA(0, 0, At, B0); PG8_MMA(0, 1, At, B1); PG8_BAR; PG8_SCHED;
            PG8_LDA(At, 0, 1); PG8_STAGE_B(PG8_SB(0, 0), b2); PG8_STAGE_B(PG8_SB(0, 1), b2 + hstep); PG8_STAGE_A(PG8_SA(0, 0), a2, 0);
            PG8_WAIT_V(8); PG8_WAIT_L(0); PG8_BAR; PG8_MMA(1, 0, At, B0); PG8_MMA(1, 1, At, B1); PG8_BAR; PG8_SCHED;
            PG8_LDB(B0, 1, 0); PG8_LDB(B1, 1, 1); PG8_SCHED; PG8_LDA(At, 1, 0); PG8_STAGE_A(PG8_SA(0, 1), a2, 1);
            PG8_WAIT_V(8); PG8_WAIT_L(0); PG8_BAR; PG8_MMA(0, 0, At, B0); PG8_MMA(0, 1, At, B1); PG8_BAR; PG8_SCHED;
            PG8_LDA(At, 1, 1); PG8_STAGE_B(PG8_SB(1, 0), b3); PG8_STAGE_B(PG8_SB(1, 1), b3 + hstep); PG8_STAGE_A(PG8_SA(1, 0), a3, 0);
            PG8_WAIT_V(8); PG8_WAIT_L(0); PG8_BAR; PG8_MMA(1, 0, At, B0); PG8_MMA(1, 1, At, B1); PG8_BAR; PG8_SCHED;
        }
        if constexpr (ALIGN_EPI) { if (wr == 0) PG8_BAR; }
        E(acc, cur, wr, wc, fr, fq);
        if (!has_next) break;
#pragma unroll
        for (int a = 0; a < 2; ++a)
#pragma unroll
            for (int b = 0; b < 2; ++b)
#pragma unroll
                for (int m = 0; m < 4; ++m)
#pragma unroll
                    for (int n = 0; n < 2; ++n) acc[a][b][m][n] = (f32x4){0.f, 0.f, 0.f, 0.f};
        cur = nxt; cA = nA; cB = nB; ++ui;
        if constexpr (ALIGN_EPI) { if (wr == 1) PG8_BAR; }
    }
    PG8_WAIT_V(0);
    if constexpr (!ALIGN_EPI) { if (wr == 0) PG8_BAR; }
    PG8_BAR;
#undef PG8_SA
#undef PG8_SB
#undef PG8_STAGE_A
#undef PG8_STAGE_B
#undef PG8_LDA
#undef PG8_LDB
#undef PG8_MMA
#undef PG8_WAIT_V
#undef PG8_WAIT_L
#undef PG8_BAR
#undef PG8_SCHED
}

struct EpiInProj {
    static constexpr bool PERM = true;
    unsigned char* ws; const float* lb;
    __device__ __forceinline__ void operator()(const f32x4 (&acc)[2][2][4][2], const Unit& u, int wr, int wc, int fr_, int fq) const {
        int fr = fr_; asm volatile("" : "+v"(fr));
        const int pn = u.pn; size_t base; int ld, colbase, act, hm;
        if (pn < 2) { base = WS_HQ; ld = 512; colbase = pn * 256; act = 1; hm = 1; }
        else if (pn < 4) { base = WS_HV; ld = 512; colbase = (pn - 2) * 256; act = 0; hm = 1; }
        else if (pn < 6) { base = WS_HG; ld = 512; colbase = (pn - 4) * 256; act = 1; hm = 0; }
        else if (pn < 10) { base = WS_LF; ld = 1024; colbase = (pn - 6) * 256; act = 3; hm = 2; }
        else if (pn < 14) { base = WS_QK; ld = 1024; colbase = (pn - 10) * 256; act = 0; hm = 0; }
        else if (pn < 16) { base = WS_MV; ld = 512; colbase = (pn - 14) * 256; act = 0; hm = 1; }
        else { base = WS_MO; ld = 512; colbase = (pn - 16) * 256; act = 2; hm = 0; }
        bf16* O = (bf16*)(ws + base);
        const int bb = u.pm / 33, s0 = (u.pm % 33) * BM + wr * 64 + fr;
        const int row0 = u.pm * BM + wr * 64 + fr, col0 = colbase + wc * 32 + 8 * fq;
#pragma unroll
        for (int bj = 0; bj < 2; ++bj) {
            float lbv[8];
            const int cf = col0 + bj * HALF;
            if (act == 3) {
#pragma unroll
                for (int e = 0; e < 8; ++e) lbv[e] = lb[cf + e];
            }
            const size_t hbase = (hm == 2) ? ((size_t)((bb * 2 + (cf >> 9)) * 4 + ((cf >> 7) & 3)) * SROW) : ((size_t)(bb * 4 + (cf >> 7)) * SROW);
#pragma unroll
            for (int ai = 0; ai < 2; ++ai)
#pragma unroll
                for (int m = 0; m < 4; ++m) {
                    float v[8];
#pragma unroll
                    for (int e = 0; e < 4; ++e) { v[e] = acc[ai][bj][m][0][e]; v[4 + e] = acc[ai][bj][m][1][e]; }
                    u32x4 w;
                    if (act == 3) {
#pragma unroll
                        for (int e = 0; e < 8; ++e) v[e] = __logf(lbv[e] + (1.0f - lbv[e]) * sigmoid_(v[e]));
                        w.x = pkh2(v[0], v[1]); w.y = pkh2(v[2], v[3]); w.z = pkh2(v[4], v[5]); w.w = pkh2(v[6], v[7]);
                    } else {
                        if (act == 1) {
#pragma unroll
                            for (int e = 0; e < 8; ++e) v[e] = silu_(v[e]);
                        } else if (act == 2) {
#pragma unroll
                            for (int e = 0; e < 8; ++e) v[e] = sigmoid_(v[e]);
                        }
                        w.x = pk2(v[0], v[1]); w.y = pk2(v[2], v[3]); w.z = pk2(v[4], v[5]); w.w = pk2(v[6], v[7]);
                    }
                    const size_t off = hm ? (hbase + (size_t)(s0 + ai * HALF + m * 16)) * 128 + (cf & 127) : (size_t)(row0 + ai * HALF + m * 16) * ld + cf;
                    *(u32x4*)(O + off) = w;
                }
        }
    }
};
struct EpiOutProj {
    static constexpr bool PERM = false;
    const float* x; float* out; const float* mod;
    __device__ __forceinline__ void operator()(const f32x4 (&acc)[2][2][4][2], const Unit& u, int wr, int wc, int fr_, int fq) const {
        int fr = fr_; asm volatile("" : "+v"(fr));
        const int row0 = u.pm * BM + wr * 64 + fr, col0 = u.pn * BM + wc * 32 + 4 * fq;
        const float* g1 = mod + (size_t)(u.pm / 32) * 6144 + 2048;
#pragma unroll
        for (int bj = 0; bj < 2; ++bj)
#pragma unroll
            for (int n = 0; n < 2; ++n) {
                const int c = col0 + bj * HALF + n * 16; const f32x4 gv = *(const f32x4*)(g1 + c);
#pragma unroll
                for (int ai = 0; ai < 2; ++ai)
#pragma unroll
                    for (int m = 0; m < 4; ++m) { const size_t off = (size_t)(row0 + ai * HALF + m * 16) * D + c;
                        *(f32x4*)(out + off) = *(const f32x4*)(x + off) + gv * acc[ai][bj][m][n]; }
            }
    }
};
struct EpiMoE1 {
    static constexpr bool PERM = true;
    bf16* H;
    __device__ __forceinline__ void operator()(const f32x4 (&acc)[2][2][4][2], const Unit& u, int wr, int wc, int fr_, int fq) const {
        int fr = fr_; asm volatile("" : "+v"(fr));
        const int row0 = u.pm * BM + wr * 64 + fr, col0 = u.pn * HALF + wc * 32 + 8 * fq;
#pragma unroll
        for (int ai = 0; ai < 2; ++ai)
#pragma unroll
            for (int m = 0; m < 4; ++m) {
                float v[8];
#pragma unroll
                for (int e = 0; e < 4; ++e) { v[e] = silu_(acc[ai][0][m][0][e]) * acc[ai][1][m][0][e]; v[4 + e] = silu_(acc[ai][0][m][1][e]) * acc[ai][1][m][1][e]; }
                u32x4 w; w.x = pk2(v[0], v[1]); w.y = pk2(v[2], v[3]); w.z = pk2(v[4], v[5]); w.w = pk2(v[6], v[7]);
                *(u32x4*)(H + (size_t)(row0 + ai * HALF + m * 16) * FF + col0) = w;
            }
    }
};
struct EpiMoE2 {
    static constexpr bool PERM = true;
    bf16* Y; const float* gatev;
    __device__ __forceinline__ void operator()(const f32x4 (&acc)[2][2][4][2], const Unit& u, int wr, int wc, int fr_, int fq) const {
        int fr = fr_; asm volatile("" : "+v"(fr));
        const int row0 = u.pm * BM + wr * 64 + fr, col0 = u.pn * BM + wc * 32 + 8 * fq;
#pragma unroll
        for (int ai = 0; ai < 2; ++ai)
#pragma unroll
            for (int m = 0; m < 4; ++m) { const int row = row0 + ai * HALF + m * 16; const float gt = gatev[row];
#pragma unroll
                for (int bj = 0; bj < 2; ++bj) { const f32x4 a = acc[ai][bj][m][0] * gt, b = acc[ai][bj][m][1] * gt;
                    u32x4 w; w.x = pk2(a[0], a[1]); w.y = pk2(a[2], a[3]); w.z = pk2(b[0], b[1]); w.w = pk2(b[2], b[3]);
                    *(u32x4*)(Y + (size_t)row * D + col0 + bj * HALF) = w; } }
    }
};
}

__device__ __forceinline__ void transpose_item(const float* W, int ldw, int k0, int n0, bf16* dst_row0, LAS float* scr, int lane) {
#pragma unroll 8
    for (int i = 0; i < 32; ++i) { const int kk = 2 * i + (lane >> 5); scr[kk * 33 + (lane & 31)] = W[(size_t)(k0 + kk) * ldw + n0 + (lane & 31)]; }
    LDS_WAIT(); asm volatile("" ::: "memory");
    const int c = lane & 7;
#pragma unroll
    for (int j = 0; j < 4; ++j) { const int n = (lane >> 3) + 8 * j; const LAS float* s = scr + (8 * c) * 33 + n;
        u32x4 o; o.x = pk2(s[0 * 33], s[1 * 33]); o.y = pk2(s[2 * 33], s[3 * 33]); o.z = pk2(s[4 * 33], s[5 * 33]); o.w = pk2(s[6 * 33], s[7 * 33]);
        *(u32x4*)(dst_row0 + (size_t)n * 1024 + k0 + 8 * c) = o; }
    LDS_WAIT(); asm volatile("" ::: "memory");
}
__device__ __forceinline__ void phase_prologue(const Params& p, LAS unsigned char* lds) {
    const int tid = tid_opaque(), lane = tid & 63, wave = tid >> 6;
    const int gw = blockIdx.x * NWAVES + wave, NGW = gridDim.x * NWAVES;
    LAS float* scr = (LAS float*)(lds + wave * 16384);
    constexpr int I_IN = 16 * 144, I_OUT = 16 * 32, I_E = 16 * 512, I_MOD = 24 * 16;
    constexpr int NITEMS = I_IN + I_OUT + 3 * I_E + I_MOD;
    unsigned char* ws = p.ws;
    for (int it = gw; it < NITEMS; it += NGW) {
        int r = it;
        if (r < I_IN) { const int kb = r / 144, nb = r % 144; transpose_item(p.w_in, PROJ, kb * 64, nb * 32, (bf16*)(ws + WS_WIN_T) + (size_t)(nb * 32) * 1024, scr, lane); continue; } r -= I_IN;
        if (r < I_OUT) { const int kb = r / 32, nb = r % 32; transpose_item(p.w_out, D, kb * 64, nb * 32, (bf16*)(ws + WS_WOUT_T) + (size_t)(nb * 32) * 1024, scr, lane); continue; } r -= I_OUT;
        if (r < 2 * I_E) { const int up = r / I_E; r -= up * I_E; const int e = r / 512, q = r % 512, kb = q / 32, nb = q % 32, n0 = nb * 32;
            const int drow = (n0 / 128) * 256 + up * 128 + (n0 % 128);
            transpose_item((up ? p.wu : p.wg) + (size_t)e * D * FF, FF, kb * 64, n0, (bf16*)(ws + WS_WGU_T) + ((size_t)e * 2048 + drow) * 1024, scr, lane); continue; } r -= 2 * I_E;
        if (r < I_E) { const int e = r / 512, q = r % 512, kb = q / 32, nb = q % 32;
            transpose_item(p.wd + (size_t)e * FF * D, D, kb * 64, nb * 32, (bf16*)(ws + WS_WD_T) + ((size_t)e * 1024 + nb * 32) * 1024, scr, lane); continue; } r -= I_E;
        {
            const int cb = r / 16, ks = r % 16; const int col = cb * 256 + lane * 4;
            f32x4 a[5];
            float sv[5];
#pragma unroll
            for (int q = 0; q < 5; ++q) { a[q] = (f32x4){0.f, 0.f, 0.f, 0.f}; const float cv = (q < 4) ? p.c[q * D + ks * 64 + lane] : p.c_ctx[ks * 64 + lane]; sv[q] = silu_(cv); }
#pragma unroll 8
            for (int kk = 0; kk < 64; ++kk) {
                const f32x4 w = *(const f32x4*)(p.ada_w + (size_t)(ks * 64 + kk) * 6144 + col);
#pragma unroll
                for (int q = 0; q < 5; ++q) a[q] += w * __uint_as_float((unsigned)__builtin_amdgcn_readlane((int)__float_as_uint(sv[q]), kk));
            }
            float* mp = (float*)(ws + WS_MODP);
#pragma unroll
            for (int q = 0; q < 5; ++q) *(f32x4*)(mp + ((size_t)ks * 5 + q) * 6144 + col) = a[q];
        }
    }
    const int gt = blockIdx.x * NTHR + tid, NGT = gridDim.x * NTHR;
    for (int i = gt; i < 1024; i += NGT) { const float l0 = p.lb_logits[i], l1 = p.lb_logits[1024 + i]; ((float*)(ws + WS_LB))[i] = 1.0f / (1.0f + __expf(l1 - l0)); }
    for (int i = gt; i < 16 * 1024; i += NGT) { const int g = i >> 10, k = i & 1023; ((float*)(ws + WS_WGT))[i] = p.w_in[(size_t)k * PROJ + NPROJ + g]; ((float*)(ws + WS_RWT))[i] = p.router_w[k * 16 + g]; }
}

__device__ __forceinline__ void phase_u(const Params& p, LAS unsigned char* lds) {
    const int tid = tid_opaque(), lane = tid & 63, wave = tid >> 6;
    unsigned char* ws = p.ws;
    LAS float* Lsh = (LAS float*)lds;
    LAS float* Lsc = Lsh + 5 * 1024;
    LAS float* Lnw = Lsc + 5 * 1024;
    LAS float* Lwg = Lnw + 1024;
    const float* modp = (const float*)(ws + WS_MODP);
    for (int idx = tid; idx < 5 * 2048; idx += NTHR) { const int r = idx / 2048, col = idx % 2048; float s = p.ada_b[col];
        for (int ks = 0; ks < 16; ++ks) s += modp[((size_t)ks * 5 + r) * 6144 + col];
        if (col < 1024) Lsh[r * 1024 + col] = s; else Lsc[r * 1024 + col - 1024] = s; }
    for (int e = blockIdx.x * NTHR + tid; e < 5 * 6144; e += gridDim.x * NTHR) { const int r = e / 6144, col = e % 6144; float s = p.ada_b[col];
        for (int ks = 0; ks < 16; ++ks) s += modp[((size_t)ks * 5 + r) * 6144 + col];
        ((float*)(ws + WS_MOD))[e] = s; }
    for (int i = tid; i < 1024; i += NTHR) Lnw[i] = p.norm1_w[i];
    for (int i = tid; i < 16 * 1024; i += NTHR) Lwg[i] = ((const float*)(ws + WS_WGT))[i];
    __syncthreads();
    const int gw = blockIdx.x * NWAVES + wave, NGW = gridDim.x * NWAVES;
    for (int row = gw; row < R_ALL; row += NGW) {
        const int b = row / SROW, s = row % SROW;
        const float* src = (s < CTX) ? p.ctx + ((size_t)b * CTX + s) * D : p.x + ((size_t)b * SEQ + (s - CTX)) * D;
        const int r = (s < CTX) ? 4 : b;
        f32x4 v[4]; float ss = 0.f;
#pragma unroll
        for (int j = 0; j < 4; ++j) { v[j] = *(const f32x4*)(src + j * 256 + lane * 4); ss += (v[j].x * v[j].x + v[j].y * v[j].y) + (v[j].z * v[j].z + v[j].w * v[j].w); }
        const float rstd = rsqrtf(wave_sum(ss) * (1.0f / D) + EPS);
        bf16* urow = (bf16*)(ws + WS_U) + (size_t)row * D;
#pragma unroll
        for (int j = 0; j < 4; ++j) { const int c0 = j * 256 + lane * 4;
            const f32x4 nw = *(const LAS f32x4*)(Lnw + c0), sc = *(const LAS f32x4*)(Lsc + r * 1024 + c0), sh = *(const LAS f32x4*)(Lsh + r * 1024 + c0);
            v[j] = v[j] * rstd * nw * (1.0f + sc) + sh;
            u32x2 w; w.x = pk2(v[j].x, v[j].y); w.y = pk2(v[j].z, v[j].w); *(u32x2*)(urow + c0) = w; }
        float pa[16];
#pragma unroll
        for (int g = 0; g < 16; ++g) { float a = 0.f;
#pragma unroll
            for (int j = 0; j < 4; ++j) { const f32x4 w = *(const LAS f32x4*)(Lwg + g * 1024 + j * 256 + lane * 4); a += (v[j].x * w.x + v[j].y * w.y) + (v[j].z * w.z + v[j].w * w.w); }
            pa[g] = a; if (g & 1) __builtin_amdgcn_sched_barrier(0); }
        const float mine = butterfly16(pa, lane);
        if ((lane & 3) == 0) { const int gi = lane >> 2; float gv = mine + p.ml_gate_b[gi];
            if ((gi >> 2) & 1) gv = fminf(gv, 0.f) - log1pf(__expf(-fabsf(gv)));
            ((float*)(ws + WS_GATES))[(size_t)row * 16 + gi] = gv; }
    }
}

__device__ __forceinline__ void phase_conv(const Params& p) {
    unsigned char* ws = p.ws;
    const bf16* QK = (const bf16*)(ws + WS_QK); bf16* QKC = (bf16*)(ws + WS_QKC);
    const long total = (long)R_ALL * 128;
    const int tid0 = tid_opaque();
    for (long it = (long)blockIdx.x * NTHR + tid0; it < total; it += (long)gridDim.x * NTHR) {
        const int row = (int)(it >> 7), ch = (int)(it & 127) * 8;
        const int b = row / SROW, s = row % SROW;
        float a[8];
#pragma unroll
        for (int e = 0; e < 8; ++e) a[e] = p.conv_b[ch + e];
        if (s < CTX) {
#pragma unroll
            for (int j = 0; j < 3; ++j) { const int s2 = s + j - 1; if (s2 < 0 || s2 >= CTX) continue;
                const u32x4 w = *(const u32x4*)(QK + ((size_t)b * SROW + s2) * 1024 + ch); const float* cw = p.conv_w + (size_t)(3 + j) * 1024 + ch;
                a[0] += bflo(w.x) * cw[0]; a[1] += bfhi(w.x) * cw[1]; a[2] += bflo(w.y) * cw[2]; a[3] += bfhi(w.y) * cw[3];
                a[4] += bflo(w.z) * cw[4]; a[5] += bfhi(w.z) * cw[5]; a[6] += bflo(w.w) * cw[6]; a[7] += bfhi(w.w) * cw[7]; }
        } else {
            const int t = s - CTX, gr = t >> 6, gc = t & 63;
#pragma unroll
            for (int i = 0; i < 3; ++i) { const int r2 = gr + i - 1; if (r2 < 0 || r2 >= 128) continue;
#pragma unroll
                for (int j = 0; j < 3; ++j) { const int c2 = gc + j - 1; if (c2 < 0 || c2 >= 64) continue;
                    const u32x4 w = *(const u32x4*)(QK + ((size_t)b * SROW + CTX + r2 * 64 + c2) * 1024 + ch); const float* cw = p.conv_w + (size_t)(i * 3 + j) * 1024 + ch;
                    a[0] += bflo(w.x) * cw[0]; a[1] += bfhi(w.x) * cw[1]; a[2] += bflo(w.y) * cw[2]; a[3] += bfhi(w.y) * cw[3];
                    a[4] += bflo(w.z) * cw[4]; a[5] += bfhi(w.z) * cw[5]; a[6] += bflo(w.w) * cw[6]; a[7] += bfhi(w.w) * cw[7]; } }
        }
        const float sc = (ch >= 512) ? 0.08838834764831845f : 1.0f;
#pragma unroll
        for (int e = 0; e < 8; ++e) a[e] = silu_(a[e]) * sc;
        u32x4 o; o.x = pk2(a[0], a[1]); o.y = pk2(a[2], a[3]); o.z = pk2(a[4], a[5]); o.w = pk2(a[6], a[7]);
        *(u32x4*)(QKC + (size_t)(ch >> 9) * ((size_t)R_ALL * 512) + ((size_t)(b * 4 + ((ch >> 7) & 3)) * SROW + s) * 128 + (ch & 127)) = o;
    }
    {
        const int lane = tid0 & 63, gw = blockIdx.x * NWAVES + (tid0 >> 6), NGW = gridDim.x * NWAVES;
        for (int it = gw; it < 32 * 132; it += NGW) {
            const int chain = it / 132, ck = it % 132, dir = chain >> 4, b = (chain >> 2) & 3, h = chain & 3;
            const int n = ck * 64 + lane, s = dir ? (n < CTX ? CTX - 1 - n : CTX + (SROW - 1 - n)) : n;
            const float* gp = (const float*)(ws + WS_GATES) + ((size_t)b * SROW + s) * 16 + dir * 8 + h;
            const float li = gp[0]; float bs_ = gp[4];
#pragma unroll
            for (int o = 1; o < 64; o <<= 1) { const float t = __shfl_up(bs_, o); if (lane >= o) bs_ += t; }
            const float gg = li - bs_; float gm = gg;
#pragma unroll
            for (int o = 1; o < 64; o <<= 1) gm = fmaxf(gm, __shfl_xor(gm, o));
            ((float*)(ws + WS_SCB))[(size_t)chain * SROW + n] = bs_; ((float*)(ws + WS_SCG))[(size_t)chain * SROW + n] = gg;
            if (lane == 0) ((float*)(ws + WS_SCM))[chain * 132 + ck] = gm;
        }
    }
}

namespace sc {
typedef short v4i16_t __attribute__((ext_vector_type(4)));
constexpr int PQ = 272, PK = 144;
constexpr int L_QT = 0, L_KT = 17408, L_K2T = 34816, L_V = 53248, L_P = 70656, L_O = 79872, L_ST = 97280, L_TOT = 132096, L_DVEC = 136192, L_EREF = 136704,
              L_N = 137216, L_DV = 137728, L_FL = 137984, L_END = 138240;
constexpr size_t SEG_STRIDE = 66560;

__device__ __forceinline__ int s_of(int dir, int n) { return dir ? (n < CTX ? CTX - 1 - n : CTX + (SROW - 1 - n)) : n; }
__device__ __forceinline__ bf16x8 ld8(LAS unsigned char* lds, int off) { return *(const LAS bf16x8*)(lds + off); }
__device__ __forceinline__ bf16x8 trB(LAS unsigned char* lds, int off) {
    const v4i16_t a = __builtin_amdgcn_ds_read_tr16_b64_v4i16((LAS v4i16_t*)(lds + off));
    const v4i16_t b = __builtin_amdgcn_ds_read_tr16_b64_v4i16((LAS v4i16_t*)(lds + off + 4 * PQ));
    return (bf16x8){a[0], a[1], a[2], a[3], b[0], b[1], b[2], b[3]};
}
__device__ __forceinline__ float rdlane(float v, int idx) { return __uint_as_float((unsigned)__builtin_amdgcn_readlane((int)__float_as_uint(v), idx)); }
#define SC_MFMA(a, b, c) __builtin_amdgcn_mfma_f32_16x16x32_bf16((a), (b), (c), 0, 0, 0)

template <bool ML>
__device__ __forceinline__ void pc_step(LAS unsigned char* lds, int w, int li, int g, int offA, int offB) {
    for (int ti = w; ti < 10; ti += 8) {
        const int ib = (ti >= 6) ? 3 : (ti >= 3) ? 2 : (ti >= 1) ? 1 : 0, jb = ti - (ib * (ib + 1)) / 2;
        f32x4 acc = (f32x4){0.f, 0.f, 0.f, 0.f};
#pragma unroll
        for (int s = 0; s < 4; ++s) acc = SC_MFMA(ld8(lds, offA + (16 * jb + li) * PQ + (32 * s + 8 * g) * 2), ld8(lds, offB + (16 * ib + li) * PQ + (32 * s + 8 * g) * 2), acc);
        const int i = 16 * ib + li, j0 = 16 * jb + 4 * g;
        const float v0 = (j0 + 0 <= i) ? acc[0] : 0.f, v1 = (j0 + 1 <= i) ? acc[1] : 0.f, v2 = (j0 + 2 <= i) ? acc[2] : 0.f, v3 = (j0 + 3 <= i) ? acc[3] : 0.f;
        u32x2 pw; pw.x = pk2(v0, v1); pw.y = pk2(v2, v3);
        *(LAS u32x2*)(lds + L_P + i * PK + j0 * 2) = pw;
        if (ML) { float ps = (bflo(pw.x) + bfhi(pw.x)) + (bflo(pw.y) + bfhi(pw.y)); ps += __shfl_xor(ps, 16); ps += __shfl_xor(ps, 32);
            if (g == 0) __hip_atomic_fetch_add((LAS float*)(lds + L_DV) + i, ps, __ATOMIC_RELAXED, __HIP_MEMORY_SCOPE_WORKGROUP); }
    }
}
__device__ __forceinline__ void w_step(const Params& p, LAS unsigned char* lds, int tid, int dir, int b, int nbase, int type, int h) {
#pragma unroll
    for (int q = 0; q < 2; ++q) { const int idx = tid + q * NTHR, i = idx >> 4, ch = idx & 15;
        const u32x4 val = *(const LAS u32x4*)(lds + L_O + i * PQ + ch * 16);
        const int t = s_of(dir, nbase + i) - CTX;
        *(u32x4*)((bf16*)p.out + (((size_t)(dir * 2 + type) * 16 + (b * 4 + h)) * SEQ + t) * 128 + ch * 8) = val; }
}
__device__ __forceinline__ void save_tiles(float* dst, const f32x4 (&S)[8], int w, int lane) {
#pragma unroll
    for (int t = 0; t < 8; ++t) *(f32x4*)(dst + ((size_t)(w * 8 + t) * 64 + lane) * 4) = S[t];
}

struct HgIn { unsigned lf[8], q[8], v[8]; };
template <bool OUT>
__device__ __forceinline__ void hg_load(const Params& p, HgIn& r, int dir, int b, int h, int nbase, int w, int l) {
    const unsigned char* ws = p.ws;
#pragma unroll
    for (int t = 0; t < 8; ++t) { const size_t sp = (size_t)s_of(dir, nbase + 8 * w + t);
        r.lf[t] = *(const unsigned*)((const bf16*)(ws + WS_LF) + ((size_t)((b * 2 + dir) * 4 + h) * SROW + sp) * 128 + 2 * l);
        r.v[t] = *(const unsigned*)((const bf16*)(ws + WS_HV) + ((size_t)(b * 4 + h) * SROW + sp) * 128 + 2 * l);
        if (OUT) r.q[t] = *(const unsigned*)((const bf16*)(ws + WS_HQ) + ((size_t)(b * 4 + h) * SROW + sp) * 128 + 2 * l); else r.q[t] = 0u; }
}
template <bool OUT>
__device__ __forceinline__ void hg_run(const Params& p, LAS unsigned char* lds, int dir, int b, int h, int n0, int nch, f32x4 (&S)[8], float& lt0, float& lt1) {
    const int tid = tid_opaque(), w = __builtin_amdgcn_readfirstlane(tid >> 6), l = tid & 63, li = l & 15, g = l >> 4;
    HgIn cur, nxt;
    hg_load<OUT>(p, cur, dir, b, h, n0, w, l);
    for (int c = 0; c < nch; ++c) {
        const int nbase = n0 + 64 * c;
        float a0[8], a1[8], f0[8], f1[8]; float c0 = 0.f, c1 = 0.f;
#pragma unroll
        for (int t = 0; t < 8; ++t) { f0[t] = h2f((unsigned short)(cur.lf[t] & 0xffffu)); f1[t] = h2f((unsigned short)(cur.lf[t] >> 16)); c0 += f0[t]; c1 += f1[t]; a0[t] = c0; a1[t] = c1; }
        *(LAS f32x2*)(lds + L_TOT + (w * 128 + 2 * l) * 4) = (f32x2){c0, c1};
        __syncthreads();
        float pre0 = 0.f, pre1 = 0.f, ar0 = 0.f, ar1 = 0.f, al0 = 0.f, al1 = 0.f;
#pragma unroll
        for (int w2 = 0; w2 < 8; ++w2) { const f32x2 tt = *(const LAS f32x2*)(lds + L_TOT + (w2 * 128 + 2 * l) * 4);
            if (w2 < w) { pre0 += tt.x; pre1 += tt.y; } if (w2 < 4) { ar0 += tt.x; ar1 += tt.y; } al0 += tt.x; al1 += tt.y; }
        unsigned k2a[8], k2b[8];
        const float c20 = __expf(al0 - ar0), c21 = __expf(al1 - ar1);
#pragma unroll
        for (int t = 0; t < 8; ++t) { const int j = 8 * w + t;
            const float A0 = a0[t] + pre0, A1 = a1[t] + pre1;
            const float k0 = 1.0f - __expf(f0[t]), k1 = 1.0f - __expf(f1[t]);
            float kt0, kt1, kk0, kk1;
            if (OUT) { kt0 = k0 * __expf(fminf(ar0 - A0, 60.f)); kt1 = k1 * __expf(fminf(ar1 - A1, 60.f)); kk0 = kt0 * c20; kk1 = kt1 * c21; }
            else { kt0 = kt1 = 0.f; kk0 = k0 * __expf(al0 - A0); kk1 = k1 * __expf(al1 - A1); }
            if (OUT) *(LAS unsigned*)(lds + L_KT + j * PQ + 4 * l) = pk2(kt0, kt1);
            *(LAS unsigned*)(lds + L_V + j * PQ + 4 * l) = cur.v[t];
            if (OUT) { const float q0 = bflo(cur.q[t]) * __expf(fminf(A0 - ar0, 60.f)), q1 = bfhi(cur.q[t]) * __expf(fminf(A1 - ar1, 60.f));
                *(LAS unsigned*)(lds + L_QT + j * PQ + 4 * l) = pk2(q0, q1); }
            const unsigned kk = pk2(kk0, kk1);
            if (t & 1) { k2a[t >> 1] = (k2a[t >> 1] & 0xffffu) | (kk << 16); k2b[t >> 1] = (k2b[t >> 1] & 0xffffu) | (kk & 0xffff0000u); }
            else { k2a[t >> 1] = kk & 0xffffu; k2b[t >> 1] = kk >> 16; } }
        *(LAS u32x4*)(lds + L_K2T + (2 * l) * PK + 16 * w) = (u32x4){k2a[0], k2a[1], k2a[2], k2a[3]};
        *(LAS u32x4*)(lds + L_K2T + (2 * l + 1) * PK + 16 * w) = (u32x4){k2b[0], k2b[1], k2b[2], k2b[3]};
        if (w == 0) { *(LAS f32x2*)(lds + L_DVEC + 8 * l) = (f32x2){__expf(al0), __expf(al1)}; *(LAS f32x2*)(lds + L_EREF + 8 * l) = (f32x2){__expf(ar0), __expf(ar1)}; }
        lt0 += al0; lt1 += al1;
        __syncthreads();
        if (c + 1 < nch) hg_load<OUT>(p, nxt, dir, b, h, nbase + 64, w, l);
        if (OUT) { pc_step<false>(lds, w, li, g, L_KT, L_QT); __syncthreads(); }
        bf16x8 bv[2];
#pragma unroll
        for (int s = 0; s < 2; ++s) bv[s] = trB(lds, L_V + (32 * s + 8 * g + (li >> 2)) * PQ + (16 * w + 4 * (li & 3)) * 2);
        if (OUT) {
#pragma unroll
            for (int t = 0; t < 8; ++t) { const f32x4 er = *(const LAS f32x4*)(lds + L_EREF + (16 * t + 4 * g) * 4); const f32x4 sv = S[t] * er;
                u32x2 pw; pw.x = pk2(sv[0], sv[1]); pw.y = pk2(sv[2], sv[3]); *(LAS u32x2*)(lds + L_ST + (16 * w + li) * PQ + (16 * t + 4 * g) * 2) = pw; }
            bf16x8 bs[4];
#pragma unroll
            for (int s = 0; s < 4; ++s) bs[s] = ld8(lds, L_ST + (16 * w + li) * PQ + (32 * s + 8 * g) * 2);
#pragma unroll
            for (int it = 0; it < 4; ++it) { f32x4 acc = (f32x4){0.f, 0.f, 0.f, 0.f};
#pragma unroll
                for (int s = 0; s < 2; ++s) if (32 * s <= 16 * it + 15) acc = SC_MFMA(bv[s], ld8(lds, L_P + (16 * it + li) * PK + (32 * s + 8 * g) * 2), acc);
#pragma unroll
                for (int s = 0; s < 4; ++s) acc = SC_MFMA(bs[s], ld8(lds, L_QT + (16 * it + li) * PQ + (32 * s + 8 * g) * 2), acc);
                u32x2 pw; pw.x = pk2(acc[0], acc[1]); pw.y = pk2(acc[2], acc[3]); *(LAS u32x2*)(lds + L_O + (16 * it + li) * PQ + (16 * w + 4 * g) * 2) = pw; }
        }
#pragma unroll
        for (int t = 0; t < 8; ++t) { const f32x4 dv = *(const LAS f32x4*)(lds + L_DVEC + (16 * t + 4 * g) * 4); S[t] = S[t] * dv;
#pragma unroll
            for (int s = 0; s < 2; ++s) S[t] = SC_MFMA(ld8(lds, L_K2T + (16 * t + li) * PK + (32 * s + 8 * g) * 2), bv[s], S[t]); }
        __syncthreads();
        if (OUT) w_step(p, lds, tid, dir, b, nbase, 0, h);
        cur = nxt;
    }
}

struct MlIn { unsigned q[8], k[8], v[8]; float bs, gg, gm; };
template <bool OUT>
__device__ __forceinline__ void ml_load(const Params& p, MlIn& r, int dir, int b, int h, int nbase, int w, int l) {
    const unsigned char* ws = p.ws;
#pragma unroll
    for (int t = 0; t < 8; ++t) { const size_t sp = (size_t)s_of(dir, nbase + 8 * w + t); const size_t o = ((size_t)(b * 4 + h) * SROW + sp) * 128 + 2 * l;
        r.k[t] = *(const unsigned*)((const bf16*)(ws + WS_QKC) + (size_t)R_ALL * 512 + o);
        r.v[t] = *(const unsigned*)((const bf16*)(ws + WS_MV) + o);
        if (OUT) r.q[t] = *(const unsigned*)((const bf16*)(ws + WS_QKC) + o); else r.q[t] = 0u; }
    const int chain = (dir * 4 + b) * 4 + h;
    r.bs = ((const float*)(ws + WS_SCB))[(size_t)chain * SROW + nbase + l]; r.gg = ((const float*)(ws + WS_SCG))[(size_t)chain * SROW + nbase + l];
    r.gm = ((const float*)(ws + WS_SCM))[chain * 132 + (nbase >> 6)];
}
template <bool OUT>
__device__ __forceinline__ void ml_run(const Params& p, LAS unsigned char* lds, int dir, int b, int h, int n0, int nch, f32x4 (&S)[8], float& m_prev, float& btot) {
    const int tid = tid_opaque(), w = __builtin_amdgcn_readfirstlane(tid >> 6), l = tid & 63, li = l & 15, g = l >> 4;
    MlIn cur, nxt;
    ml_load<OUT>(p, cur, dir, b, h, n0, w, l);
    for (int c = 0; c < nch; ++c) {
        const int nbase = n0 + 64 * c;
        const float bs_ = cur.bs, gg = cur.gg, gm = cur.gm;
        const float G = fmaxf(m_prev, gm), s_in = __expf(m_prev - G), eg = __expf(gg - G), b63 = rdlane(bs_, 63);
        if (w == 0 && OUT) *(LAS float*)(lds + L_FL + 4 * l) = __expf(-(bs_ + G));
        float n0v = 0.f, n1v = 0.f;
        if (OUT) { const f32x2 nn = *(const LAS f32x2*)(lds + L_N + 8 * l); n0v = nn.x * s_in; n1v = nn.y * s_in; }
        float ks0 = 0.f, ks1 = 0.f; unsigned k2a[8], k2b[8]; float qd[8];
#pragma unroll
        for (int t = 0; t < 8; ++t) { const int j = 8 * w + t; const float egj = rdlane(eg, j);
            const float kh0 = bflo(cur.k[t]) * egj, kh1 = bfhi(cur.k[t]) * egj; ks0 += kh0; ks1 += kh1;
            const unsigned kk = pk2(kh0, kh1);
            *(LAS unsigned*)(lds + L_V + j * PQ + 4 * l) = cur.v[t];
            if (OUT) { *(LAS unsigned*)(lds + L_KT + j * PQ + 4 * l) = kk; *(LAS unsigned*)(lds + L_QT + j * PQ + 4 * l) = cur.q[t];
                qd[t] = bflo(cur.q[t]) * n0v + bfhi(cur.q[t]) * n1v; } else qd[t] = 0.f;
            if (t & 1) { k2a[t >> 1] = (k2a[t >> 1] & 0xffffu) | (kk << 16); k2b[t >> 1] = (k2b[t >> 1] & 0xffffu) | (kk & 0xffff0000u); }
            else { k2a[t >> 1] = kk & 0xffffu; k2b[t >> 1] = kk >> 16; } }
        if (OUT) {
            const bool h5 = (l & 32) != 0, h4 = (l & 16) != 0, h3 = (l & 8) != 0; float r4[4], r2[2];
#pragma unroll
            for (int e = 0; e < 4; ++e) { const float keep = h5 ? qd[e + 4] : qd[e], send = h5 ? qd[e] : qd[e + 4]; r4[e] = keep + __shfl_xor(send, 32); }
#pragma unroll
            for (int e = 0; e < 2; ++e) { const float keep = h4 ? r4[e + 2] : r4[e], send = h4 ? r4[e] : r4[e + 2]; r2[e] = keep + __shfl_xor(send, 16); }
            const float keep = h3 ? r2[1] : r2[0], send = h3 ? r2[0] : r2[1];
            float r1 = keep + __shfl_xor(send, 8);
            r1 += __shfl_xor(r1, 4); r1 += __shfl_xor(r1, 2); r1 += __shfl_xor(r1, 1);
            if ((l & 7) == 0) *(LAS float*)(lds + L_DV + 4 * (8 * w + ((l >> 3) & 7))) = r1;
        }
        *(LAS u32x4*)(lds + L_K2T + (2 * l) * PK + 16 * w) = (u32x4){k2a[0], k2a[1], k2a[2], k2a[3]};
        *(LAS u32x4*)(lds + L_K2T + (2 * l + 1) * PK + 16 * w) = (u32x4){k2b[0], k2b[1], k2b[2], k2b[3]};
        *(LAS f32x2*)(lds + L_TOT + (w * 128 + 2 * l) * 4) = (f32x2){ks0, ks1};
        __syncthreads();
        if (tid < 128) { float s = *(const LAS float*)(lds + L_N + 4 * tid) * s_in;
#pragma unroll
            for (int w2 = 0; w2 < 8; ++w2) s += *(const LAS float*)(lds + L_TOT + (w2 * 128 + tid) * 4);
            *(LAS float*)(lds + L_N + 4 * tid) = s; }
        if (c + 1 < nch) ml_load<OUT>(p, nxt, dir, b, h, nbase + 64, w, l);
        if (OUT) { pc_step<true>(lds, w, li, g, L_KT, L_QT); __syncthreads(); }
        bf16x8 bv[2];
#pragma unroll
        for (int s = 0; s < 2; ++s) bv[s] = trB(lds, L_V + (32 * s + 8 * g + (li >> 2)) * PQ + (16 * w + 4 * (li & 3)) * 2);
#pragma unroll
        for (int t = 0; t < 8; ++t) S[t] = S[t] * s_in;
        if (OUT) {
#pragma unroll
            for (int t = 0; t < 8; ++t) { u32x2 pw; pw.x = pk2(S[t][0], S[t][1]); pw.y = pk2(S[t][2], S[t][3]); *(LAS u32x2*)(lds + L_ST + (16 * w + li) * PQ + (16 * t + 4 * g) * 2) = pw; }
            bf16x8 bs[4];
#pragma unroll
            for (int s = 0; s < 4; ++s) bs[s] = ld8(lds, L_ST + (16 * w + li) * PQ + (32 * s + 8 * g) * 2);
#pragma unroll
            for (int it = 0; it < 4; ++it) { f32x4 acc = (f32x4){0.f, 0.f, 0.f, 0.f};
#pragma unroll
                for (int s = 0; s < 2; ++s) if (32 * s <= 16 * it + 15) acc = SC_MFMA(bv[s], ld8(lds, L_P + (16 * it + li) * PK + (32 * s + 8 * g) * 2), acc);
#pragma unroll
                for (int s = 0; s < 4; ++s) acc = SC_MFMA(bs[s], ld8(lds, L_QT + (16 * it + li) * PQ + (32 * s + 8 * g) * 2), acc);
                const int i = 16 * it + li; const float den = *(const LAS float*)(lds + L_DV + 4 * i), fl = *(const LAS float*)(lds + L_FL + 4 * i);
                const float rd = __builtin_amdgcn_rcpf(fmaxf(fabsf(den), fl)); acc = acc * rd;
                u32x2 pw; pw.x = pk2(acc[0], acc[1]); pw.y = pk2(acc[2], acc[3]); *(LAS u32x2*)(lds + L_O + i * PQ + (16 * w + 4 * g) * 2) = pw; }
        }
#pragma unroll
        for (int t = 0; t < 8; ++t) {
#pragma unroll
            for (int s = 0; s < 2; ++s) S[t] = SC_MFMA(ld8(lds, L_K2T + (16 * t + li) * PK + (32 * s + 8 * g) * 2), bv[s], S[t]); }
        m_prev = b63 + G; btot += b63;
        __syncthreads();
        if (OUT) w_step(p, lds, tid, dir, b, nbase, 1, h);
        cur = nxt;
    }
}

__device__ __forceinline__ void pass_a(const Params& p, LAS unsigned char* lds, int item) {
    const int tid = tid_opaque(), w = __builtin_amdgcn_readfirstlane(tid >> 6), l = tid & 63;
    const int chain = item >> 2, sa = item & 3, type = chain >> 5, dir = (chain >> 4) & 1, b = (chain >> 2) & 3, h = chain & 3;
    const int n0 = sa == 0 ? 0 : CTX + (sa - 1) * 2048, nch = sa == 0 ? 4 : 32;
    float* rec = (float*)(p.ws + WS_SEG + (size_t)item * SEG_STRIDE);
    f32x4 S[8];
#pragma unroll
    for (int t = 0; t < 8; ++t) S[t] = (f32x4){0.f, 0.f, 0.f, 0.f};
    if (type == 0) { float lt0 = 0.f, lt1 = 0.f; hg_run<false>(p, lds, dir, b, h, n0, nch, S, lt0, lt1);
        save_tiles(rec, S, w, l); if (w == 0) *(f32x2*)(rec + 16384 + 2 * l) = (f32x2){lt0, lt1}; }
    else { float m_prev = -1.0e30f, btot = 0.f;
        if (tid < 128) *(LAS float*)(lds + L_N + 4 * tid) = 0.f;
        __syncthreads();
        ml_run<false>(p, lds, dir, b, h, n0, nch, S, m_prev, btot);
        save_tiles(rec, S, w, l); if (tid < 128) rec[16384 + tid] = *(const LAS float*)(lds + L_N + 4 * tid);
        if (tid == 0) { rec[16384 + 128] = m_prev; rec[16384 + 129] = btot; } }
    __syncthreads();
}
__device__ __forceinline__ void pass_b(const Params& p, LAS unsigned char* lds, int item) {
    const int tid = tid_opaque(), w = __builtin_amdgcn_readfirstlane(tid >> 6), l = tid & 63, g = l >> 4;
    const int chain = item >> 2, k = item & 3, type = chain >> 5, dir = (chain >> 4) & 1, b = (chain >> 2) & 3, h = chain & 3;
    const int n0 = CTX + k * 2048;
    for (int i = tid; i < 64 * PK / 4; i += NTHR) *(LAS unsigned*)(lds + L_P + 4 * i) = 0u;
    f32x4 S[8];
#pragma unroll
    for (int t = 0; t < 8; ++t) S[t] = (f32x4){0.f, 0.f, 0.f, 0.f};
    if (type == 0) {
        for (int j = 0; j <= k; ++j) { const float* rec = (const float*)(p.ws + WS_SEG + (size_t)(chain * 4 + j) * SEG_STRIDE);
#pragma unroll
            for (int t = 0; t < 8; ++t) { const f32x4 lt = *(const f32x4*)(rec + 16384 + 16 * t + 4 * g); const f32x4 u = *(const f32x4*)(rec + ((size_t)(w * 8 + t) * 64 + l) * 4);
                S[t][0] = S[t][0] * __expf(lt[0]) + u[0]; S[t][1] = S[t][1] * __expf(lt[1]) + u[1]; S[t][2] = S[t][2] * __expf(lt[2]) + u[2]; S[t][3] = S[t][3] * __expf(lt[3]) + u[3]; } }
        __syncthreads();
        float lt0 = 0.f, lt1 = 0.f; hg_run<true>(p, lds, dir, b, h, n0, 32, S, lt0, lt1);
    } else {
        float m_in = -1.0e30f, nacc = 0.f;
        for (int j = 0; j <= k; ++j) { const float* rec = (const float*)(p.ws + WS_SEG + (size_t)(chain * 4 + j) * SEG_STRIDE);
            const float m_loc = rec[16384 + 128], bj = rec[16384 + 129]; const float mn = fmaxf(bj + m_in, m_loc), sa_ = __expf(bj + m_in - mn), sb_ = __expf(m_loc - mn);
#pragma unroll
            for (int t = 0; t < 8; ++t) { const f32x4 u = *(const f32x4*)(rec + ((size_t)(w * 8 + t) * 64 + l) * 4); S[t] = S[t] * sa_ + u * sb_; }
            if (tid < 128) nacc = nacc * sa_ + rec[16384 + tid] * sb_;
            m_in = mn; }
        if (tid < 128) *(LAS float*)(lds + L_N + 4 * tid) = nacc;
        __syncthreads();
        float btot = 0.f; ml_run<true>(p, lds, dir, b, h, n0, 32, S, m_in, btot);
    }
    __syncthreads();
}
#undef SC_MFMA
}

__device__ __forceinline__ void phase_mixprep(const Params& p) {
    unsigned char* ws = p.ws;
    const int tid = tid_opaque(), lane = tid & 63, wave = tid >> 6;
    const int gw = blockIdx.x * NWAVES + wave, NGW = gridDim.x * NWAVES;
    for (int xr = gw; xr < R_X; xr += NGW) {
        const int b = xr / SEQ, t = xr % SEQ; const size_t row = (size_t)b * SROW + CTX + t;
        const int tyh = lane >> 3;
        const size_t o2 = (((size_t)(tyh >> 2) * 16 + (b * 4 + (tyh & 3))) * SEQ + t) * 128 + (lane & 7) * 16;
        const bf16* of = (const bf16*)p.out + o2;
        const bf16* ob = (const bf16*)p.out + (size_t)2 * 16 * SEQ * 128 + o2;
        float v[16];
#pragma unroll
        for (int q = 0; q < 2; ++q) { const u32x4 a = *(const u32x4*)(of + q * 8), c = *(const u32x4*)(ob + q * 8);
            v[q * 8 + 0] = bflo(a.x) + bflo(c.x); v[q * 8 + 1] = bfhi(a.x) + bfhi(c.x); v[q * 8 + 2] = bflo(a.y) + bflo(c.y); v[q * 8 + 3] = bfhi(a.y) + bfhi(c.y);
            v[q * 8 + 4] = bflo(a.z) + bflo(c.z); v[q * 8 + 5] = bfhi(a.z) + bfhi(c.z); v[q * 8 + 6] = bflo(a.w) + bflo(c.w); v[q * 8 + 7] = bfhi(a.w) + bfhi(c.w); }
        float s = 0.f;
#pragma unroll
        for (int e = 0; e < 16; ++e) s += v[e];
        s += __shfl_xor(s, 1); s += __shfl_xor(s, 2); s += __shfl_xor(s, 4);
        const bool ml = lane >= 32;
        const float mean = ml ? s * (1.0f / 128.0f) : 0.f;
        float q2 = 0.f;
#pragma unroll
        for (int e = 0; e < 16; ++e) { v[e] -= mean; q2 += v[e] * v[e]; }
        q2 += __shfl_xor(q2, 1); q2 += __shfl_xor(q2, 2); q2 += __shfl_xor(q2, 4);
        const float rstd = rsqrtf(q2 * (1.0f / 128.0f) + EPS);
        const int c0 = (lane & 31) * 16;
        const float* nw = (ml ? p.ml_norm_w : p.hg_norm_w) + c0;
        const bf16* gt = (const bf16*)(ws + (ml ? WS_MO : WS_HG)) + row * 512 + c0;
        const u32x4 g0 = *(const u32x4*)gt, g1 = *(const u32x4*)(gt + 8);
        float g[16] = {bflo(g0.x), bfhi(g0.x), bflo(g0.y), bfhi(g0.y), bflo(g0.z), bfhi(g0.z), bflo(g0.w), bfhi(g0.w),
                       bflo(g1.x), bfhi(g1.x), bflo(g1.y), bfhi(g1.y), bflo(g1.z), bfhi(g1.z), bflo(g1.w), bfhi(g1.w)};
#pragma unroll
        for (int e = 0; e < 16; ++e) v[e] = v[e] * rstd * nw[e] * g[e];
        u32x4 o0, o1; o0.x = pk2(v[0], v[1]); o0.y = pk2(v[2], v[3]); o0.z = pk2(v[4], v[5]); o0.w = pk2(v[6], v[7]);
        o1.x = pk2(v[8], v[9]); o1.y = pk2(v[10], v[11]); o1.z = pk2(v[12], v[13]); o1.w = pk2(v[14], v[15]);
        bf16* am = (bf16*)(ws + WS_AMIX2) + (size_t)xr * 1024 + lane * 16;
        *(u32x4*)am = o0; *(u32x4*)(am + 8) = o1;
    }
}

__device__ __forceinline__ void phase_vx(const Params& p, LAS unsigned char* lds) {
    unsigned char* ws = p.ws;
    const int tid = tid_opaque(), lane = tid & 63, wave = tid >> 6;
    LAS float* Lrw = (LAS float*)lds;
    LAS float* Lnw = Lrw + 16 * 1024;
    LAS float* Lsh = Lnw + 1024;
    LAS float* Lsc = Lsh + 4096;
    const float* mod = (const float*)(ws + WS_MOD);
    for (int i = tid; i < 16 * 1024; i += NTHR) Lrw[i] = ((const float*)(ws + WS_RWT))[i];
    for (int i = tid; i < 1024; i += NTHR) Lnw[i] = p.norm2_w[i];
    for (int i = tid; i < 4096; i += NTHR) { const int b = i >> 10, c = i & 1023; Lsh[i] = mod[(size_t)b * 6144 + 3072 + c]; Lsc[i] = mod[(size_t)b * 6144 + 4096 + c]; }
    __syncthreads();
    const int gw = blockIdx.x * NWAVES + wave, NGW = gridDim.x * NWAVES;
    for (int xr = gw; xr < R_X; xr += NGW) {
        const int b = xr / SEQ, t = xr % SEQ;
        const float* src = p.out + (size_t)xr * D;
        f32x4 v[4]; float ss = 0.f;
#pragma unroll
        for (int j = 0; j < 4; ++j) { v[j] = *(const f32x4*)(src + j * 256 + lane * 4); ss += (v[j].x * v[j].x + v[j].y * v[j].y) + (v[j].z * v[j].z + v[j].w * v[j].w); }
        const float rstd = rsqrtf(wave_sum(ss) * (1.0f / D) + EPS);
        bf16* vrow = (bf16*)(ws + WS_VX) + (size_t)xr * D;
#pragma unroll
        for (int j = 0; j < 4; ++j) { const int c0 = j * 256 + lane * 4;
            const f32x4 nw = *(const LAS f32x4*)(Lnw + c0), sc = *(const LAS f32x4*)(Lsc + b * 1024 + c0), sh = *(const LAS f32x4*)(Lsh + b * 1024 + c0);
            v[j] = v[j] * rstd * nw * (1.0f + sc) + sh;
            u32x2 w; w.x = pk2(v[j].x, v[j].y); w.y = pk2(v[j].z, v[j].w); *(u32x2*)(vrow + c0) = w; }
        float pa[16];
#pragma unroll
        for (int g = 0; g < 16; ++g) { float a = 0.f;
#pragma unroll
            for (int j = 0; j < 4; ++j) { const f32x4 w = *(const LAS f32x4*)(Lrw + g * 1024 + j * 256 + lane * 4); a += (v[j].x * w.x + v[j].y * w.y) + (v[j].z * w.z + v[j].w * w.w); }
            pa[g] = a; if (g & 1) __builtin_amdgcn_sched_barrier(0); }
        const float mine = butterfly16(pa, lane);
        float mx = mine;
        mx = fmaxf(mx, __shfl_xor(mx, 4)); mx = fmaxf(mx, __shfl_xor(mx, 8)); mx = fmaxf(mx, __shfl_xor(mx, 16)); mx = fmaxf(mx, __shfl_xor(mx, 32));
        const float ex = __expf(mine - mx);
        float sm = ex; sm += __shfl_xor(sm, 4); sm += __shfl_xor(sm, 8); sm += __shfl_xor(sm, 16); sm += __shfl_xor(sm, 32);
        if ((lane & 3) == 0) ((float*)(ws + WS_AFF))[((size_t)b * 16 + (lane >> 2)) * SEQ + t] = ex / sm;
    }
}

__device__ __forceinline__ void phase_topk(const Params& p, LAS unsigned char* lds) {
    unsigned char* ws = p.ws;
    const int tid = tid_opaque(), lane = tid & 63, w = __builtin_amdgcn_readfirstlane(tid >> 6);
    LAS int* wc = (LAS int*)lds;
    for (int item = blockIdx.x; item < 256; item += gridDim.x) {
        const int be = item >> 2, qtr = item & 3, b = be >> 4, e = be & 15;
        const float* aff = (const float*)(ws + WS_AFF) + (size_t)be * SEQ + tid * 16;
        unsigned u[16];
#pragma unroll
        for (int q = 0; q < 4; ++q) { const f32x4 v = *(const f32x4*)(aff + 4 * q); u[4 * q] = __float_as_uint(v.x); u[4 * q + 1] = __float_as_uint(v.y); u[4 * q + 2] = __float_as_uint(v.z); u[4 * q + 3] = __float_as_uint(v.w); }
        unsigned T = 0u; int par = 0;
        for (int bit = 30; bit >= -1; --bit) {
            const unsigned cand = (bit >= 0) ? (T | (1u << bit)) : (T + 1u);
            int c = 0;
#pragma unroll
            for (int i = 0; i < 16; ++i) c += (int)__popcll(__ballot(u[i] >= cand));
            if (lane == 0) wc[par * 8 + w] = c;
            __syncthreads();
            int tot = 0;
#pragma unroll
            for (int w2 = 0; w2 < 8; ++w2) tot += wc[par * 8 + w2];
            if (bit >= 0) { if (tot >= CAP) T = cand; } else wc[32] = tot;
            par ^= 1;
        }
        int ngt = 0, neq = 0;
#pragma unroll
        for (int i = 0; i < 16; ++i) { ngt += (u[i] > T) ? 1 : 0; neq += (u[i] == T) ? 1 : 0; }
        int pk = (ngt << 16) | neq, inc = pk;
#pragma unroll
        for (int o = 1; o < 64; o <<= 1) { const int t = __shfl_up(inc, o); if (lane >= o) inc += t; }
        if (lane == 63) wc[16 + w] = inc;
        __syncthreads();
        const int cgt = wc[32];
        int base = inc - pk;
#pragma unroll
        for (int w2 = 0; w2 < 8; ++w2) if (w2 < w) base += wc[16 + w2];
        int gtb = base >> 16, eqb = base & 0xffff; const int need_eq = CAP - cgt;
        if ((tid >> 7) == qtr) {
            int sl[16];
#pragma unroll
            for (int i = 0; i < 16; ++i) { int s_ = -1;
                if (u[i] > T) { s_ = gtb; ++gtb; } else if (u[i] == T) { if (eqb < need_eq) s_ = cgt + eqb; ++eqb; }
                sl[i] = s_;
                if (s_ >= 0) { const int mrow = (e * NB + b) * CAP + s_; ((int*)(ws + WS_ROWMAP))[mrow] = b * SEQ + tid * 16 + i; ((float*)(ws + WS_GATEV))[mrow] = __uint_as_float(u[i]); } }
            int* so = (int*)(ws + WS_SLOT) + (size_t)be * SEQ + tid * 16;
#pragma unroll
            for (int q = 0; q < 4; ++q) *(int4*)(so + 4 * q) = make_int4(sl[4 * q], sl[4 * q + 1], sl[4 * q + 2], sl[4 * q + 3]);
        }
        __syncthreads();
    }
}

__device__ __forceinline__ void phase_final(const Params& p) {
    unsigned char* ws = p.ws;
    const int tid = tid_opaque(), lane = tid & 63, wave = tid >> 6;
    const int gw = blockIdx.x * NWAVES + wave, NGW = gridDim.x * NWAVES;
    const float* mod = (const float*)(ws + WS_MOD);
    for (int blk = gw; blk < R_X / 16; blk += NGW) {
        const int xr0 = blk * 16, b = xr0 / SEQ, t0 = xr0 % SEQ;
        const int4 sl4 = *(const int4*)((const int*)(ws + WS_SLOT) + ((size_t)b * 16 + (lane & 15)) * SEQ + t0 + 4 * (lane >> 4));
#pragma unroll 1
        for (int rq = 0; rq < 4; ++rq)
#pragma unroll 1
            for (int rr = 0; rr < 4; ++rr) {
                const int xr = xr0 + rq * 4 + rr; const int myv = (rr == 0) ? sl4.x : (rr == 1) ? sl4.y : (rr == 2) ? sl4.z : sl4.w;
                float* row = p.out + (size_t)xr * D;
                f32x4 acc[4];
#pragma unroll
                for (int j = 0; j < 4; ++j) acc[j] = (f32x4){0.f, 0.f, 0.f, 0.f};
                for (int e = 0; e < 16; ++e) { const int sl = __shfl(myv, e + 16 * rq); if (sl < 0) continue;
                    const bf16* y = (const bf16*)(ws + WS_Y) + ((size_t)(e * NB + b) * CAP + sl) * D;
#pragma unroll
                    for (int j = 0; j < 4; ++j) { const u32x2 wv = *(const u32x2*)(y + j * 256 + lane * 4); acc[j].x += bflo(wv.x); acc[j].y += bfhi(wv.x); acc[j].z += bflo(wv.y); acc[j].w += bfhi(wv.y); } }
                f32x4 v[4]; float ss = 0.f;
#pragma unroll
                for (int j = 0; j < 4; ++j) { const int c0 = j * 256 + lane * 4; const f32x4 g2 = *(const f32x4*)(mod + (size_t)b * 6144 + 5120 + c0);
                    v[j] = *(const f32x4*)(row + c0) + g2 * acc[j]; ss += (v[j].x * v[j].x + v[j].y * v[j].y) + (v[j].z * v[j].z + v[j].w * v[j].w); }
                const float rstd = rsqrtf(wave_sum(ss) * (1.0f / D) + EPS);
#pragma unroll
                for (int j = 0; j < 4; ++j) { const int c0 = j * 256 + lane * 4; const f32x4 fw = *(const f32x4*)(p.final_w + c0); *(f32x4*)(row + c0) = v[j] * rstd * fw; }
            }
    }
}

#define XB_TMO      128
#define XB_XCNT(j)  (256  + 64 * (j))
#define XB_XSUB(j)  (1280 + 64 * (j))
#define XB_XGEN(j)  (2304 + 64 * (j))
#define XB_TOP      3328
#define XB_TOPGEN   3392
#define XCD_BAR_WORDS 3456
#define XB_SPIN_CAP (1u << 20)
__device__ __forceinline__ unsigned xb_ld(unsigned* p)              { return __hip_atomic_load(p, __ATOMIC_RELAXED, __HIP_MEMORY_SCOPE_AGENT); }
__device__ __forceinline__ unsigned xb_add(unsigned* p, unsigned v) { return __hip_atomic_fetch_add(p, v, __ATOMIC_RELAXED, __HIP_MEMORY_SCOPE_AGENT); }
__device__ __forceinline__ unsigned xb_xcc_id() { return (unsigned)__builtin_amdgcn_s_getreg((3 << 11) | 20) & 0xFu; }
#define XB_SPIN(cond, bar) do { unsigned _sp = 0; while (cond) { __builtin_amdgcn_s_sleep(1); \
    if ((++_sp & 255u) == 0u) { if (xb_ld(&(bar)[XB_TMO])) break; if (_sp > XB_SPIN_CAP) { atomicAdd(&(bar)[XB_TMO], 1u); break; } } } } while (0)
struct XcdBarrier { unsigned* bar; unsigned x; volatile LAS unsigned* st; };
__device__ __forceinline__ XcdBarrier xcd_barrier_post(unsigned* bar, volatile LAS unsigned* st) {
    XcdBarrier b; b.bar = bar; b.x = xb_xcc_id(); b.st = st;
    if (threadIdx.x == 0) (void)xb_add(&bar[XB_XCNT(b.x)], 1u);
    return b;
}
__device__ __forceinline__ void xcd_barrier_complete(unsigned* bar, unsigned x, unsigned& nloc, unsigned& nx) {
    const unsigned G = gridDim.x * gridDim.y * gridDim.z;
    unsigned sum, cnt, mine, sp = 0u;
    for (;;) {
        sum = 0u; cnt = 0u; mine = 0u;
#pragma unroll
        for (unsigned j = 0; j < 16; ++j) { const unsigned c = xb_ld(&bar[XB_XCNT(j)]); sum += c; cnt += (c > 0u) ? 1u : 0u; mine = (j == x) ? c : mine; }
        if (sum == G) break;
        __builtin_amdgcn_s_sleep(1);
        if ((++sp & 255u) == 0u) { if (xb_ld(&bar[XB_TMO])) break; if (sp > XB_SPIN_CAP) { atomicAdd(&bar[XB_TMO], 1u); break; } }
    }
    nloc = mine > 0u ? mine : 1u; nx = cnt > 0u ? cnt : 1u;
}
__device__ __forceinline__ void xcd_barrier(const XcdBarrier& b) {
    asm volatile("s_waitcnt vmcnt(0)" ::: "memory");
    __syncthreads();
    if (threadIdx.x == 0) {
        unsigned* bar = b.bar;
        __builtin_amdgcn_s_waitcnt(0);
        unsigned nloc = b.st[0], nx = b.st[1];
        if (nloc == 0u) { xcd_barrier_complete(bar, b.x, nloc, nx); b.st[0] = nloc; b.st[1] = nx; }
        const unsigned old = xb_add(&bar[XB_XSUB(b.x)], 1u);
        const unsigned gen = old / nloc;
        if (old + 1u == (gen + 1u) * nloc) {
            __builtin_amdgcn_fence(__ATOMIC_RELEASE, "agent");
            asm volatile("s_waitcnt vmcnt(0)" ::: "memory");
            const unsigned og = xb_add(&bar[XB_TOP], 1u);
            const unsigned tg = og / nx;
            if (og + 1u == (tg + 1u) * nx) xb_add(&bar[XB_TOPGEN], 1u);
            else XB_SPIN(xb_ld(&bar[XB_TOPGEN]) == tg, bar);
            __builtin_amdgcn_fence(__ATOMIC_ACQUIRE, "agent");
            xb_add(&bar[XB_XGEN(b.x)], 1u);
            asm volatile("s_waitcnt vmcnt(0)" ::: "memory");
        } else {
            XB_SPIN(xb_ld(&bar[XB_XGEN(b.x)]) == gen, bar);
            __builtin_amdgcn_fence(__ATOMIC_ACQUIRE, "agent");
            asm volatile("s_waitcnt vmcnt(0)" ::: "memory");
        }
    }
    __syncthreads();
}

constexpr int MISC_OFF = LDS_BYTES - 256;
constexpr int CW_BAR = 4096;
constexpr size_t CTL_ZERO_BYTES = 65536;
constexpr unsigned REPEAT_MASK = 0x0u;
constexpr int PB_FILTER = 0;

__global__ void __launch_bounds__(NTHR, 2) mega_fwd(Params p) {
    extern __shared__ __attribute__((aligned(16))) unsigned char lds_raw[];
    LAS unsigned char* lds = (LAS unsigned char*)lds_raw;
    for (int u = threadIdx.x; u < 64; u += NTHR) ((LAS unsigned*)(lds + MISC_OFF))[u] = 0u;
    __syncthreads();
    XcdBarrier bar = xcd_barrier_post((unsigned*)(p.ws + WS_CTL) + CW_BAR, (volatile LAS unsigned*)(lds + MISC_OFF) + 8);
#define GRID_BAR() xcd_barrier(bar)
#define PHASE(k, ...) for (int rep_ = 0; rep_ <= (int)((REPEAT_MASK >> (k)) & 1u); ++rep_) { __VA_ARGS__; GRID_BAR(); }
    PHASE(0, phase_prologue(p, lds))
    PHASE(1, phase_u(p, lds))
    PHASE(2, { pg8::Gemm g{(const bf16*)(p.ws + WS_U), (const bf16*)(p.ws + WS_WIN_T), D, nullptr}; pg8::StaticOrder S; S.init(R_ALL, NPROJ, gridDim.x, blockIdx.x);
        pg8::EpiInProj E{p.ws, (const float*)(p.ws + WS_LB)};
        pg8::gemm_phase<pg8::EpiInProj, pg8::StaticOrder, true, false>(lds, g, S, E); })
    PHASE(3, phase_conv(p))
    PHASE(4, for (int item = blockIdx.x; item < 256; item += gridDim.x) { if (rep_ == 1 && PB_FILTER != 0 && ((item >> 7) + 1) != PB_FILTER) continue; sc::pass_a(p, lds, item); })
    PHASE(5, for (int item = blockIdx.x; item < 256; item += gridDim.x) { if (rep_ == 1 && PB_FILTER != 0 && ((item >> 7) + 1) != PB_FILTER) continue; sc::pass_b(p, lds, item); })
    PHASE(6, phase_mixprep(p))
    PHASE(7, { pg8::Gemm g{(const bf16*)(p.ws + WS_AMIX2), (const bf16*)(p.ws + WS_WOUT_T), D, nullptr}; pg8::StaticOrder S; S.init(R_X, D, gridDim.x, blockIdx.x);
        pg8::EpiOutProj E{p.x, p.out, (const float*)(p.ws + WS_MOD)};
        pg8::gemm_phase<pg8::EpiOutProj, pg8::StaticOrder, true, false>(lds, g, S, E); })
    PHASE(8, phase_vx(p, lds))
    PHASE(9, phase_topk(p, lds))
    PHASE(10, for (int w = blockIdx.x; w < 256; w += gridDim.x) {
        const int xcd = w & 7, idx = w >> 3, e = xcd * 2 + (idx >> 4), pm = e * 16 + (idx & 15);
        {   pg8::Gemm g{(const bf16*)(p.ws + WS_VX), (const bf16*)(p.ws + WS_WGU_T), D, (const int*)(p.ws + WS_ROWMAP)};
            pg8::PanelOrder S{pm, 8, (size_t)e * 2048 * 1024 * 2}; pg8::EpiMoE1 E{(bf16*)(p.ws + WS_H)};
            pg8::gemm_phase<pg8::EpiMoE1, pg8::PanelOrder, true, true>(lds, g, S, E); }
        VM_WAIT(); __syncthreads();
        if (threadIdx.x == 0) { __builtin_amdgcn_fence(__ATOMIC_ACQUIRE, "agent"); VM_WAIT(); }
        __syncthreads();
        {   pg8::Gemm g{(const bf16*)(p.ws + WS_H), (const bf16*)(p.ws + WS_WD_T), FF, nullptr};
            pg8::PanelOrder S{pm, 4, (size_t)e * 1024 * 1024 * 2}; pg8::EpiMoE2 E{(bf16*)(p.ws + WS_Y), (const float*)(p.ws + WS_GATEV)};
            pg8::gemm_phase<pg8::EpiMoE2, pg8::PanelOrder, true, false>(lds, g, S, E); }
    })
    phase_final(p);
}

extern "C" void kernel_launch(void* const* d_in, const int* in_sizes, int n_in, void* d_out, int out_size, void* d_ws, size_t ws_size, hipStream_t stream) {
    static int grid = 0;
    if (grid == 0) {
        if (n_in != 21 || out_size != R_X * D || ws_size < WS_END) { fprintf(stderr, "kernel_launch: unexpected shapes: n_in %d out %d ws %zu\n", n_in, out_size, ws_size); grid = -1; return; }
        int dev = 0, cus = 0, per_cu = 0;
        if (hipGetDevice(&dev) != hipSuccess || hipDeviceGetAttribute(&cus, hipDeviceAttributeMultiprocessorCount, dev) != hipSuccess) { grid = -1; return; }
        if (hipFuncSetAttribute((const void*)mega_fwd, hipFuncAttributeMaxDynamicSharedMemorySize, LDS_BYTES) != hipSuccess) { fprintf(stderr, "kernel_launch: hipFuncSetAttribute failed\n"); grid = -1; return; }
        if (hipOccupancyMaxActiveBlocksPerMultiprocessor(&per_cu, (const void*)mega_fwd, NTHR, LDS_BYTES) != hipSuccess || per_cu < 1) { fprintf(stderr, "kernel_launch: occupancy query says %d blocks/CU; nothing launched\n", per_cu); (void)hipGetLastError(); grid = -1; return; }
        grid = cus;
    }
    if (grid < 0) return;
    (void)hipMemsetAsync((char*)d_ws + WS_CTL, 0, CTL_ZERO_BYTES, stream);
    Params p{};
    const float** pp = (const float**)&p;
    for (int i = 0; i < 21; ++i) pp[i] = (const float*)d_in[i];
    p.out = (float*)d_out; p.ws = (unsigned char*)d_ws;
    hipLaunchKernelGGL(mega_fwd, dim3(grid), dim3(NTHR), LDS_BYTES, stream, p);
}
```

```cpp
#include <hip/hip_runtime.h>
#include <cstdio>
#include <cstdint>

#define GAS __attribute__((address_space(1)))
#define LAS __attribute__((address_space(3)))
typedef unsigned short bf16;
typedef float f32x4 __attribute__((ext_vector_type(4)));
typedef float f32x2 __attribute__((ext_vector_type(2)));
typedef unsigned u32x4 __attribute__((ext_vector_type(4)));
typedef unsigned u32x2 __attribute__((ext_vector_type(2)));
typedef short bf16x8 __attribute__((ext_vector_type(8)));
typedef __bf16 bf16x2_t __attribute__((ext_vector_type(2)));
typedef _Float16 f16x2_t __attribute__((ext_vector_type(2)));

constexpr int D = 1024, NB = 4, SEQ = 8192, CTX = 256, SROW = SEQ + CTX, R_ALL = NB * SROW, R_X = NB * SEQ;
constexpr int PROJ = 4624, NPROJ = 4608;
constexpr int NE = 16, CAP = 1024, FF = 1024, R_MOE = NE * NB * CAP;
constexpr float EPS = 1e-6f;
constexpr int NTHR = 512, NWAVES = 8;
constexpr int LDS_BYTES = 155648;
constexpr int PROF = 0, PROF_BLOCK = 0;

constexpr size_t MiB = 1u << 20;
constexpr size_t WS_CTL = 0;
constexpr size_t WS_MODP = 1 * MiB;
constexpr size_t WS_MOD = 3 * MiB;
constexpr size_t WS_LB = WS_MOD + 128 * 1024;
constexpr size_t WS_WGT = WS_LB + 4096;
constexpr size_t WS_RWT = WS_WGT + 65536;
constexpr size_t WS_WIN_T = 4 * MiB;
constexpr size_t WS_WOUT_T = 13 * MiB;
constexpr size_t WS_GATES = 15 * MiB;
constexpr size_t WS_WGU_T = 18 * MiB;
constexpr size_t WS_WD_T = 82 * MiB;
constexpr size_t WS_U = 114 * MiB;
constexpr size_t WS_HQ = 180 * MiB;
constexpr size_t WS_HV = 213 * MiB;
constexpr size_t WS_HG = 246 * MiB;
constexpr size_t WS_LF = 279 * MiB;
constexpr size_t WS_QK = 345 * MiB;
constexpr size_t WS_MV = 411 * MiB;
constexpr size_t WS_MO = 444 * MiB;
constexpr size_t WS_AFF = 477 * MiB;
constexpr size_t WS_ROWMAP = 479 * MiB;
constexpr size_t WS_GATEV = WS_ROWMAP + 262144;
constexpr size_t WS_SLOT = 480 * MiB;
constexpr size_t WS_SEG = 484 * MiB;
constexpr size_t WS_SCB = 502 * MiB;
constexpr size_t WS_SCG = 504 * MiB;
constexpr size_t WS_SCM = 506 * MiB;
constexpr size_t WS_END = 512 * MiB;
constexpr size_t WS_QKC = WS_U;
constexpr size_t WS_AMIX2 = WS_LF;
constexpr size_t WS_VX = WS_U;
constexpr size_t WS_H = WS_HQ;
constexpr size_t WS_Y = 308 * MiB;

struct Params {
    const float *x, *c, *ctx, *c_ctx, *ada_w, *ada_b, *norm1_w, *w_in, *conv_w, *conv_b, *lb_logits, *ml_gate_b, *hg_norm_w, *ml_norm_w, *w_out, *norm2_w,
        *router_w, *wg, *wu, *wd, *final_w;
    float* out; unsigned char* ws;
};

__device__ __forceinline__ unsigned pk2(float lo, float hi) { f32x2 v = {lo, hi}; bf16x2_t b = __builtin_convertvector(v, bf16x2_t); return __builtin_bit_cast(unsigned, b); }
__device__ __forceinline__ unsigned pkh2(float lo, float hi) { f32x2 v = {lo, hi}; f16x2_t b = __builtin_convertvector(v, f16x2_t); return __builtin_bit_cast(unsigned, b); }
__device__ __forceinline__ float bf2f(unsigned short b) { return __uint_as_float((unsigned)b << 16); }
__device__ __forceinline__ float bflo(unsigned w) { return __uint_as_float(w << 16); }
__device__ __forceinline__ float bfhi(unsigned w) { return __uint_as_float(w & 0xffff0000u); }
__device__ __forceinline__ float h2f(unsigned short h) { return (float)__builtin_bit_cast(_Float16, h); }
__device__ __forceinline__ float sigmoid_(float x) { return __builtin_amdgcn_rcpf(1.0f + __expf(-x)); }
__device__ __forceinline__ float silu_(float x) { return x * sigmoid_(x); }
__device__ __forceinline__ float wave_sum(float v) {
#pragma unroll
    for (int o = 1; o < 64; o <<= 1) v += __shfl_xor(v, o);
    return v;
}
__device__ __forceinline__ int tid_opaque() { int t = threadIdx.x; asm volatile("" : "+v"(t)); return t; }
__device__ __forceinline__ float butterfly16(const float (&a)[16], int lane) {
    const bool h5 = (lane & 32) != 0, h4 = (lane & 16) != 0, h3 = (lane & 8) != 0, h2 = (lane & 4) != 0;
    float b8[8], b4[4], b2[2];
#pragma unroll
    for (int e = 0; e < 8; ++e) { const float keep = h5 ? a[e + 8] : a[e], send = h5 ? a[e] : a[e + 8]; b8[e] = keep + __shfl_xor(send, 32); }
#pragma unroll
    for (int e = 0; e < 4; ++e) { const float keep = h4 ? b8[e + 4] : b8[e], send = h4 ? b8[e] : b8[e + 4]; b4[e] = keep + __shfl_xor(send, 16); }
#pragma unroll
    for (int e = 0; e < 2; ++e) { const float keep = h3 ? b4[e + 2] : b4[e], send = h3 ? b4[e] : b4[e + 2]; b2[e] = keep + __shfl_xor(send, 8); }
    const float keep = h2 ? b2[1] : b2[0], send = h2 ? b2[0] : b2[1];
    float r = keep + __shfl_xor(send, 4);
    r += __shfl_xor(r, 2); r += __shfl_xor(r, 1);
    return r;
}
#define LDS_WAIT() asm volatile("s_waitcnt lgkmcnt(0)" ::: "memory")
#define VM_WAIT() asm volatile("s_waitcnt vmcnt(0)" ::: "memory")

namespace pg8 {
constexpr int BM = 256, BK = 64, HALF = 128, HTB = HALF * BK * 2, STAGE_BYTES = 8 * HTB, NXCD = 8, WGM = 8;
__host__ __device__ __forceinline__ int lds_byte(int r, int c) { const int st = (r >> 4) * 2 + (c >> 5), rr = r & 15, cc = c & 31, ob = rr * 64 + cc * 2; return st * 1024 + (ob ^ (((ob >> 9) & 1) << 5)); }
__host__ __device__ __forceinline__ void stage_rc(int b, int& R, int& C) { const int st = b / 1024, sb = b % 1024, swz = sb ^ (((sb >> 9) & 1) << 5); R = (st >> 1) * 16 + swz / 64; C = (st & 1) * 32 + (swz % 64) / 2; }
__host__ __device__ __forceinline__ int perm32(int rho) { const int n = rho >> 4, i = rho & 15; return 8 * (i >> 2) + 4 * n + (i & 3); }

struct Unit { int pm, pn; size_t boff; };
struct Gemm { const bf16* A; const bf16* Bt; int K; const int* rowmap; };

struct StaticOrder {
    int nM, nN, nwg, G, c;
    __device__ void init(int M, int N, int G_, int c_) { nM = M / BM; nN = N / BM; nwg = nM * nN; G = G_; c = c_; }
    __device__ bool next(int i, Unit& u) const {
        const long L = (long)i * G + c; if (L >= nwg) return false;
        int wgid = (int)L; { const int q = nwg / NXCD, r = nwg % NXCD, xcd = wgid % NXCD, off = wgid / NXCD; wgid = (xcd < r ? xcd * (q + 1) : r * (q + 1) + (xcd - r) * q) + off; }
        const int nig = WGM * nN, gid = wgid / nig, fm = gid * WGM, gsz = (nM - fm) < WGM ? (nM - fm) : WGM;
        u.pm = fm + ((wgid % nig) % gsz); u.pn = (wgid % nig) / gsz; u.boff = 0; return true;
    }
};
struct PanelOrder {
    int pm, npn; size_t boff;
    __device__ bool next(int i, Unit& u) const { if (i >= npn) return false; u.pm = pm; u.pn = i; u.boff = boff; return true; }
};

template <class Epi, class Sched, bool ALIGN_EPI, bool GATHER>
__device__ __forceinline__ void gemm_phase(LAS unsigned char* lds, const Gemm g, const Sched& S, const Epi& E) {
    const int tid = tid_opaque(), wid = __builtin_amdgcn_readfirstlane(tid >> 6), lane = tid & 63, wr = wid >> 2, wc = wid & 3, fr = lane & 15, fq = lane >> 4;
    const int K = g.K, nt = K / BK;
    Unit cur, nxt; int ui = 0;
    if (!S.next(0, cur)) return;
    const size_t kstep = (size_t)(BK * 2);
    const size_t hstep = (size_t)HALF * K * 2;
    const size_t tstep = 2 * hstep;
    unsigned voffA[2][2], voffB[2];
#pragma unroll
    for (int i = 0; i < 2; ++i) { int R, C; stage_rc(tid * 16 + i * 8192, R, C); const int Rb = Epi::PERM ? ((R & ~31) + perm32(R & 31)) : R;
        voffB[i] = (unsigned)(Rb * K + C) * 2u;
#pragma unroll
        for (int h = 0; h < 2; ++h) {
            if (GATHER) voffA[h][i] = (unsigned)g.rowmap[cur.pm * BM + h * HALF + R] * (unsigned)(K * 2) + (unsigned)C * 2u;
            else voffA[h][i] = (unsigned)(R * K + C) * 2u + (unsigned)(h * hstep);
        } }
    const unsigned ldsw = (unsigned)wid * 1024u;
    const int aoff = lds_byte(wr * 64 + fr, fq * 8), boff = lds_byte(wc * 32 + fr, fq * 8);
#define PG8_SA(b, h) (((b) * 2 + (h)) * HTB)
#define PG8_SB(b, h) ((4 + (b) * 2 + (h)) * HTB)
#define PG8_STAGE_A(bufoff, gbase, h) do { _Pragma("unroll") for (int _i = 0; _i < 2; ++_i) \
        __builtin_amdgcn_global_load_lds((const unsigned*)((const char*)(gbase) + voffA[h][_i]), (LAS unsigned*)(lds + (bufoff) + ldsw + _i * 8192), 16, 0, 0); } while (0)
#define PG8_STAGE_B(bufoff, gbase) do { _Pragma("unroll") for (int _i = 0; _i < 2; ++_i) \
        __builtin_amdgcn_global_load_lds((const unsigned*)((const char*)(gbase) + voffB[_i]), (LAS unsigned*)(lds + (bufoff) + ldsw + _i * 8192), 16, 0, 0); } while (0)
#define PG8_LDA(dst, b, h) do { _Pragma("unroll") for (int m = 0; m < 4; ++m) _Pragma("unroll") for (int k = 0; k < 2; ++k) dst[m][k] = *(const LAS bf16x8*)(lds + PG8_SA(b, h) + aoff + m * 2048 + k * 1024); } while (0)
#define PG8_LDB(dst, b, h) do { _Pragma("unroll") for (int n = 0; n < 2; ++n) _Pragma("unroll") for (int k = 0; k < 2; ++k) dst[n][k] = *(const LAS bf16x8*)(lds + PG8_SB(b, h) + boff + n * 2048 + k * 1024); } while (0)
#define PG8_MMA(ai, bj, At, Bt) do { __builtin_amdgcn_s_setprio(1); _Pragma("unroll") for (int m = 0; m < 4; ++m) _Pragma("unroll") for (int n = 0; n < 2; ++n) _Pragma("unroll") for (int k = 0; k < 2; ++k) \
        acc[ai][bj][m][n] = __builtin_amdgcn_mfma_f32_16x16x32_bf16(Bt[n][k], At[m][k], acc[ai][bj][m][n], 0, 0, 0); __builtin_amdgcn_s_setprio(0); } while (0)
#define PG8_WAIT_V(n) asm volatile("s_waitcnt vmcnt(" #n ")" ::: "memory")
#define PG8_WAIT_L(n) asm volatile("s_waitcnt lgkmcnt(" #n ")" ::: "memory")
#define PG8_BAR __builtin_amdgcn_s_barrier()
#define PG8_SCHED __builtin_amdgcn_sched_barrier(0)
    f32x4 acc[2][2][4][2];
#pragma unroll
    for (int a = 0; a < 2; ++a)
#pragma unroll
        for (int b = 0; b < 2; ++b)
#pragma unroll
            for (int m = 0; m < 4; ++m)
#pragma unroll
                for (int n = 0; n < 2; ++n) acc[a][b][m][n] = (f32x4){0.f, 0.f, 0.f, 0.f};
    bf16x8 At[4][2], B0[2][2], B1[2][2];
    const char* cA = GATHER ? (const char*)g.A : (const char*)g.A + (size_t)cur.pm * tstep;
    const char* cB = (const char*)g.Bt + cur.boff + (size_t)cur.pn * tstep;
    if (GATHER) VM_WAIT();
    PG8_STAGE_B(PG8_SB(0, 0), cB); PG8_STAGE_B(PG8_SB(0, 1), cB + hstep); PG8_STAGE_A(PG8_SA(0, 0), cA, 0); PG8_STAGE_A(PG8_SA(0, 1), cA, 1);
    if (wr == 1) PG8_BAR;
    PG8_WAIT_V(2); PG8_BAR;
    PG8_STAGE_B(PG8_SB(1, 0), cB + kstep); PG8_STAGE_A(PG8_SA(1, 0), cA + kstep, 0); PG8_STAGE_B(PG8_SB(1, 1), cB + hstep + kstep);
    PG8_WAIT_V(6); PG8_BAR;
    for (;;) {
        const bool has_next = S.next(ui + 1, nxt);
        const char* nA = has_next ? (GATHER ? (const char*)g.A : (const char*)g.A + (size_t)nxt.pm * tstep) : cA;
        const char* nB = has_next ? (const char*)g.Bt + nxt.boff + (size_t)nxt.pn * tstep : cB;
        for (int t = 0; t < nt; t += 2) {
            const bool last = (t == nt - 2);
            const char* a1 = cA + (size_t)(t + 1) * kstep;
            const char* a2 = last ? nA : cA + (size_t)(t + 2) * kstep; const char* b2 = last ? nB : cB + (size_t)(t + 2) * kstep;
            const char* a3 = a2 + kstep; const char* b3 = b2 + kstep;
            PG8_LDB(B0, 0, 0); PG8_LDB(B1, 0, 1); PG8_SCHED; PG8_LDA(At, 0, 0); PG8_STAGE_A(PG8_SA(1, 1), a1, 1);
            PG8_WAIT_V(8); PG8_WAIT_L(0); PG8_BAR; PG8_MMA(0, 0, At, B0); PG8_MMA(0, 1, At, B1); PG8_BAR; PG8_SCHED;
            PG8_LDA(At, 0, 1); PG8_STAGE_B(PG8_SB(0, 0), b2); PG8_STAGE_B(PG8_SB(0, 1), b2 + hstep); PG8_STAGE_A(PG8_SA(0, 0), a2, 0);
            PG8_WAIT_V(8); PG8_WAIT_L(0); PG8_BAR; PG8_MMA(1, 0, At, B0); PG8_MMA(1, 1, At, B1); PG8_BAR; PG8_SCHED;
            PG8_LDB(B0, 1, 0); PG8_LDB(B1, 1, 1); PG8_SCHED; PG8_LDA(At, 1, 0); PG8_STAGE_A(PG8_SA(0, 1), a2, 1);
            PG8_WAIT_V(8); PG8_WAIT_L(0); PG8_BAR; PG8_MMA(0, 0, At, B0); PG8_MMA(0, 1, At, B1); PG8_BAR; PG8_SCHED;
            PG8_LDA(At, 1, 1); PG8_STAGE_B(PG8_SB(1, 0), b3); PG8_STAGE_B(PG8_SB(1, 1), b3 + hstep); PG8_STAGE_A(PG8_SA(1, 0), a3, 0);
            PG8_WAIT_V(8); PG8_WAIT_L(0); PG8_BAR; PG8_MMA(1, 0, At, B0); PG8_MMA(1, 1, At, B1); PG8_BAR; PG8_SCHED;
        }
        if constexpr (ALIGN_EPI) { if (wr == 0) PG8_BAR; }
        E(acc, cur, wr, wc, fr, fq);
        if (!has_next) break;
#pragma unroll
        for (int a = 0; a < 2; ++a)
#pragma unroll
            for (int b = 0; b < 2; ++b)
#pragma unroll
                for (int m = 0; m < 4; ++m)
#pragma unroll
                    for (int n = 0; n < 2; ++n) acc[a][b][m][n] = (f32x4){0.f, 0.f, 0.f, 0.f};
        cur = nxt; cA = nA; cB = nB; ++ui;
        if constexpr (ALIGN_EPI) { if (wr == 1) PG8_BAR; }
    }
    PG8_WAIT_V(0);
    if constexpr (!ALIGN_EPI) { if (wr == 0) PG8_BAR; }
    PG8_BAR;
#undef PG8_SA
#undef PG8_SB
#undef PG8_STAGE_A
#undef PG8_STAGE_B
#undef PG8_LDA
#undef PG8_LDB
#undef PG8_MMA
#undef PG8_WAIT_V
#undef PG8_WAIT_L
#undef PG8_BAR
#undef PG8_SCHED
}

struct EpiInProj {
    static constexpr bool PERM = true;
    unsigned char* ws; const float* lb;
    __device__ __forceinline__ void operator()(const f32x4 (&acc)[2][2][4][2], const Unit& u, int wr, int wc, int fr_, int fq) const {
        int fr = fr_; asm volatile("" : "+v"(fr));
        const int pn = u.pn; size_t base; int ld, colbase, act, hm;
        if (pn < 2) { base = WS_HQ; ld = 512; colbase = pn * 256; act = 1; hm = 1; }
        else if (pn < 4) { base = WS_HV; ld = 512; colbase = (pn - 2) * 256; act = 0; hm = 1; }
        else if (pn < 6) { base = WS_HG; ld = 512; colbase = (pn - 4) * 256; act = 1; hm = 0; }
        else if (pn < 10) { base = WS_LF; ld = 1024; colbase = (pn - 6) * 256; act = 3; hm = 2; }
        else if (pn < 14) { base = WS_QK; ld = 1024; colbase = (pn - 10) * 256; act = 0; hm = 0; }
        else if (pn < 16) { base = WS_MV; ld = 512; colbase = (pn - 14) * 256; act = 0; hm = 1; }
        else { base = WS_MO; ld = 512; colbase = (pn - 16) * 256; act = 2; hm = 0; }
        bf16* O = (bf16*)(ws + base);
        const int bb = u.pm / 33, s0 = (u.pm % 33) * BM + wr * 64 + fr;
        const int row0 = u.pm * BM + wr * 64 + fr, col0 = colbase + wc * 32 + 8 * fq;
#pragma unroll
        for (int bj = 0; bj < 2; ++bj) {
            float lbv[8];
            const int cf = col0 + bj * HALF;
            if (act == 3) {
#pragma unroll
                for (int e = 0; e < 8; ++e) lbv[e] = lb[cf + e];
            }
            const size_t hbase = (hm == 2) ? ((size_t)((bb * 2 + (cf >> 9)) * 4 + ((cf >> 7) & 3)) * SROW) : ((size_t)(bb * 4 + (cf >> 7)) * SROW);
#pragma unroll
            for (int ai = 0; ai < 2; ++ai)
#pragma unroll
                for (int m = 0; m < 4; ++m) {
                    float v[8];
#pragma unroll
                    for (int e = 0; e < 4; ++e) { v[e] = acc[ai][bj][m][0][e]; v[4 + e] = acc[ai][bj][m][1][e]; }
                    u32x4 w;
                    if (act == 3) {
#pragma unroll
                        for (int e = 0; e < 8; ++e) v[e] = __logf(lbv[e] + (1.0f - lbv[e]) * sigmoid_(v[e]));
                        w.x = pkh2(v[0], v[1]); w.y = pkh2(v[2], v[3]); w.z = pkh2(v[4], v[5]); w.w = pkh2(v[6], v[7]);
                    } else {
                        if (act == 1) {
#pragma unroll
                            for (int e = 0; e < 8; ++e) v[e] = silu_(v[e]);
                        } else if (act == 2) {
#pragma unroll
                            for (int e = 0; e < 8; ++e) v[e] = sigmoid_(v[e]);
                        }
                        w.x = pk2(v[0], v[1]); w.y = pk2(v[2], v[3]); w.z = pk2(v[4], v[5]); w.w = pk2(v[6], v[7]);
                    }
                    const size_t off = hm ? (hbase + (size_t)(s0 + ai * HALF + m * 16)) * 128 + (cf & 127) : (size_t)(row0 + ai * HALF + m * 16) * ld + cf;
                    *(u32x4*)(O + off) = w;
                }
        }
    }
};
struct EpiOutProj {
    static constexpr bool PERM = false;
    const float* x; float* out; const float* mod;
    __device__ __forceinline__ void operator()(const f32x4 (&acc)[2][2][4][2], const Unit& u, int wr, int wc, int fr_, int fq) const {
        int fr = fr_; asm volatile("" : "+v"(fr));
        const int row0 = u.pm * BM + wr * 64 + fr, col0 = u.pn * BM + wc * 32 + 4 * fq;
        const float* g1 = mod + (size_t)(u.pm / 32) * 6144 + 2048;
#pragma unroll
        for (int bj = 0; bj < 2; ++bj)
#pragma unroll
            for (int n = 0; n < 2; ++n) {
                const int c = col0 + bj * HALF + n * 16; const f32x4 gv = *(const f32x4*)(g1 + c);
#pragma unroll
                for (int ai = 0; ai < 2; ++ai)
#pragma unroll
                    for (int m = 0; m < 4; ++m) { const size_t off = (size_t)(row0 + ai * HALF + m * 16) * D + c;
                        *(f32x4*)(out + off) = *(const f32x4*)(x + off) + gv * acc[ai][bj][m][n]; }
            }
    }
};
struct EpiMoE1 {
    static constexpr bool PERM = true;
    bf16* H;
    __device__ __forceinline__ void operator()(const f32x4 (&acc)[2][2][4][2], const Unit& u, int wr, int wc, int fr_, int fq) const {
        int fr = fr_; asm volatile("" : "+v"(fr));
        const int row0 = u.pm * BM + wr * 64 + fr, col0 = u.pn * HALF + wc * 32 + 8 * fq;
#pragma unroll
        for (int ai = 0; ai < 2; ++ai)
#pragma unroll
            for (int m = 0; m < 4; ++m) {
                float v[8];
#pragma unroll
                for (int e = 0; e < 4; ++e) { v[e] = silu_(acc[ai][0][m][0][e]) * acc[ai][1][m][0][e]; v[4 + e] = silu_(acc[ai][0][m][1][e]) * acc[ai][1][m][1][e]; }
                u32x4 w; w.x = pk2(v[0], v[1]); w.y = pk2(v[2], v[3]); w.z = pk2(v[4], v[5]); w.w = pk2(v[6], v[7]);
                *(u32x4*)(H + (size_t)(row0 + ai * HALF + m * 16) * FF + col0) = w;
            }
    }
};
struct EpiMoE2 {
    static constexpr bool PERM = true;
    bf16* Y; const float* gatev;
    __device__ __forceinline__ void operator()(const f32x4 (&acc)[2][2][4][2], const Unit& u, int wr, int wc, int fr_, int fq) const {
        int fr = fr_; asm volatile("" : "+v"(fr));
        const int row0 = u.pm * BM + wr * 64 + fr, col0 = u.pn * BM + wc * 32 + 8 * fq;
#pragma unroll
        for (int ai = 0; ai < 2; ++ai)
#pragma unroll
            for (int m = 0; m < 4; ++m) { const int row = row0 + ai * HALF + m * 16; const float gt = gatev[row];
#pragma unroll
                for (int bj = 0; bj < 2; ++bj) { const f32x4 a = acc[ai][bj][m][0] * gt, b = acc[ai][bj][m][1] * gt;
                    u32x4 w; w.x = pk2(a[0], a[1]); w.y = pk2(a[2], a[3]); w.z = pk2(b[0], b[1]); w.w = pk2(b[2], b[3]);
                    *(u32x4*)(Y + (size_t)row * D + col0 + bj * HALF) = w; } }
    }
};
}

__device__ __forceinline__ void transpose_item(const float* W, int ldw, int k0, int n0, bf16* dst_row0, LAS float* scr, int lane) {
#pragma unroll 8
    for (int i = 0; i < 32; ++i) { const int kk = 2 * i + (lane >> 5); scr[kk * 33 + (lane & 31)] = W[(size_t)(k0 + kk) * ldw + n0 + (lane & 31)]; }
    LDS_WAIT(); asm volatile("" ::: "memory");
    const int c = lane & 7;
#pragma unroll
    for (int j = 0; j < 4; ++j) { const int n = (lane >> 3) + 8 * j; const LAS float* s = scr + (8 * c) * 33 + n;
        u32x4 o; o.x = pk2(s[0 * 33], s[1 * 33]); o.y = pk2(s[2 * 33], s[3 * 33]); o.z = pk2(s[4 * 33], s[5 * 33]); o.w = pk2(s[6 * 33], s[7 * 33]);
        *(u32x4*)(dst_row0 + (size_t)n * 1024 + k0 + 8 * c) = o; }
    LDS_WAIT(); asm volatile("" ::: "memory");
}
__device__ __forceinline__ void phase_prologue(const Params& p, LAS unsigned char* lds) {
    const int tid = tid_opaque(), lane = tid & 63, wave = tid >> 6;
    const int gw = blockIdx.x * NWAVES + wave, NGW = gridDim.x * NWAVES;
    LAS float* scr = (LAS float*)(lds + wave * 16384);
    constexpr int I_IN = 16 * 144, I_OUT = 16 * 32, I_E = 16 * 512, I_MOD = 24 * 16;
    constexpr int NITEMS = I_IN + I_OUT + 3 * I_E + I_MOD;
    unsigned char* ws = p.ws;
    for (int it = gw; it < NITEMS; it += NGW) {
        int r = it;
        if (r < I_IN) { const int kb = r / 144, nb = r % 144; transpose_item(p.w_in, PROJ, kb * 64, nb * 32, (bf16*)(ws + WS_WIN_T) + (size_t)(nb * 32) * 1024, scr, lane); continue; } r -= I_IN;
        if (r < I_OUT) { const int kb = r / 32, nb = r % 32; transpose_item(p.w_out, D, kb * 64, nb * 32, (bf16*)(ws + WS_WOUT_T) + (size_t)(nb * 32) * 1024, scr, lane); continue; } r -= I_OUT;
        if (r < 2 * I_E) { const int up = r / I_E; r -= up * I_E; const int e = r / 512, q = r % 512, kb = q / 32, nb = q % 32, n0 = nb * 32;
            const int drow = (n0 / 128) * 256 + up * 128 + (n0 % 128);
            transpose_item((up ? p.wu : p.wg) + (size_t)e * D * FF, FF, kb * 64, n0, (bf16*)(ws + WS_WGU_T) + ((size_t)e * 2048 + drow) * 1024, scr, lane); continue; } r -= 2 * I_E;
        if (r < I_E) { const int e = r / 512, q = r % 512, kb = q / 32, nb = q % 32;
            transpose_item(p.wd + (size_t)e * FF * D, D, kb * 64, nb * 32, (bf16*)(ws + WS_WD_T) + ((size_t)e * 1024 + nb * 32) * 1024, scr, lane); continue; } r -= I_E;
        {
            const int cb = r / 16, ks = r % 16; const int col = cb * 256 + lane * 4;
            f32x4 a[5];
            float sv[5];
#pragma unroll
            for (int q = 0; q < 5; ++q) { a[q] = (f32x4){0.f, 0.f, 0.f, 0.f}; const float cv = (q < 4) ? p.c[q * D + ks * 64 + lane] : p.c_ctx[ks * 64 + lane]; sv[q] = silu_(cv); }
#pragma unroll 8
            for (int kk = 0; kk < 64; ++kk) {
                const f32x4 w = *(const f32x4*)(p.ada_w + (size_t)(ks * 64 + kk) * 6144 + col);
#pragma unroll
                for (int q = 0; q < 5; ++q) a[q] += w * __uint_as_float((unsigned)__builtin_amdgcn_readlane((int)__float_as_uint(sv[q]), kk));
            }
            float* mp = (float*)(ws + WS_MODP);
#pragma unroll
            for (int q = 0; q < 5; ++q) *(f32x4*)(mp + ((size_t)ks * 5 + q) * 6144 + col) = a[q];
        }
    }
    const int gt = blockIdx.x * NTHR + tid, NGT = gridDim.x * NTHR;
    for (int i = gt; i < 1024; i += NGT) { const float l0 = p.lb_logits[i], l1 = p.lb_logits[1024 + i]; ((float*)(ws + WS_LB))[i] = 1.0f / (1.0f + __expf(l1 - l0)); }
    for (int i = gt; i < 16 * 1024; i += NGT) { const int g = i >> 10, k = i & 1023; ((float*)(ws + WS_WGT))[i] = p.w_in[(size_t)k * PROJ + NPROJ + g]; ((float*)(ws + WS_RWT))[i] = p.router_w[k * 16 + g]; }
}

__device__ __forceinline__ void phase_u(const Params& p, LAS unsigned char* lds) {
    const int tid = tid_opaque(), lane = tid & 63, wave = tid >> 6;
    unsigned char* ws = p.ws;
    LAS float* Lsh = (LAS float*)lds;
    LAS float* Lsc = Lsh + 5 * 1024;
    LAS float* Lnw = Lsc + 5 * 1024;
    LAS float* Lwg = Lnw + 1024;
    const float* modp = (const float*)(ws + WS_MODP);
    for (int idx = tid; idx < 5 * 2048; idx += NTHR) { const int r = idx / 2048, col = idx % 2048; float s = p.ada_b[col];
        for (int ks = 0; ks < 16; ++ks) s += modp[((size_t)ks * 5 + r) * 6144 + col];
        if (col < 1024) Lsh[r * 1024 + col] = s; else Lsc[r * 1024 + col - 1024] = s; }
    for (int e = blockIdx.x * NTHR + tid; e < 5 * 6144; e += gridDim.x * NTHR) { const int r = e / 6144, col = e % 6144; float s = p.ada_b[col];
        for (int ks = 0; ks < 16; ++ks) s += modp[((size_t)ks * 5 + r) * 6144 + col];
        ((float*)(ws + WS_MOD))[e] = s; }
    for (int i = tid; i < 1024; i += NTHR) Lnw[i] = p.norm1_w[i];
    for (int i = tid; i < 16 * 1024; i += NTHR) Lwg[i] = ((const float*)(ws + WS_WGT))[i];
    __syncthreads();
    const int gw = blockIdx.x * NWAVES + wave, NGW = gridDim.x * NWAVES;
    for (int row = gw; row < R_ALL; row += NGW) {
        const int b = row / SROW, s = row % SROW;
        const float* src = (s < CTX) ? p.ctx + ((size_t)b * CTX + s) * D : p.x + ((size_t)b * SEQ + (s - CTX)) * D;
        const int r = (s < CTX) ? 4 : b;
        f32x4 v[4]; float ss = 0.f;
#pragma unroll
        for (int j = 0; j < 4; ++j) { v[j] = *(const f32x4*)(src + j * 256 + lane * 4); ss += (v[j].x * v[j].x + v[j].y * v[j].y) + (v[j].z * v[j].z + v[j].w * v[j].w); }
        const float rstd = rsqrtf(wave_sum(ss) * (1.0f / D) + EPS);
        bf16* urow = (bf16*)(ws + WS_U) + (size_t)row * D;
#pragma unroll
        for (int j = 0; j < 4; ++j) { const int c0 = j * 256 + lane * 4;
            const f32x4 nw = *(const LAS f32x4*)(Lnw + c0), sc = *(const LAS f32x4*)(Lsc + r * 1024 + c0), sh = *(const LAS f32x4*)(Lsh + r * 1024 + c0);
            v[j] = v[j] * rstd * nw * (1.0f + sc) + sh;
            u32x2 w; w.x = pk2(v[j].x, v[j].y); w.y = pk2(v[j].z, v[j].w); *(u32x2*)(urow + c0) = w; }
        float pa[16];
#pragma unroll
        for (int g = 0; g < 16; ++g) { float a = 0.f;
#pragma unroll
            for (int j = 0; j < 4; ++j) { const f32x4 w = *(const LAS f32x4*)(Lwg + g * 1024 + j * 256 + lane * 4); a += (v[j].x * w.x + v[j].y * w.y) + (v[j].z * w.z + v[j].w * w.w); }
            pa[g] = a; if (g & 1) __builtin_amdgcn_sched_barrier(0); }
        const float mine = butterfly16(pa, lane);
        if ((lane & 3) == 0) { const int gi = lane >> 2; float gv = mine + p.ml_gate_b[gi];
            if ((gi >> 2) & 1) gv = fminf(gv, 0.f) - log1pf(__expf(-fabsf(gv)));
            ((float*)(ws + WS_GATES))[(size_t)row * 16 + gi] = gv; }
    }
}

__device__ __forceinline__ void conv_loadcol(const bf16* QKb, int r, int c, int ch, float (&o)[3][8]) {
#pragma unroll
    for (int i = 0; i < 3; ++i) { const int r2 = r + i - 1;
        if (c < 0 || c > 63 || r2 < 0 || r2 > 127) {
#pragma unroll
            for (int e = 0; e < 8; ++e) o[i][e] = 0.f;
        } else { const u32x4 w = *(const u32x4*)(QKb + (size_t)(r2 * 64 + c) * 1024 + ch);
            o[i][0] = bflo(w.x); o[i][1] = bfhi(w.x); o[i][2] = bflo(w.y); o[i][3] = bfhi(w.y); o[i][4] = bflo(w.z); o[i][5] = bfhi(w.z); o[i][6] = bflo(w.w); o[i][7] = bfhi(w.w); } }
}
__device__ __forceinline__ void conv_out(const float (&L)[3][8], const float (&M)[3][8], const float (&R)[3][8], const float (&wv)[9][8], const float (&bias)[8], float sc, bf16* dst) {
    float a[8];
#pragma unroll
    for (int e = 0; e < 8; ++e) { float t = bias[e];
#pragma unroll
        for (int i = 0; i < 3; ++i) t += L[i][e] * wv[i * 3][e] + M[i][e] * wv[i * 3 + 1][e] + R[i][e] * wv[i * 3 + 2][e];
        a[e] = silu_(t) * sc; }
    u32x4 o; o.x = pk2(a[0], a[1]); o.y = pk2(a[2], a[3]); o.z = pk2(a[4], a[5]); o.w = pk2(a[6], a[7]);
    *(u32x4*)dst = o;
}
__device__ __forceinline__ void phase_conv(const Params& p) {
    unsigned char* ws = p.ws;
    const bf16* QK = (const bf16*)(ws + WS_QK); bf16* QKC = (bf16*)(ws + WS_QKC);
    const int tid0 = tid_opaque();
    {
        const int lane = tid0 & 63, gw = blockIdx.x * NWAVES + (tid0 >> 6), NGW = gridDim.x * NWAVES;
        for (int item = gw; item < NB * 128 * 4; item += NGW) {
            const int half = item & 1, seg = (item >> 1) & 1, r = (item >> 2) & 127, b = item >> 9;
            const int ch = (half * 64 + lane) * 8;
            float wv[9][8], bias[8];
#pragma unroll
            for (int k = 0; k < 9; ++k) { const f32x4 w0 = *(const f32x4*)(p.conv_w + (size_t)k * 1024 + ch), w1 = *(const f32x4*)(p.conv_w + (size_t)k * 1024 + ch + 4);
                wv[k][0] = w0.x; wv[k][1] = w0.y; wv[k][2] = w0.z; wv[k][3] = w0.w; wv[k][4] = w1.x; wv[k][5] = w1.y; wv[k][6] = w1.z; wv[k][7] = w1.w; }
            { const f32x4 b0 = *(const f32x4*)(p.conv_b + ch), b1 = *(const f32x4*)(p.conv_b + ch + 4); bias[0] = b0.x; bias[1] = b0.y; bias[2] = b0.z; bias[3] = b0.w; bias[4] = b1.x; bias[5] = b1.y; bias[6] = b1.z; bias[7] = b1.w; }
            const float sc = (ch >= 512) ? 0.08838834764831845f : 1.0f;
            const bf16* QKb = QK + ((size_t)b * SROW + CTX) * 1024;
            bf16* dst = QKC + (size_t)(ch >> 9) * ((size_t)R_ALL * 512) + ((size_t)(b * 4 + ((ch >> 7) & 3)) * SROW + CTX + r * 64) * 128 + (ch & 127);
            const int c0 = seg * 32;
            float L[3][8], M[3][8], R[3][8];
            conv_loadcol(QKb, r, c0 - 1, ch, L); conv_loadcol(QKb, r, c0, ch, M);
#pragma unroll 1
            for (int c = c0; c < c0 + 32; c += 3) {
                conv_loadcol(QKb, r, c + 1, ch, R); conv_out(L, M, R, wv, bias, sc, dst + (size_t)c * 128);
                if (c + 1 < c0 + 32) { conv_loadcol(QKb, r, c + 2, ch, L); conv_out(M, R, L, wv, bias, sc, dst + (size_t)(c + 1) * 128); }
                if (c + 2 < c0 + 32) { conv_loadcol(QKb, r, c + 3, ch, M); conv_out(R, L, M, wv, bias, sc, dst + (size_t)(c + 2) * 128); }
            }
        }
    }
    for (int it = blockIdx.x * NTHR + tid0; it < NB * CTX * 128; it += gridDim.x * NTHR) {
        const int ch = (it & 127) * 8, s = (it >> 7) & (CTX - 1), b = it >> 15;
        float a[8];
#pragma unroll
        for (int e = 0; e < 8; ++e) a[e] = p.conv_b[ch + e];
#pragma unroll
        for (int j = 0; j < 3; ++j) { const int s2 = s + j - 1; if (s2 < 0 || s2 >= CTX) continue;
            const u32x4 w = *(const u32x4*)(QK + ((size_t)b * SROW + s2) * 1024 + ch); const float* cw = p.conv_w + (size_t)(3 + j) * 1024 + ch;
            a[0] += bflo(w.x) * cw[0]; a[1] += bfhi(w.x) * cw[1]; a[2] += bflo(w.y) * cw[2]; a[3] += bfhi(w.y) * cw[3];
            a[4] += bflo(w.z) * cw[4]; a[5] += bfhi(w.z) * cw[5]; a[6] += bflo(w.w) * cw[6]; a[7] += bfhi(w.w) * cw[7]; }
        const float sc = (ch >= 512) ? 0.08838834764831845f : 1.0f;
#pragma unroll
        for (int e = 0; e < 8; ++e) a[e] = silu_(a[e]) * sc;
        u32x4 o; o.x = pk2(a[0], a[1]); o.y = pk2(a[2], a[3]); o.z = pk2(a[4], a[5]); o.w = pk2(a[6], a[7]);
        *(u32x4*)(QKC + (size_t)(ch >> 9) * ((size_t)R_ALL * 512) + ((size_t)(b * 4 + ((ch >> 7) & 3)) * SROW + s) * 128 + (ch & 127)) = o;
    }
    {
        const int lane = tid0 & 63, gw = blockIdx.x * NWAVES + (tid0 >> 6), NGW = gridDim.x * NWAVES;
        for (int it = gw; it < 32 * 132; it += NGW) {
            const int chain = it / 132, ck = it % 132, dir = chain >> 4, b = (chain >> 2) & 3, h = chain & 3;
            const int n = ck * 64 + lane, s = dir ? (n < CTX ? CTX - 1 - n : CTX + (SROW - 1 - n)) : n;
            const float* gp = (const float*)(ws + WS_GATES) + ((size_t)b * SROW + s) * 16 + dir * 8 + h;
            const float li = gp[0]; float bs_ = gp[4];
#pragma unroll
            for (int o = 1; o < 64; o <<= 1) { const float t = __shfl_up(bs_, o); if (lane >= o) bs_ += t; }
            const float gg = li - bs_; float gm = gg;
#pragma unroll
            for (int o = 1; o < 64; o <<= 1) gm = fmaxf(gm, __shfl_xor(gm, o));
            ((float*)(ws + WS_SCB))[(size_t)chain * SROW + n] = bs_; ((float*)(ws + WS_SCG))[(size_t)chain * SROW + n] = gg;
            if (lane == 0) ((float*)(ws + WS_SCM))[chain * 132 + ck] = gm;
        }
    }
}

#define PSTAMP(k) do { if (PROF != 0 && OUT) { const unsigned long long t_ = __builtin_amdgcn_s_memrealtime(); if (PROF == (k)) tacc += t_ - tprev; tprev = t_; } } while (0)
namespace sc {
typedef short v4i16_t __attribute__((ext_vector_type(4)));
constexpr int PQ = 288, PK = 160;
constexpr int L_QT = 0, L_KT = 18432, L_K2T = 36864, L_V = 57344, L_P = 75776, L_O = 86016, L_ST = 104448, L_TOT = 141312, L_DVEC = 145408, L_EREF = 145920,
              L_N = 146432, L_DV = 146944, L_FL = 147200, L_END = 147456;
constexpr size_t SEG_STRIDE = 66560;

__device__ __forceinline__ int s_of(int dir, int n) { return dir ? (n < CTX ? CTX - 1 - n : CTX + (SROW - 1 - n)) : n; }
__device__ __forceinline__ bf16x8 ld8(LAS unsigned char* lds, int off) { return *(const LAS bf16x8*)(lds + off); }
__device__ __forceinline__ bf16x8 trB(LAS unsigned char* lds, int off) {
    const v4i16_t a = __builtin_amdgcn_ds_read_tr16_b64_v4i16((LAS v4i16_t*)(lds + off));
    const v4i16_t b = __builtin_amdgcn_ds_read_tr16_b64_v4i16((LAS v4i16_t*)(lds + off + 4 * PQ));
    return (bf16x8){a[0], a[1], a[2], a[3], b[0], b[1], b[2], b[3]};
}
__device__ __forceinline__ float rdlane(float v, int idx) { return __uint_as_float((unsigned)__builtin_amdgcn_readlane((int)__float_as_uint(v), idx)); }
#define SC_MFMA(a, b, c) __builtin_amdgcn_mfma_f32_16x16x32_bf16((a), (b), (c), 0, 0, 0)

template <bool ML>
__device__ __forceinline__ void pc_step(LAS unsigned char* lds, int w, int li, int g, int offA, int offB) {
    for (int ti = w; ti < 10; ti += 8) {
        const int ib = (ti >= 6) ? 3 : (ti >= 3) ? 2 : (ti >= 1) ? 1 : 0, jb = ti - (ib * (ib + 1)) / 2;
        f32x4 acc = (f32x4){0.f, 0.f, 0.f, 0.f};
#pragma unroll
        for (int s = 0; s < 4; ++s) acc = SC_MFMA(ld8(lds, offA + (16 * jb + li) * PQ + (32 * s + 8 * g) * 2), ld8(lds, offB + (16 * ib + li) * PQ + (32 * s + 8 * g) * 2), acc);
        const int i = 16 * ib + li, j0 = 16 * jb + 4 * g;
        const float v0 = (j0 + 0 <= i) ? acc[0] : 0.f, v1 = (j0 + 1 <= i) ? acc[1] : 0.f, v2 = (j0 + 2 <= i) ? acc[2] : 0.f, v3 = (j0 + 3 <= i) ? acc[3] : 0.f;
        u32x2 pw; pw.x = pk2(v0, v1); pw.y = pk2(v2, v3);
        *(LAS u32x2*)(lds + L_P + i * PK + j0 * 2) = pw;
        if (ML) { float ps = (bflo(pw.x) + bfhi(pw.x)) + (bflo(pw.y) + bfhi(pw.y)); ps += __shfl_xor(ps, 16); ps += __shfl_xor(ps, 32);
            if (g == 0) __hip_atomic_fetch_add((LAS float*)(lds + L_DV) + i, ps, __ATOMIC_RELAXED, __HIP_MEMORY_SCOPE_WORKGROUP); }
    }
}
__device__ __forceinline__ void w_step(const Params& p, LAS unsigned char* lds, int tid, int dir, int b, int nbase, int type, int h) {
#pragma unroll
    for (int q = 0; q < 2; ++q) { const int idx = tid + q * NTHR, i = idx >> 4, ch = idx & 15;
        const u32x4 val = *(const LAS u32x4*)(lds + L_O + i * PQ + ch * 16);
        const int t = s_of(dir, nbase + i) - CTX;
        *(u32x4*)((bf16*)p.out + (((size_t)(dir * 2 + type) * 16 + (b * 4 + h)) * SEQ + t) * 128 + ch * 8) = val; }
}
__device__ __forceinline__ void save_tiles(float* dst, const f32x4 (&S)[8], int w, int lane) {
#pragma unroll
    for (int t = 0; t < 8; ++t) *(f32x4*)(dst + ((size_t)(w * 8 + t) * 64 + lane) * 4) = S[t];
}

#define SC_SB __builtin_amdgcn_sched_barrier(0)
template <bool ML>
__device__ __forceinline__ void o_tiles(LAS unsigned char* lds, const bf16x8 (&bv)[2], const bf16x8 (&bs)[4], int w, int li, int g) {
#pragma unroll
    for (int it = 0; it < 4; ++it) {
        bf16x8 fp[2], fq[4]; float den = 1.f, fl = 0.f;
        fp[0] = ld8(lds, L_P + (16 * it + li) * PK + (8 * g) * 2);
        if (it >= 2) fp[1] = ld8(lds, L_P + (16 * it + li) * PK + (32 + 8 * g) * 2); else fp[1] = fp[0];
#pragma unroll
        for (int s = 0; s < 4; ++s) fq[s] = ld8(lds, L_QT + (16 * it + li) * PQ + (32 * s + 8 * g) * 2);
        if (ML) { den = *(const LAS float*)(lds + L_DV + 4 * (16 * it + li)); fl = *(const LAS float*)(lds + L_FL + 4 * (16 * it + li)); }
        SC_SB;
        f32x4 acc = (f32x4){0.f, 0.f, 0.f, 0.f};
        acc = SC_MFMA(bv[0], fp[0], acc);
        if (it >= 2) acc = SC_MFMA(bv[1], fp[1], acc);
#pragma unroll
        for (int s = 0; s < 4; ++s) acc = SC_MFMA(bs[s], fq[s], acc);
        SC_SB;
        const int i = 16 * it + li;
        if (ML) acc = acc * __builtin_amdgcn_rcpf(fmaxf(fabsf(den), fl));
        u32x2 pw; pw.x = pk2(acc[0], acc[1]); pw.y = pk2(acc[2], acc[3]); *(LAS u32x2*)(lds + L_O + i * PQ + (16 * w + 4 * g) * 2) = pw;
    }
}
__device__ __forceinline__ void s_update(LAS unsigned char* lds, f32x4 (&S)[8], const bf16x8 (&bv)[2], int li, int g) {
#pragma unroll
    for (int hp = 0; hp < 2; ++hp) {
        bf16x8 fk[4][2];
#pragma unroll
        for (int u = 0; u < 4; ++u)
#pragma unroll
            for (int s = 0; s < 2; ++s) fk[u][s] = ld8(lds, L_K2T + (16 * (4 * hp + u) + li) * PK + (32 * s + 8 * g) * 2);
        SC_SB;
#pragma unroll
        for (int s = 0; s < 2; ++s)
#pragma unroll
            for (int u = 0; u < 4; ++u) S[4 * hp + u] = SC_MFMA(fk[u][s], bv[s], S[4 * hp + u]);
        SC_SB;
    }
}

struct HgIn { unsigned lf[8], q[8], v[8]; };
template <bool OUT>
__device__ __forceinline__ void hg_load(const Params& p, HgIn& r, int dir, int b, int h, int nbase, int w, int l) {
    const unsigned char* ws = p.ws;
    const size_t sp0 = (size_t)s_of(dir, nbase + 8 * w); const long step = dir ? -256 : 256;
    const char* plf = (const char*)(ws + WS_LF) + ((size_t)((b * 2 + dir) * 4 + h) * SROW + sp0) * 256;
    const char* pv = (const char*)(ws + WS_HV) + ((size_t)(b * 4 + h) * SROW + sp0) * 256;
    const char* pq = (const char*)(ws + WS_HQ) + ((size_t)(b * 4 + h) * SROW + sp0) * 256;
#pragma unroll
    for (int t = 0; t < 8; ++t) {
        r.lf[t] = *(const unsigned*)(plf + t * step + 4 * l);
        r.v[t] = *(const unsigned*)(pv + t * step + 4 * l);
        if (OUT) r.q[t] = *(const unsigned*)(pq + t * step + 4 * l); else r.q[t] = 0u; }
}
template <bool OUT>
__device__ __forceinline__ void hg_chunk(const Params& p, LAS unsigned char* lds, int dir, int b, int h, int nbase, f32x4 (&S)[8], float& lt0, float& lt1, unsigned long long& tacc,
                                         const HgIn& cur, HgIn& pf, bool do_pf, int tid, int w, int l, int li, int g) {
        unsigned long long tprev = 0; PSTAMP(0);
        float c0 = 0.f, c1 = 0.f;
#pragma unroll
        for (int t = 0; t < 8; ++t) { c0 += h2f((unsigned short)(cur.lf[t] & 0xffffu)); c1 += h2f((unsigned short)(cur.lf[t] >> 16)); }
        *(LAS f32x2*)(lds + L_TOT + (w * 128 + 2 * l) * 4) = (f32x2){c0, c1};
        __syncthreads(); PSTAMP(1);
        float pre0 = 0.f, pre1 = 0.f, ar0 = 0.f, ar1 = 0.f, al0 = 0.f, al1 = 0.f;
#pragma unroll
        for (int w2 = 0; w2 < 8; ++w2) { const f32x2 tt = *(const LAS f32x2*)(lds + L_TOT + (w2 * 128 + 2 * l) * 4);
            if (w2 < w) { pre0 += tt.x; pre1 += tt.y; } if (w2 < 4) { ar0 += tt.x; ar1 += tt.y; } al0 += tt.x; al1 += tt.y; }
        unsigned k2a[8], k2b[8];
        const float c20 = __expf(al0 - ar0), c21 = __expf(al1 - ar1);
        float A0 = pre0, A1 = pre1;
#pragma unroll
        for (int t = 0; t < 8; ++t) { const int j = 8 * w + t;
            const float lf0 = h2f((unsigned short)(cur.lf[t] & 0xffffu)), lf1 = h2f((unsigned short)(cur.lf[t] >> 16));
            A0 += lf0; A1 += lf1;
            const float k0 = 1.0f - __expf(lf0), k1 = 1.0f - __expf(lf1);
            float kt0, kt1, kk0, kk1;
            if (OUT) { kt0 = k0 * __expf(fminf(ar0 - A0, 60.f)); kt1 = k1 * __expf(fminf(ar1 - A1, 60.f)); kk0 = kt0 * c20; kk1 = kt1 * c21; }
            else { kt0 = kt1 = 0.f; kk0 = k0 * __expf(al0 - A0); kk1 = k1 * __expf(al1 - A1); }
            if (OUT) *(LAS unsigned*)(lds + L_KT + j * PQ + 4 * l) = pk2(kt0, kt1);
            *(LAS unsigned*)(lds + L_V + j * PQ + 4 * l) = cur.v[t];
            if (OUT) { const float q0 = bflo(cur.q[t]) * __expf(fminf(A0 - ar0, 60.f)), q1 = bfhi(cur.q[t]) * __expf(fminf(A1 - ar1, 60.f));
                *(LAS unsigned*)(lds + L_QT + j * PQ + 4 * l) = pk2(q0, q1); }
            const unsigned kk = pk2(kk0, kk1);
            if (t & 1) { k2a[t >> 1] = (k2a[t >> 1] & 0xffffu) | (kk << 16); k2b[t >> 1] = (k2b[t >> 1] & 0xffffu) | (kk & 0xffff0000u); }
            else { k2a[t >> 1] = kk & 0xffffu; k2b[t >> 1] = kk >> 16; } }
        *(LAS u32x4*)(lds + L_K2T + (2 * l) * PK + 16 * w) = (u32x4){k2a[0], k2a[1], k2a[2], k2a[3]};
        *(LAS u32x4*)(lds + L_K2T + (2 * l + 1) * PK + 16 * w) = (u32x4){k2b[0], k2b[1], k2b[2], k2b[3]};
        if (w == 0) { *(LAS f32x2*)(lds + L_DVEC + 8 * l) = (f32x2){__expf(al0), __expf(al1)}; *(LAS f32x2*)(lds + L_EREF + 8 * l) = (f32x2){__expf(ar0), __expf(ar1)}; }
        lt0 += al0; lt1 += al1;
        __syncthreads(); PSTAMP(2);
        if (do_pf) hg_load<OUT>(p, pf, dir, b, h, nbase + 128, w, l);
        if (OUT) { pc_step<false>(lds, w, li, g, L_KT, L_QT); __syncthreads(); } PSTAMP(3);
        bf16x8 bv[2];
#pragma unroll
        for (int s = 0; s < 2; ++s) bv[s] = trB(lds, L_V + (32 * s + 8 * g + (li >> 2)) * PQ + (16 * w + 4 * (li & 3)) * 2);
        if (OUT) {
            f32x4 er[8];
#pragma unroll
            for (int t = 0; t < 8; ++t) er[t] = *(const LAS f32x4*)(lds + L_EREF + (16 * t + 4 * g) * 4);
            SC_SB;
#pragma unroll
            for (int t = 0; t < 8; ++t) { const f32x4 sv = S[t] * er[t];
                u32x2 pw; pw.x = pk2(sv[0], sv[1]); pw.y = pk2(sv[2], sv[3]); *(LAS u32x2*)(lds + L_ST + (16 * w + li) * PQ + (16 * t + 4 * g) * 2) = pw; }
            bf16x8 bs[4];
#pragma unroll
            for (int s = 0; s < 4; ++s) bs[s] = ld8(lds, L_ST + (16 * w + li) * PQ + (32 * s + 8 * g) * 2);
            o_tiles<false>(lds, bv, bs, w, li, g);
        }
        {   f32x4 dvv[8];
#pragma unroll
            for (int t = 0; t < 8; ++t) dvv[t] = *(const LAS f32x4*)(lds + L_DVEC + (16 * t + 4 * g) * 4);
            SC_SB;
#pragma unroll
            for (int t = 0; t < 8; ++t) S[t] = S[t] * dvv[t]; }
        s_update(lds, S, bv, li, g);
        __syncthreads(); PSTAMP(4);
        if (OUT) w_step(p, lds, tid, dir, b, nbase, 0, h);
        PSTAMP(5);
}
template <bool OUT>
__device__ __forceinline__ void hg_run(const Params& p, LAS unsigned char* lds, int dir, int b, int h, int n0, int nch, f32x4 (&S)[8], float& lt0, float& lt1, unsigned long long& tacc) {
    const int tid = tid_opaque(), w = __builtin_amdgcn_readfirstlane(tid >> 6), l = tid & 63, li = l & 15, g = l >> 4;
    HgIn A, B, C;
    hg_load<OUT>(p, A, dir, b, h, n0, w, l);
    if (nch > 1) hg_load<OUT>(p, B, dir, b, h, n0 + 64, w, l);
    for (int c = 0; c < nch; c += 3) {
        hg_chunk<OUT>(p, lds, dir, b, h, n0 + 64 * c, S, lt0, lt1, tacc, A, C, c + 2 < nch, tid, w, l, li, g);
        if (c + 1 < nch) hg_chunk<OUT>(p, lds, dir, b, h, n0 + 64 * (c + 1), S, lt0, lt1, tacc, B, A, c + 3 < nch, tid, w, l, li, g);
        if (c + 2 < nch) hg_chunk<OUT>(p, lds, dir, b, h, n0 + 64 * (c + 2), S, lt0, lt1, tacc, C, B, c + 4 < nch, tid, w, l, li, g);
    }
}

struct MlIn { unsigned q[8], k[8], v[8]; float bs, gg, gm; };
template <bool OUT>
__device__ __forceinline__ void ml_load(const Params& p, MlIn& r, int dir, int b, int h, int nbase, int w, int l) {
    const unsigned char* ws = p.ws;
    const size_t sp0 = (size_t)s_of(dir, nbase + 8 * w); const long step = dir ? -256 : 256;
    const size_t o0 = ((size_t)(b * 4 + h) * SROW + sp0) * 256;
    const char* pq = (const char*)(ws + WS_QKC) + o0; const char* pk = pq + (size_t)R_ALL * 1024; const char* pv = (const char*)(ws + WS_MV) + o0;
#pragma unroll
    for (int t = 0; t < 8; ++t) {
        r.k[t] = *(const unsigned*)(pk + t * step + 4 * l);
        r.v[t] = *(const unsigned*)(pv + t * step + 4 * l);
        if (OUT) r.q[t] = *(const unsigned*)(pq + t * step + 4 * l); else r.q[t] = 0u; }
    const int chain = (dir * 4 + b) * 4 + h;
    r.bs = ((const float*)(ws + WS_SCB))[(size_t)chain * SROW + nbase + l]; r.gg = ((const float*)(ws + WS_SCG))[(size_t)chain * SROW + nbase + l];
    r.gm = ((const float*)(ws + WS_SCM))[chain * 132 + (nbase >> 6)];
}
template <bool OUT>
__device__ __forceinline__ void ml_chunk(const Params& p, LAS unsigned char* lds, int dir, int b, int h, int nbase, f32x4 (&S)[8], float& m_prev, float& btot, unsigned long long& tacc,
                                         const MlIn& cur, MlIn& pf, bool do_pf, int tid, int w, int l, int li, int g) {
        unsigned long long tprev = 0; PSTAMP(0);
        const float bs_ = cur.bs, gg = cur.gg, gm = cur.gm;
        const float G = fmaxf(m_prev, gm), s_in = __expf(m_prev - G), eg = __expf(gg - G), b63 = rdlane(bs_, 63);
        if (w == 0 && OUT) *(LAS float*)(lds + L_FL + 4 * l) = __expf(-(bs_ + G));
        float n0v = 0.f, n1v = 0.f;
        if (OUT) { const f32x2 nn = *(const LAS f32x2*)(lds + L_N + 8 * l); n0v = nn.x * s_in; n1v = nn.y * s_in; }
        float ks0 = 0.f, ks1 = 0.f; unsigned k2a[8], k2b[8]; float qd[8];
#pragma unroll
        for (int t = 0; t < 8; ++t) { const int j = 8 * w + t; const float egj = rdlane(eg, j);
            const float kh0 = bflo(cur.k[t]) * egj, kh1 = bfhi(cur.k[t]) * egj; ks0 += kh0; ks1 += kh1;
            const unsigned kk = pk2(kh0, kh1);
            *(LAS unsigned*)(lds + L_V + j * PQ + 4 * l) = cur.v[t];
            if (OUT) { *(LAS unsigned*)(lds + L_KT + j * PQ + 4 * l) = kk; *(LAS unsigned*)(lds + L_QT + j * PQ + 4 * l) = cur.q[t];
                qd[t] = bflo(cur.q[t]) * n0v + bfhi(cur.q[t]) * n1v; } else qd[t] = 0.f;
            if (t & 1) { k2a[t >> 1] = (k2a[t >> 1] & 0xffffu) | (kk << 16); k2b[t >> 1] = (k2b[t >> 1] & 0xffffu) | (kk & 0xffff0000u); }
            else { k2a[t >> 1] = kk & 0xffffu; k2b[t >> 1] = kk >> 16; } }
        if (OUT) {
            const bool h5 = (l & 32) != 0, h4 = (l & 16) != 0, h3 = (l & 8) != 0; float r4[4], r2[2];
#pragma unroll
            for (int e = 0; e < 4; ++e) { const float keep = h5 ? qd[e + 4] : qd[e], send = h5 ? qd[e] : qd[e + 4]; r4[e] = keep + __shfl_xor(send, 32); }
#pragma unroll
            for (int e = 0; e < 2; ++e) { const float keep = h4 ? r4[e + 2] : r4[e], send = h4 ? r4[e] : r4[e + 2]; r2[e] = keep + __shfl_xor(send, 16); }
            const float keep = h3 ? r2[1] : r2[0], send = h3 ? r2[0] : r2[1];
            float r1 = keep + __shfl_xor(send, 8);
            r1 += __shfl_xor(r1, 4); r1 += __shfl_xor(r1, 2); r1 += __shfl_xor(r1, 1);
            if ((l & 7) == 0) *(LAS float*)(lds + L_DV + 4 * (8 * w + ((l >> 3) & 7))) = r1;
        }
        *(LAS u32x4*)(lds + L_K2T + (2 * l) * PK + 16 * w) = (u32x4){k2a[0], k2a[1], k2a[2], k2a[3]};
        *(LAS u32x4*)(lds + L_K2T + (2 * l + 1) * PK + 16 * w) = (u32x4){k2b[0], k2b[1], k2b[2], k2b[3]};
        *(LAS f32x2*)(lds + L_TOT + (w * 128 + 2 * l) * 4) = (f32x2){ks0, ks1};
        __syncthreads(); PSTAMP(2);
        if (tid < 128) { float s = *(const LAS float*)(lds + L_N + 4 * tid) * s_in;
#pragma unroll
            for (int w2 = 0; w2 < 8; ++w2) s += *(const LAS float*)(lds + L_TOT + (w2 * 128 + tid) * 4);
            *(LAS float*)(lds + L_N + 4 * tid) = s; }
        if (do_pf) ml_load<OUT>(p, pf, dir, b, h, nbase + 128, w, l);
        if (OUT) { pc_step<true>(lds, w, li, g, L_KT, L_QT); __syncthreads(); } PSTAMP(3);
        bf16x8 bv[2];
#pragma unroll
        for (int s = 0; s < 2; ++s) bv[s] = trB(lds, L_V + (32 * s + 8 * g + (li >> 2)) * PQ + (16 * w + 4 * (li & 3)) * 2);
#pragma unroll
        for (int t = 0; t < 8; ++t) S[t] = S[t] * s_in;
        if (OUT) {
#pragma unroll
            for (int t = 0; t < 8; ++t) { u32x2 pw; pw.x = pk2(S[t][0], S[t][1]); pw.y = pk2(S[t][2], S[t][3]); *(LAS u32x2*)(lds + L_ST + (16 * w + li) * PQ + (16 * t + 4 * g) * 2) = pw; }
            bf16x8 bs[4];
#pragma unroll
            for (int s = 0; s < 4; ++s) bs[s] = ld8(lds, L_ST + (16 * w + li) * PQ + (32 * s + 8 * g) * 2);
            o_tiles<true>(lds, bv, bs, w, li, g);
        }
        s_update(lds, S, bv, li, g);
        m_prev = b63 + G; btot += b63;
        __syncthreads(); PSTAMP(4);
        if (OUT) w_step(p, lds, tid, dir, b, nbase, 1, h);
        PSTAMP(5);
}
template <bool OUT>
__device__ __forceinline__ void ml_run(const Params& p, LAS unsigned char* lds, int dir, int b, int h, int n0, int nch, f32x4 (&S)[8], float& m_prev, float& btot, unsigned long long& tacc) {
    const int tid = tid_opaque(), w = __builtin_amdgcn_readfirstlane(tid >> 6), l = tid & 63, li = l & 15, g = l >> 4;
    MlIn A, B, C;
    ml_load<OUT>(p, A, dir, b, h, n0, w, l);
    if (nch > 1) ml_load<OUT>(p, B, dir, b, h, n0 + 64, w, l);
    for (int c = 0; c < nch; c += 3) {
        ml_chunk<OUT>(p, lds, dir, b, h, n0 + 64 * c, S, m_prev, btot, tacc, A, C, c + 2 < nch, tid, w, l, li, g);
        if (c + 1 < nch) ml_chunk<OUT>(p, lds, dir, b, h, n0 + 64 * (c + 1), S, m_prev, btot, tacc, B, A, c + 3 < nch, tid, w, l, li, g);
        if (c + 2 < nch) ml_chunk<OUT>(p, lds, dir, b, h, n0 + 64 * (c + 2), S, m_prev, btot, tacc, C, B, c + 4 < nch, tid, w, l, li, g);
    }
}

__device__ __forceinline__ void pass_a(const Params& p, LAS unsigned char* lds, int item) {
    const int tid = tid_opaque(), w = __builtin_amdgcn_readfirstlane(tid >> 6), l = tid & 63;
    const int chain = item >> 2, sa = item & 3, type = chain >> 5, dir = (chain >> 4) & 1, b = (chain >> 2) & 3, h = chain & 3;
    const int n0 = sa == 0 ? 0 : CTX + (sa - 1) * 2048, nch = sa == 0 ? 4 : 32;
    float* rec = (float*)(p.ws + WS_SEG + (size_t)item * SEG_STRIDE);
    f32x4 S[8];
#pragma unroll
    for (int t = 0; t < 8; ++t) S[t] = (f32x4){0.f, 0.f, 0.f, 0.f};
    if (type == 0) { float lt0 = 0.f, lt1 = 0.f; unsigned long long tacc = 0; hg_run<false>(p, lds, dir, b, h, n0, nch, S, lt0, lt1, tacc);
        save_tiles(rec, S, w, l); if (w == 0) *(f32x2*)(rec + 16384 + 2 * l) = (f32x2){lt0, lt1}; }
    else { float m_prev = -1.0e30f, btot = 0.f;
        if (tid < 128) *(LAS float*)(lds + L_N + 4 * tid) = 0.f;
        __syncthreads();
        unsigned long long tacc = 0; ml_run<false>(p, lds, dir, b, h, n0, nch, S, m_prev, btot, tacc);
        save_tiles(rec, S, w, l); if (tid < 128) rec[16384 + tid] = *(const LAS float*)(lds + L_N + 4 * tid);
        if (tid == 0) { rec[16384 + 128] = m_prev; rec[16384 + 129] = btot; } }
    __syncthreads();
}
__device__ __forceinline__ void pass_b(const Params& p, LAS unsigned char* lds, int item) {
    const int tid = tid_opaque(), w = __builtin_amdgcn_readfirstlane(tid >> 6), l = tid & 63, g = l >> 4;
    const int chain = item >> 2, k = item & 3, type = chain >> 5, dir = (chain >> 4) & 1, b = (chain >> 2) & 3, h = chain & 3;
    const int n0 = CTX + k * 2048;
    unsigned long long tacc = 0;
    for (int i = tid; i < 64 * PK / 4; i += NTHR) *(LAS unsigned*)(lds + L_P + 4 * i) = 0u;
    f32x4 S[8];
#pragma unroll
    for (int t = 0; t < 8; ++t) S[t] = (f32x4){0.f, 0.f, 0.f, 0.f};
    if (type == 0) {
        for (int j = 0; j <= k; ++j) { const float* rec = (const float*)(p.ws + WS_SEG + (size_t)(chain * 4 + j) * SEG_STRIDE);
#pragma unroll
            for (int t = 0; t < 8; ++t) { const f32x4 lt = *(const f32x4*)(rec + 16384 + 16 * t + 4 * g); const f32x4 u = *(const f32x4*)(rec + ((size_t)(w * 8 + t) * 64 + l) * 4);
                S[t][0] = S[t][0] * __expf(lt[0]) + u[0]; S[t][1] = S[t][1] * __expf(lt[1]) + u[1]; S[t][2] = S[t][2] * __expf(lt[2]) + u[2]; S[t][3] = S[t][3] * __expf(lt[3]) + u[3]; } }
        __syncthreads();
        float lt0 = 0.f, lt1 = 0.f; hg_run<true>(p, lds, dir, b, h, n0, 32, S, lt0, lt1, tacc);
    } else {
        float m_in = -1.0e30f, nacc = 0.f;
        for (int j = 0; j <= k; ++j) { const float* rec = (const float*)(p.ws + WS_SEG + (size_t)(chain * 4 + j) * SEG_STRIDE);
            const float m_loc = rec[16384 + 128], bj = rec[16384 + 129]; const float mn = fmaxf(bj + m_in, m_loc), sa_ = __expf(bj + m_in - mn), sb_ = __expf(m_loc - mn);
#pragma unroll
            for (int t = 0; t < 8; ++t) { const f32x4 u = *(const f32x4*)(rec + ((size_t)(w * 8 + t) * 64 + l) * 4); S[t] = S[t] * sa_ + u * sb_; }
            if (tid < 128) nacc = nacc * sa_ + rec[16384 + tid] * sb_;
            m_in = mn; }
        if (tid < 128) *(LAS float*)(lds + L_N + 4 * tid) = nacc;
        __syncthreads();
        float btot = 0.f; ml_run<true>(p, lds, dir, b, h, n0, 32, S, m_in, btot, tacc);
    }
    if (PROF != 0 && (int)blockIdx.x == PROF_BLOCK) { const unsigned long long st = __builtin_amdgcn_s_memrealtime(); while (__builtin_amdgcn_s_memrealtime() - st < tacc * 100ull) __builtin_amdgcn_s_sleep(8); }
    __syncthreads();
}
#undef SC_MFMA
#undef SC_SB
}

__device__ __forceinline__ void phase_mixprep(const Params& p) {
    unsigned char* ws = p.ws;
    const int tid = tid_opaque(), lane = tid & 63, wave = tid >> 6;
    const int gw = blockIdx.x * NWAVES + wave, NGW = gridDim.x * NWAVES;
    for (int xr = gw; xr < R_X; xr += NGW) {
        const int b = xr / SEQ, t = xr % SEQ; const size_t row = (size_t)b * SROW + CTX + t;
        const int tyh = lane >> 3;
        const size_t o2 = (((size_t)(tyh >> 2) * 16 + (b * 4 + (tyh & 3))) * SEQ + t) * 128 + (lane & 7) * 16;
        const bf16* of = (const bf16*)p.out + o2;
        const bf16* ob = (const bf16*)p.out + (size_t)2 * 16 * SEQ * 128 + o2;
        float v[16];
#pragma unroll
        for (int q = 0; q < 2; ++q) { const u32x4 a = *(const u32x4*)(of + q * 8), c = *(const u32x4*)(ob + q * 8);
            v[q * 8 + 0] = bflo(a.x) + bflo(c.x); v[q * 8 + 1] = bfhi(a.x) + bfhi(c.x); v[q * 8 + 2] = bflo(a.y) + bflo(c.y); v[q * 8 + 3] = bfhi(a.y) + bfhi(c.y);
            v[q * 8 + 4] = bflo(a.z) + bflo(c.z); v[q * 8 + 5] = bfhi(a.z) + bfhi(c.z); v[q * 8 + 6] = bflo(a.w) + bflo(c.w); v[q * 8 + 7] = bfhi(a.w) + bfhi(c.w); }
        float s = 0.f;
#pragma unroll
        for (int e = 0; e < 16; ++e) s += v[e];
        s += __shfl_xor(s, 1); s += __shfl_xor(s, 2); s += __shfl_xor(s, 4);
        const bool ml = lane >= 32;
        const float mean = ml ? s * (1.0f / 128.0f) : 0.f;
        float q2 = 0.f;
#pragma unroll
        for (int e = 0; e < 16; ++e) { v[e] -= mean; q2 += v[e] * v[e]; }
        q2 += __shfl_xor(q2, 1); q2 += __shfl_xor(q2, 2); q2 += __shfl_xor(q2, 4);
        const float rstd = rsqrtf(q2 * (1.0f / 128.0f) + EPS);
        const int c0 = (lane & 31) * 16;
        const float* nw = (ml ? p.ml_norm_w : p.hg_norm_w) + c0;
        const bf16* gt = (const bf16*)(ws + (ml ? WS_MO : WS_HG)) + row * 512 + c0;
        const u32x4 g0 = *(const u32x4*)gt, g1 = *(const u32x4*)(gt + 8);
        float g[16] = {bflo(g0.x), bfhi(g0.x), bflo(g0.y), bfhi(g0.y), bflo(g0.z), bfhi(g0.z), bflo(g0.w), bfhi(g0.w),
                       bflo(g1.x), bfhi(g1.x), bflo(g1.y), bfhi(g1.y), bflo(g1.z), bfhi(g1.z), bflo(g1.w), bfhi(g1.w)};
#pragma unroll
        for (int e = 0; e < 16; ++e) v[e] = v[e] * rstd * nw[e] * g[e];
        u32x4 o0, o1; o0.x = pk2(v[0], v[1]); o0.y = pk2(v[2], v[3]); o0.z = pk2(v[4], v[5]); o0.w = pk2(v[6], v[7]);
        o1.x = pk2(v[8], v[9]); o1.y = pk2(v[10], v[11]); o1.z = pk2(v[12], v[13]); o1.w = pk2(v[14], v[15]);
        bf16* am = (bf16*)(ws + WS_AMIX2) + (size_t)xr * 1024 + lane * 16;
        *(u32x4*)am = o0; *(u32x4*)(am + 8) = o1;
    }
}

__device__ __forceinline__ void phase_vx(const Params& p, LAS unsigned char* lds) {
    unsigned char* ws = p.ws;
    const int tid = tid_opaque(), lane = tid & 63, wave = tid >> 6;
    LAS float* Lrw = (LAS float*)lds;
    LAS float* Lnw = Lrw + 16 * 1024;
    LAS float* Lsh = Lnw + 1024;
    LAS float* Lsc = Lsh + 4096;
    const float* mod = (const float*)(ws + WS_MOD);
    for (int i = tid; i < 16 * 1024; i += NTHR) Lrw[i] = ((const float*)(ws + WS_RWT))[i];
    for (int i = tid; i < 1024; i += NTHR) Lnw[i] = p.norm2_w[i];
    for (int i = tid; i < 4096; i += NTHR) { const int b = i >> 10, c = i & 1023; Lsh[i] = mod[(size_t)b * 6144 + 3072 + c]; Lsc[i] = mod[(size_t)b * 6144 + 4096 + c]; }
    __syncthreads();
    const int gw = blockIdx.x * NWAVES + wave, NGW = gridDim.x * NWAVES;
    for (int xr = gw; xr < R_X; xr += NGW) {
        const int b = xr / SEQ, t = xr % SEQ;
        const float* src = p.out + (size_t)xr * D;
        f32x4 v[4]; float ss = 0.f;
#pragma unroll
        for (int j = 0; j < 4; ++j) { v[j] = *(const f32x4*)(src + j * 256 + lane * 4); ss += (v[j].x * v[j].x + v[j].y * v[j].y) + (v[j].z * v[j].z + v[j].w * v[j].w); }
        const float rstd = rsqrtf(wave_sum(ss) * (1.0f / D) + EPS);
        bf16* vrow = (bf16*)(ws + WS_VX) + (size_t)xr * D;
#pragma unroll
        for (int j = 0; j < 4; ++j) { const int c0 = j * 256 + lane * 4;
            const f32x4 nw = *(const LAS f32x4*)(Lnw + c0), sc = *(const LAS f32x4*)(Lsc + b * 1024 + c0), sh = *(const LAS f32x4*)(Lsh + b * 1024 + c0);
            v[j] = v[j] * rstd * nw * (1.0f + sc) + sh;
            u32x2 w; w.x = pk2(v[j].x, v[j].y); w.y = pk2(v[j].z, v[j].w); *(u32x2*)(vrow + c0) = w; }
        float pa[16];
#pragma unroll
        for (int g = 0; g < 16; ++g) { float a = 0.f;
#pragma unroll
            for (int j = 0; j < 4; ++j) { const f32x4 w = *(const LAS f32x4*)(Lrw + g * 1024 + j * 256 + lane * 4); a += (v[j].x * w.x + v[j].y * w.y) + (v[j].z * w.z + v[j].w * w.w); }
            pa[g] = a; if (g & 1) __builtin_amdgcn_sched_barrier(0); }
        const float mine = butterfly16(pa, lane);
        float mx = mine;
        mx = fmaxf(mx, __shfl_xor(mx, 4)); mx = fmaxf(mx, __shfl_xor(mx, 8)); mx = fmaxf(mx, __shfl_xor(mx, 16)); mx = fmaxf(mx, __shfl_xor(mx, 32));
        const float ex = __expf(mine - mx);
        float sm = ex; sm += __shfl_xor(sm, 4); sm += __shfl_xor(sm, 8); sm += __shfl_xor(sm, 16); sm += __shfl_xor(sm, 32);
        if ((lane & 3) == 0) ((float*)(ws + WS_AFF))[((size_t)b * 16 + (lane >> 2)) * SEQ + t] = ex / sm;
    }
}

__device__ __forceinline__ void phase_topk(const Params& p, LAS unsigned char* lds) {
    unsigned char* ws = p.ws;
    const int tid = tid_opaque(), lane = tid & 63, w = __builtin_amdgcn_readfirstlane(tid >> 6);
    LAS int* wc = (LAS int*)lds;
    for (int item = blockIdx.x; item < 256; item += gridDim.x) {
        const int be = item >> 2, qtr = item & 3, b = be >> 4, e = be & 15;
        const float* aff = (const float*)(ws + WS_AFF) + (size_t)be * SEQ + tid * 16;
        unsigned u[16];
#pragma unroll
        for (int q = 0; q < 4; ++q) { const f32x4 v = *(const f32x4*)(aff + 4 * q); u[4 * q] = __float_as_uint(v.x); u[4 * q + 1] = __float_as_uint(v.y); u[4 * q + 2] = __float_as_uint(v.z); u[4 * q + 3] = __float_as_uint(v.w); }
        unsigned T = 0u; int par = 0;
        for (int bit = 30; bit >= -1; --bit) {
            const unsigned cand = (bit >= 0) ? (T | (1u << bit)) : (T + 1u);
            int c = 0;
#pragma unroll
            for (int i = 0; i < 16; ++i) c += (int)__popcll(__ballot(u[i] >= cand));
            if (lane == 0) wc[par * 8 + w] = c;
            __syncthreads();
            int tot = 0;
#pragma unroll
            for (int w2 = 0; w2 < 8; ++w2) tot += wc[par * 8 + w2];
            if (bit >= 0) { if (tot >= CAP) T = cand; } else wc[32] = tot;
            par ^= 1;
        }
        int ngt = 0, neq = 0;
#pragma unroll
        for (int i = 0; i < 16; ++i) { ngt += (u[i] > T) ? 1 : 0; neq += (u[i] == T) ? 1 : 0; }
        int pk = (ngt << 16) | neq, inc = pk;
#pragma unroll
        for (int o = 1; o < 64; o <<= 1) { const int t = __shfl_up(inc, o); if (lane >= o) inc += t; }
        if (lane == 63) wc[16 + w] = inc;
        __syncthreads();
        const int cgt = wc[32];
        int base = inc - pk;
#pragma unroll
        for (int w2 = 0; w2 < 8; ++w2) if (w2 < w) base += wc[16 + w2];
        int gtb = base >> 16, eqb = base & 0xffff; const int need_eq = CAP - cgt;
        if ((tid >> 7) == qtr) {
            int sl[16];
#pragma unroll
            for (int i = 0; i < 16; ++i) { int s_ = -1;
                if (u[i] > T) { s_ = gtb; ++gtb; } else if (u[i] == T) { if (eqb < need_eq) s_ = cgt + eqb; ++eqb; }
                sl[i] = s_;
                if (s_ >= 0) { const int mrow = (e * NB + b) * CAP + s_; ((int*)(ws + WS_ROWMAP))[mrow] = b * SEQ + tid * 16 + i; ((float*)(ws + WS_GATEV))[mrow] = __uint_as_float(u[i]); } }
            int* so = (int*)(ws + WS_SLOT) + (size_t)be * SEQ + tid * 16;
#pragma unroll
            for (int q = 0; q < 4; ++q) *(int4*)(so + 4 * q) = make_int4(sl[4 * q], sl[4 * q + 1], sl[4 * q + 2], sl[4 * q + 3]);
        }
        __syncthreads();
    }
}

__device__ __forceinline__ void phase_final(const Params& p) {
    unsigned char* ws = p.ws;
    const int tid = tid_opaque(), lane = tid & 63, wave = tid >> 6;
    const int gw = blockIdx.x * NWAVES + wave, NGW = gridDim.x * NWAVES;
    const float* mod = (const float*)(ws + WS_MOD);
    for (int blk = gw; blk < R_X / 16; blk += NGW) {
        const int xr0 = blk * 16, b = xr0 / SEQ, t0 = xr0 % SEQ;
        const int4 sl4 = *(const int4*)((const int*)(ws + WS_SLOT) + ((size_t)b * 16 + (lane & 15)) * SEQ + t0 + 4 * (lane >> 4));
#pragma unroll 1
        for (int rq = 0; rq < 4; ++rq)
#pragma unroll 1
            for (int rr = 0; rr < 4; ++rr) {
                const int xr = xr0 + rq * 4 + rr; const int myv = (rr == 0) ? sl4.x : (rr == 1) ? sl4.y : (rr == 2) ? sl4.z : sl4.w;
                float* row = p.out + (size_t)xr * D;
                f32x4 acc[4];
#pragma unroll
                for (int j = 0; j < 4; ++j) acc[j] = (f32x4){0.f, 0.f, 0.f, 0.f};
                for (int e = 0; e < 16; ++e) { const int sl = __shfl(myv, e + 16 * rq); if (sl < 0) continue;
                    const bf16* y = (const bf16*)(ws + WS_Y) + ((size_t)(e * NB + b) * CAP + sl) * D;
#pragma unroll
                    for (int j = 0; j < 4; ++j) { const u32x2 wv = *(const u32x2*)(y + j * 256 + lane * 4); acc[j].x += bflo(wv.x); acc[j].y += bfhi(wv.x); acc[j].z += bflo(wv.y); acc[j].w += bfhi(wv.y); } }
                f32x4 v[4]; float ss = 0.f;
#pragma unroll
                for (int j = 0; j < 4; ++j) { const int c0 = j * 256 + lane * 4; const f32x4 g2 = *(const f32x4*)(mod + (size_t)b * 6144 + 5120 + c0);
                    v[j] = *(const f32x4*)(row + c0) + g2 * acc[j]; ss += (v[j].x * v[j].x + v[j].y * v[j].y) + (v[j].z * v[j].z + v[j].w * v[j].w); }
                const float rstd = rsqrtf(wave_sum(ss) * (1.0f / D) + EPS);
#pragma unroll
                for (int j = 0; j < 4; ++j) { const int c0 = j * 256 + lane * 4; const f32x4 fw = *(const f32x4*)(p.final_w + c0); *(f32x4*)(row + c0) = v[j] * rstd * fw; }
            }
    }
}

#define XB_TMO      128
#define XB_XCNT(j)  (256  + 64 * (j))
#define XB_XSUB(j)  (1280 + 64 * (j))
#define XB_XGEN(j)  (2304 + 64 * (j))
#define XB_TOP      3328
#define XB_TOPGEN   3392
#define XCD_BAR_WORDS 3456
#define XB_SPIN_CAP (1u << 20)
__device__ __forceinline__ unsigned xb_ld(unsigned* p)              { return __hip_atomic_load(p, __ATOMIC_RELAXED, __HIP_MEMORY_SCOPE_AGENT); }
__device__ __forceinline__ unsigned xb_add(unsigned* p, unsigned v) { return __hip_atomic_fetch_add(p, v, __ATOMIC_RELAXED, __HIP_MEMORY_SCOPE_AGENT); }
__device__ __forceinline__ unsigned xb_xcc_id() { return (unsigned)__builtin_amdgcn_s_getreg((3 << 11) | 20) & 0xFu; }
#define XB_SPIN(cond, bar) do { unsigned _sp = 0; while (cond) { __builtin_amdgcn_s_sleep(1); \
    if ((++_sp & 255u) == 0u) { if (xb_ld(&(bar)[XB_TMO])) break; if (_sp > XB_SPIN_CAP) { atomicAdd(&(bar)[XB_TMO], 1u); break; } } } } while (0)
struct XcdBarrier { unsigned* bar; unsigned x; volatile LAS unsigned* st; };
__device__ __forceinline__ XcdBarrier xcd_barrier_post(unsigned* bar, volatile LAS unsigned* st) {
    XcdBarrier b; b.bar = bar; b.x = xb_xcc_id(); b.st = st;
    if (threadIdx.x == 0) (void)xb_add(&bar[XB_XCNT(b.x)], 1u);
    return b;
}
__device__ __forceinline__ void xcd_barrier_complete(unsigned* bar, unsigned x, unsigned& nloc, unsigned& nx) {
    const unsigned G = gridDim.x * gridDim.y * gridDim.z;
    unsigned sum, cnt, mine, sp = 0u;
    for (;;) {
        sum = 0u; cnt = 0u; mine = 0u;
#pragma unroll
        for (unsigned j = 0; j < 16; ++j) { const unsigned c = xb_ld(&bar[XB_XCNT(j)]); sum += c; cnt += (c > 0u) ? 1u : 0u; mine = (j == x) ? c : mine; }
        if (sum == G) break;
        __builtin_amdgcn_s_sleep(1);
        if ((++sp & 255u) == 0u) { if (xb_ld(&bar[XB_TMO])) break; if (sp > XB_SPIN_CAP) { atomicAdd(&bar[XB_TMO], 1u); break; } }
    }
    nloc = mine > 0u ? mine : 1u; nx = cnt > 0u ? cnt : 1u;
}
__device__ __forceinline__ void xcd_barrier(const XcdBarrier& b) {
    asm volatile("s_waitcnt vmcnt(0)" ::: "memory");
    __syncthreads();
    if (threadIdx.x == 0) {
        unsigned* bar = b.bar;
        __builtin_amdgcn_s_waitcnt(0);
        unsigned nloc = b.st[0], nx = b.st[1];
        if (nloc == 0u) { xcd_barrier_complete(bar, b.x, nloc, nx); b.st[0] = nloc; b.st[1] = nx; }
        const unsigned old = xb_add(&bar[XB_XSUB(b.x)], 1u);
        const unsigned gen = old / nloc;
        if (old + 1u == (gen + 1u) * nloc) {
            __builtin_amdgcn_fence(__ATOMIC_RELEASE, "agent");
            asm volatile("s_waitcnt vmcnt(0)" ::: "memory");
            const unsigned og = xb_add(&bar[XB_TOP], 1u);
            const unsigned tg = og / nx;
            if (og + 1u == (tg + 1u) * nx) xb_add(&bar[XB_TOPGEN], 1u);
            else XB_SPIN(xb_ld(&bar[XB_TOPGEN]) == tg, bar);
            __builtin_amdgcn_fence(__ATOMIC_ACQUIRE, "agent");
            xb_add(&bar[XB_XGEN(b.x)], 1u);
            asm volatile("s_waitcnt vmcnt(0)" ::: "memory");
        } else {
            XB_SPIN(xb_ld(&bar[XB_XGEN(b.x)]) == gen, bar);
            __builtin_amdgcn_fence(__ATOMIC_ACQUIRE, "agent");
            asm volatile("s_waitcnt vmcnt(0)" ::: "memory");
        }
    }
    __syncthreads();
}

constexpr int MISC_OFF = LDS_BYTES - 256;
constexpr int CW_BAR = 4096;
constexpr size_t CTL_ZERO_BYTES = 65536;
constexpr unsigned REPEAT_MASK = 0x0u;
constexpr int PB_FILTER = 0;

__global__ void __launch_bounds__(NTHR, 2) mega_fwd(Params p) {
    extern __shared__ __attribute__((aligned(16))) unsigned char lds_raw[];
    LAS unsigned char* lds = (LAS unsigned char*)lds_raw;
    for (int u = threadIdx.x; u < 64; u += NTHR) ((LAS unsigned*)(lds + MISC_OFF))[u] = 0u;
    __syncthreads();
    XcdBarrier bar = xcd_barrier_post((unsigned*)(p.ws + WS_CTL) + CW_BAR, (volatile LAS unsigned*)(lds + MISC_OFF) + 8);
#define GRID_BAR() xcd_barrier(bar)
#define PHASE(k, ...) for (int rep_ = 0; rep_ <= (int)((REPEAT_MASK >> (k)) & 1u); ++rep_) { __VA_ARGS__; GRID_BAR(); }
    PHASE(0, phase_prologue(p, lds))
    PHASE(1, phase_u(p, lds))
    PHASE(2, { pg8::Gemm g{(const bf16*)(p.ws + WS_U), (const bf16*)(p.ws + WS_WIN_T), D, nullptr}; pg8::StaticOrder S; S.init(R_ALL, NPROJ, gridDim.x, blockIdx.x);
        pg8::EpiInProj E{p.ws, (const float*)(p.ws + WS_LB)};
        pg8::gemm_phase<pg8::EpiInProj, pg8::StaticOrder, true, false>(lds, g, S, E); })
    PHASE(3, phase_conv(p))
    PHASE(4, for (int item = blockIdx.x; item < 256; item += gridDim.x) { if (rep_ == 1 && PB_FILTER != 0 && ((item >> 7) + 1) != PB_FILTER) continue; sc::pass_a(p, lds, item); })
    PHASE(5, for (int item = blockIdx.x; item < 256; item += gridDim.x) { if (rep_ == 1 && PB_FILTER != 0 && ((item >> 7) + 1) != PB_FILTER) continue; sc::pass_b(p, lds, item); })
    PHASE(6, phase_mixprep(p))
    PHASE(7, { pg8::Gemm g{(const bf16*)(p.ws + WS_AMIX2), (const bf16*)(p.ws + WS_WOUT_T), D, nullptr}; pg8::StaticOrder S; S.init(R_X, D, gridDim.x, blockIdx.x);
        pg8::EpiOutProj E{p.x, p.out, (const float*)(p.ws + WS_MOD)};
        pg8::gemm_phase<pg8::EpiOutProj, pg8::StaticOrder, true, false>(lds, g, S, E); })
    PHASE(8, phase_vx(p, lds))
    PHASE(9, phase_topk(p, lds))
    PHASE(10, for (int w = blockIdx.x; w < 256; w += gridDim.x) {
        const int xcd = w & 7, idx = w >> 3, e = xcd * 2 + (idx >> 4), pm = e * 16 + (idx & 15);
        {   pg8::Gemm g{(const bf16*)(p.ws + WS_VX), (const bf16*)(p.ws + WS_WGU_T), D, (const int*)(p.ws + WS_ROWMAP)};
            pg8::PanelOrder S{pm, 8, (size_t)e * 2048 * 1024 * 2}; pg8::EpiMoE1 E{(bf16*)(p.ws + WS_H)};
            pg8::gemm_phase<pg8::EpiMoE1, pg8::PanelOrder, true, true>(lds, g, S, E); }
        VM_WAIT(); __syncthreads();
        if (threadIdx.x == 0) { __builtin_amdgcn_fence(__ATOMIC_ACQUIRE, "agent"); VM_WAIT(); }
        __syncthreads();
        {   pg8::Gemm g{(const bf16*)(p.ws + WS_H), (const bf16*)(p.ws + WS_WD_T), FF, nullptr};
            pg8::PanelOrder S{pm, 4, (size_t)e * 1024 * 1024 * 2}; pg8::EpiMoE2 E{(bf16*)(p.ws + WS_Y), (const float*)(p.ws + WS_GATEV)};
            pg8::gemm_phase<pg8::EpiMoE2, pg8::PanelOrder, true, false>(lds, g, S, E); }
    })
    phase_final(p);
}

extern "C" void kernel_launch(void* const* d_in, const int* in_sizes, int n_in, void* d_out, int out_size, void* d_ws, size_t ws_size, hipStream_t stream) {
    static int grid = 0;
    if (grid == 0) {
        if (n_in != 21 || out_size != R_X * D || ws_size < WS_END) { fprintf(stderr, "kernel_launch: unexpected shapes: n_in %d out %d ws %zu\n", n_in, out_size, ws_size); grid = -1; return; }
        int dev = 0, cus = 0, per_cu = 0;
        if (hipGetDevice(&dev) != hipSuccess || hipDeviceGetAttribute(&cus, hipDeviceAttributeMultiprocessorCount, dev) != hipSuccess) { grid = -1; return; }
        if (hipFuncSetAttribute((const void*)mega_fwd, hipFuncAttributeMaxDynamicSharedMemorySize, LDS_BYTES) != hipSuccess) { fprintf(stderr, "kernel_launch: hipFuncSetAttribute failed\n"); grid = -1; return; }
        if (hipOccupancyMaxActiveBlocksPerMultiprocessor(&per_cu, (const void*)mega_fwd, NTHR, LDS_BYTES) != hipSuccess || per_cu < 1) { fprintf(stderr, "kernel_launch: occupancy query says %d blocks/CU; nothing launched\n", per_cu); (void)hipGetLastError(); grid = -1; return; }
        grid = cus;
    }
    if (grid < 0) return;
    (void)hipMemsetAsync((char*)d_ws + WS_CTL, 0, CTL_ZERO_BYTES, stream);
    Params p{};
    const float** pp = (const float**)&p;
    for (int i = 0; i < 21; ++i) pp[i] = (const float*)d_in[i];
    p.out = (float*)d_out; p.ws = (unsigned char*)d_ws;
    hipLaunchKernelGGL(mega_fwd, dim3(grid), dim3(NTHR), LDS_BYTES, stream, p);
}
```

```cpp
#include <hip/hip_runtime.h>
#include <cstdio>
#include <cstdint>

#define GAS __attribute__((address_space(1)))
#define LAS __attribute__((address_space(3)))
typedef unsigned short bf16;
typedef float f32x4 __attribute__((ext_vector_type(4)));
typedef float f32x2 __attribute__((ext_vector_type(2)));
typedef unsigned u32x4 __attribute__((ext_vector_type(4)));
typedef unsigned u32x2 __attribute__((ext_vector_type(2)));
typedef short bf16x8 __attribute__((ext_vector_type(8)));
typedef __bf16 bf16x2_t __attribute__((ext_vector_type(2)));
typedef _Float16 f16x2_t __attribute__((ext_vector_type(2)));

constexpr int D = 1024, NB = 4, SEQ = 8192, CTX = 256, SROW = SEQ + CTX, R_ALL = NB * SROW, R_X = NB * SEQ;
constexpr int PROJ = 4624, NPROJ = 4608;
constexpr int NE = 16, CAP = 1024, FF = 1024, R_MOE = NE * NB * CAP;
constexpr float EPS = 1e-6f;
constexpr int NTHR = 512, NWAVES = 8;
constexpr int LDS_BYTES = 155648;
constexpr int PROF = 0, PROF_BLOCK = 0;

constexpr size_t MiB = 1u << 20;
constexpr size_t WS_CTL = 0;
constexpr size_t WS_MODP = 1 * MiB;
constexpr size_t WS_MOD = 3 * MiB;
constexpr size_t WS_LB = WS_MOD + 128 * 1024;
constexpr size_t WS_WGT = WS_LB + 4096;
constexpr size_t WS_RWT = WS_WGT + 65536;
constexpr size_t WS_WIN_T = 4 * MiB;
constexpr size_t WS_WOUT_T = 13 * MiB;
constexpr size_t WS_GATES = 15 * MiB;
constexpr size_t WS_WGU_T = 18 * MiB;
constexpr size_t WS_WD_T = 82 * MiB;
constexpr size_t WS_U = 114 * MiB;
constexpr size_t WS_HQ = 180 * MiB;
constexpr size_t WS_HV = 213 * MiB;
constexpr size_t WS_HG = 246 * MiB;
constexpr size_t WS_LF = 279 * MiB;
constexpr size_t WS_QK = 345 * MiB;
constexpr size_t WS_MV = 411 * MiB;
constexpr size_t WS_MO = 444 * MiB;
constexpr size_t WS_AFF = 477 * MiB;
constexpr size_t WS_ROWMAP = 479 * MiB;
constexpr size_t WS_GATEV = WS_ROWMAP + 262144;
constexpr size_t WS_SLOT = 480 * MiB;
constexpr size_t WS_SEG = 484 * MiB;
constexpr size_t WS_SCB = 502 * MiB;
constexpr size_t WS_SCG = 504 * MiB;
constexpr size_t WS_SCM = 506 * MiB;
constexpr size_t WS_END = 512 * MiB;
constexpr size_t WS_QKC = WS_U;
constexpr size_t WS_AMIX2 = WS_LF;
constexpr size_t WS_VX = WS_U;
constexpr size_t WS_H = WS_HQ;
constexpr size_t WS_Y = 308 * MiB;

struct Params {
    const float *x, *c, *ctx, *c_ctx, *ada_w, *ada_b, *norm1_w, *w_in, *conv_w, *conv_b, *lb_logits, *ml_gate_b, *hg_norm_w, *ml_norm_w, *w_out, *norm2_w,
        *router_w, *wg, *wu, *wd, *final_w;
    float* out; unsigned char* ws;
};

__device__ __forceinline__ unsigned pk2(float lo, float hi) { f32x2 v = {lo, hi}; bf16x2_t b = __builtin_convertvector(v, bf16x2_t); return __builtin_bit_cast(unsigned, b); }
__device__ __forceinline__ unsigned pkh2(float lo, float hi) { f32x2 v = {lo, hi}; f16x2_t b = __builtin_convertvector(v, f16x2_t); return __builtin_bit_cast(unsigned, b); }
__device__ __forceinline__ float bf2f(unsigned short b) { return __uint_as_float((unsigned)b << 16); }
__device__ __forceinline__ float bflo(unsigned w) { return __uint_as_float(w << 16); }
__device__ __forceinline__ float bfhi(unsigned w) { return __uint_as_float(w & 0xffff0000u); }
__device__ __forceinline__ float h2f(unsigned short h) { return (float)__builtin_bit_cast(_Float16, h); }
__device__ __forceinline__ float sigmoid_(float x) { return __builtin_amdgcn_rcpf(1.0f + __expf(-x)); }
__device__ __forceinline__ float silu_(float x) { return x * sigmoid_(x); }
__device__ __forceinline__ float wave_sum(float v) {
#pragma unroll
    for (int o = 1; o < 64; o <<= 1) v += __shfl_xor(v, o);
    return v;
}
__device__ __forceinline__ int tid_opaque() { int t = threadIdx.x; asm volatile("" : "+v"(t)); return t; }
__device__ __forceinline__ float butterfly16(const float (&a)[16], int lane) {
    const bool h5 = (lane & 32) != 0, h4 = (lane & 16) != 0, h3 = (lane & 8) != 0, h2 = (lane & 4) != 0;
    float b8[8], b4[4], b2[2];
#pragma unroll
    for (int e = 0; e < 8; ++e) { const float keep = h5 ? a[e + 8] : a[e], send = h5 ? a[e] : a[e + 8]; b8[e] = keep + __shfl_xor(send, 32); }
#pragma unroll
    for (int e = 0; e < 4; ++e) { const float keep = h4 ? b8[e + 4] : b8[e], send = h4 ? b8[e] : b8[e + 4]; b4[e] = keep + __shfl_xor(send, 16); }
#pragma unroll
    for (int e = 0; e < 2; ++e) { const float keep = h3 ? b4[e + 2] : b4[e], send = h3 ? b4[e] : b4[e + 2]; b2[e] = keep + __shfl_xor(send, 8); }
    const float keep = h2 ? b2[1] : b2[0], send = h2 ? b2[0] : b2[1];
    float r = keep + __shfl_xor(send, 4);
    r += __shfl_xor(r, 2); r += __shfl_xor(r, 1);
    return r;
}
#define LDS_WAIT() asm volatile("s_waitcnt lgkmcnt(0)" ::: "memory")
#define VM_WAIT() asm volatile("s_waitcnt vmcnt(0)" ::: "memory")

namespace pg8 {
constexpr int BM = 256, BK = 64, HALF = 128, HTB = HALF * BK * 2, STAGE_BYTES = 8 * HTB, NXCD = 8, WGM = 8;
__host__ __device__ __forceinline__ int lds_byte(int r, int c) { const int st = (r >> 4) * 2 + (c >> 5), rr = r & 15, cc = c & 31, ob = rr * 64 + cc * 2; return st * 1024 + (ob ^ (((ob >> 9) & 1) << 5)); }
__host__ __device__ __forceinline__ void stage_rc(int b, int& R, int& C) { const int st = b / 1024, sb = b % 1024, swz = sb ^ (((sb >> 9) & 1) << 5); R = (st >> 1) * 16 + swz / 64; C = (st & 1) * 32 + (swz % 64) / 2; }
__host__ __device__ __forceinline__ int perm32(int rho) { const int n = rho >> 4, i = rho & 15; return 8 * (i >> 2) + 4 * n + (i & 3); }

struct Unit { int pm, pn; size_t boff; };
struct Gemm { const bf16* A; const bf16* Bt; int K; const int* rowmap; };

struct StaticOrder {
    int nM, nN, nwg, G, c;
    __device__ void init(int M, int N, int G_, int c_) { nM = M / BM; nN = N / BM; nwg = nM * nN; G = G_; c = c_; }
    __device__ bool next(int i, Unit& u) const {
        const long L = (long)i * G + c; if (L >= nwg) return false;
        int wgid = (int)L; { const int q = nwg / NXCD, r = nwg % NXCD, xcd = wgid % NXCD, off = wgid / NXCD; wgid = (xcd < r ? xcd * (q + 1) : r * (q + 1) + (xcd - r) * q) + off; }
        const int nig = WGM * nN, gid = wgid / nig, fm = gid * WGM, gsz = (nM - fm) < WGM ? (nM - fm) : WGM;
        u.pm = fm + ((wgid % nig) % gsz); u.pn = (wgid % nig) / gsz; u.boff = 0; return true;
    }
};
struct PanelOrder {
    int pm, npn; size_t boff;
    __device__ bool next(int i, Unit& u) const { if (i >= npn) return false; u.pm = pm; u.pn = i; u.boff = boff; return true; }
};

template <class Epi, class Sched, bool ALIGN_EPI, bool GATHER>
__device__ __forceinline__ void gemm_phase(LAS unsigned char* lds, const Gemm g, const Sched& S, const Epi& E) {
    const int tid = tid_opaque(), wid = __builtin_amdgcn_readfirstlane(tid >> 6), lane = tid & 63, wr = wid >> 2, wc = wid & 3, fr = lane & 15, fq = lane >> 4;
    const int K = g.K, nt = K / BK;
    Unit cur, nxt; int ui = 0;
    if (!S.next(0, cur)) return;
    const size_t kstep = (size_t)(BK * 2);
    const size_t hstep = (size_t)HALF * K * 2;
    const size_t tstep = 2 * hstep;
    unsigned voffA[2][2], voffB[2];
#pragma unroll
    for (int i = 0; i < 2; ++i) { int R, C; stage_rc(tid * 16 + i * 8192, R, C); const int Rb = Epi::PERM ? ((R & ~31) + perm32(R & 31)) : R;
        voffB[i] = (unsigned)(Rb * K + C) * 2u;
#pragma unroll
        for (int h = 0; h < 2; ++h) {
            if (GATHER) voffA[h][i] = (unsigned)g.rowmap[cur.pm * BM + h * HALF + R] * (unsigned)(K * 2) + (unsigned)C * 2u;
            else voffA[h][i] = (unsigned)(R * K + C) * 2u + (unsigned)(h * hstep);
        } }
    const unsigned ldsw = (unsigned)wid * 1024u;
    const int aoff = lds_byte(wr * 64 + fr, fq * 8), boff = lds_byte(wc * 32 + fr, fq * 8);
#define PG8_SA(b, h) (((b) * 2 + (h)) * HTB)
#define PG8_SB(b, h) ((4 + (b) * 2 + (h)) * HTB)
#define PG8_STAGE_A(bufoff, gbase, h) do { _Pragma("unroll") for (int _i = 0; _i < 2; ++_i) \
        __builtin_amdgcn_global_load_lds((const unsigned*)((const char*)(gbase) + voffA[h][_i]), (LAS unsigned*)(lds + (bufoff) + ldsw + _i * 8192), 16, 0, 0); } while (0)
#define PG8_STAGE_B(bufoff, gbase) do { _Pragma("unroll") for (int _i = 0; _i < 2; ++_i) \
        __builtin_amdgcn_global_load_lds((const unsigned*)((const char*)(gbase) + voffB[_i]), (LAS unsigned*)(lds + (bufoff) + ldsw + _i * 8192), 16, 0, 0); } while (0)
#define PG8_LDA(dst, b, h) do { _Pragma("unroll") for (int m = 0; m < 4; ++m) _Pragma("unroll") for (int k = 0; k < 2; ++k) dst[m][k] = *(const LAS bf16x8*)(lds + PG8_SA(b, h) + aoff + m * 2048 + k * 1024); } while (0)
#define PG8_LDB(dst, b, h) do { _Pragma("unroll") for (int n = 0; n < 2; ++n) _Pragma("unroll") for (int k = 0; k < 2; ++k) dst[n][k] = *(const LAS bf16x8*)(lds + PG8_SB(b, h) + boff + n * 2048 + k * 1024); } while (0)
#define PG8_MMA(ai, bj, At, Bt) do { __builtin_amdgcn_s_setprio(1); _Pragma("unroll") for (int m = 0; m < 4; ++m) _Pragma("unroll") for (int n = 0; n < 2; ++n) _Pragma("unroll") for (int k = 0; k < 2; ++k) \
        acc[ai][bj][m][n] = __builtin_amdgcn_mfma_f32_16x16x32_bf16(Bt[n][k], At[m][k], acc[ai][bj][m][n], 0, 0, 0); __builtin_amdgcn_s_setprio(0); } while (0)
#define PG8_WAIT_V(n) asm volatile("s_waitcnt vmcnt(" #n ")" ::: "memory")
#define PG8_WAIT_L(n) asm volatile("s_waitcnt lgkmcnt(" #n ")" ::: "memory")
#define PG8_BAR __builtin_amdgcn_s_barrier()
#define PG8_SCHED __builtin_amdgcn_sched_barrier(0)
    f32x4 acc[2][2][4][2];
#pragma unroll
    for (int a = 0; a < 2; ++a)
#pragma unroll
        for (int b = 0; b < 2; ++b)
#pragma unroll
            for (int m = 0; m < 4; ++m)
#pragma unroll
                for (int n = 0; n < 2; ++n) acc[a][b][m][n] = (f32x4){0.f, 0.f, 0.f, 0.f};
    bf16x8 At[4][2], B0[2][2], B1[2][2];
    const char* cA = GATHER ? (const char*)g.A : (const char*)g.A + (size_t)cur.pm * tstep;
    const char* cB = (const char*)g.Bt + cur.boff + (size_t)cur.pn * tstep;
    if (GATHER) VM_WAIT();
    PG8_STAGE_B(PG8_SB(0, 0), cB); PG8_STAGE_B(PG8_SB(0, 1), cB + hstep); PG8_STAGE_A(PG8_SA(0, 0), cA, 0); PG8_STAGE_A(PG8_SA(0, 1), cA, 1);
    if (wr == 1) PG8_BAR;
    PG8_WAIT_V(2); PG8_BAR;
    PG8_STAGE_B(PG8_SB(1, 0), cB + kstep); PG8_STAGE_A(PG8_SA(1, 0), cA + kstep, 0); PG8_STAGE_B(PG8_SB(1, 1), cB + hstep + kstep);
    PG8_WAIT_V(6); PG8_BAR;
    for (;;) {
        const bool has_next = S.next(ui + 1, nxt);
        const char* nA = has_next ? (GATHER ? (const char*)g.A : (const char*)g.A + (size_t)nxt.pm * tstep) : cA;
        const char* nB = has_next ? (const char*)g.Bt + nxt.boff + (size_t)nxt.pn * tstep : cB;
        for (int t = 0; t < nt; t += 2) {
            const bool last = (t == nt - 2);
            const char* a1 = cA + (size_t)(t + 1) * kstep;
            const char* a2 = last ? nA : cA + (size_t)(t + 2) * kstep; const char* b2 = last ? nB : cB + (size_t)(t + 2) * kstep;
            const char* a3 = a2 + kstep; const char* b3 = b2 + kstep;
            PG8_LDB(B0, 0, 0); PG8_LDB(B1, 0, 1); PG8_SCHED; PG8_LDA(At, 0, 0); PG8_STAGE_A(PG8_SA(1, 1), a1, 1);
            PG8_WAIT_V(8); PG8_WAIT_L(0); PG8_BAR; PG8_MMA(0, 0, At, B0); PG8_MMA(0, 1, At, B1); PG8_BAR; PG8_SCHED;
            PG8_LDA(At, 0, 1); PG8_STAGE_B(PG8_SB(0, 0), b2); PG8_STAGE_B(PG8_SB(0, 1), b2 + hstep); PG8_STAGE_A(PG8_SA(0, 0), a2, 0);
            PG8_WAIT_V(8); PG8_WAIT_L(0); PG8_BAR; PG8_MMA(1, 0, At, B0); PG8_MMA(1, 1, At, B1); PG8_BAR; PG8_SCHED;
            PG8_LDB(B0, 1, 0); PG8_LDB(B1, 1, 1); PG8_SCHED; PG8_LDA(At, 1, 0); PG8_STAGE_A(PG8_SA(0, 1), a2, 1);
            PG8_WAIT_V(8); PG8_WAIT_L(0); PG8_BAR; PG8_MMA(0, 0, At, B0); PG8_MMA(0, 1, At, B1); PG8_BAR; PG8_SCHED;
            PG8_LDA(At, 1, 1); PG8_STAGE_B(PG8_SB(1, 0), b3); PG8_STAGE_B(PG8_SB(1, 1), b3 + hstep); PG8_STAGE_A(PG8_SA(1, 0), a3, 0);
            PG8_WAIT_V(8); PG8_WAIT_L(0); PG8_BAR; PG8_MMA(1, 0, At, B0); PG8_MMA(1, 1, At, B1); PG8_BAR; PG8_SCHED;
        }
        if constexpr (ALIGN_EPI) { if (wr == 0) PG8_BAR; }
        E(acc, cur, wr, wc, fr, fq);
        if (!has_next) break;
#pragma unroll
        for (int a = 0; a < 2; ++a)
#pragma unroll
            for (int b = 0; b < 2; ++b)
#pragma unroll
                for (int m = 0; m < 4; ++m)
#pragma unroll
                    for (int n = 0; n < 2; ++n) acc[a][b][m][n] = (f32x4){0.f, 0.f, 0.f, 0.f};
        cur = nxt; cA = nA; cB = nB; ++ui;
        if constexpr (ALIGN_EPI) { if (wr == 1) PG8_BAR; }
    }
    PG8_WAIT_V(0);
    if constexpr (!ALIGN_EPI) { if (wr == 0) PG8_BAR; }
    PG8_BAR;
#undef PG8_SA
#undef PG8_SB
#undef PG8_STAGE_A
#undef PG8_STAGE_B
#undef PG8_LDA
#undef PG8_LDB
#undef PG8_MMA
#undef PG8_WAIT_V
#undef PG8_WAIT_L
#undef PG8_BAR
#undef PG8_SCHED
}

struct EpiInProj {
    static constexpr bool PERM = true;
    unsigned char* ws; const float* lb;
    __device__ __forceinline__ void operator()(const f32x4 (&acc)[2][2][4][2], const Unit& u, int wr, int wc, int fr_, int fq) const {
        int fr = fr_; asm volatile("" : "+v"(fr));
        const int pn = u.pn; size_t base; int ld, colbase, act, hm;
        if (pn < 2) { base = WS_HQ; ld = 512; colbase = pn * 256; act = 1; hm = 1; }
        else if (pn < 4) { base = WS_HV; ld = 512; colbase = (pn - 2) * 256; act = 0; hm = 1; }
        else if (pn < 6) { base = WS_HG; ld = 512; colbase = (pn - 4) * 256; act = 1; hm = 0; }
        else if (pn < 10) { base = WS_LF; ld = 1024; colbase = (pn - 6) * 256; act = 3; hm = 2; }
        else if (pn < 14) { base = WS_QK; ld = 1024; colbase = (pn - 10) * 256; act = 0; hm = 0; }
        else if (pn < 16) { base = WS_MV; ld = 512; colbase = (pn - 14) * 256; act = 0; hm = 1; }
        else { base = WS_MO; ld = 512; colbase = (pn - 16) * 256; act = 2; hm = 0; }
        bf16* O = (bf16*)(ws + base);
        const int bb = u.pm / 33, s0 = (u.pm % 33) * BM + wr * 64 + fr;
        const int row0 = u.pm * BM + wr * 64 + fr, col0 = colbase + wc * 32 + 8 * fq;
#pragma unroll
        for (int bj = 0; bj < 2; ++bj) {
            float lbv[8];
            const int cf = col0 + bj * HALF;
            if (act == 3) {
#pragma unroll
                for (int e = 0; e < 8; ++e) lbv[e] = lb[cf + e];
            }
            const size_t hbase = (hm == 2) ? ((size_t)((bb * 2 + (cf >> 9)) * 4 + ((cf >> 7) & 3)) * SROW) : ((size_t)(bb * 4 + (cf >> 7)) * SROW);
#pragma unroll
            for (int ai = 0; ai < 2; ++ai)
#pragma unroll
                for (int m = 0; m < 4; ++m) {
                    float v[8];
#pragma unroll
                    for (int e = 0; e < 4; ++e) { v[e] = acc[ai][bj][m][0][e]; v[4 + e] = acc[ai][bj][m][1][e]; }
                    u32x4 w;
                    if (act == 3) {
#pragma unroll
                        for (int e = 0; e < 8; ++e) v[e] = __log2f(lbv[e] + (1.0f - lbv[e]) * sigmoid_(v[e]));
                        w.x = pkh2(v[0], v[1]); w.y = pkh2(v[2], v[3]); w.z = pkh2(v[4], v[5]); w.w = pkh2(v[6], v[7]);
                    } else {
                        if (act == 1) {
#pragma unroll
                            for (int e = 0; e < 8; ++e) v[e] = silu_(v[e]);
                        } else if (act == 2) {
#pragma unroll
                            for (int e = 0; e < 8; ++e) v[e] = sigmoid_(v[e]);
                        }
                        w.x = pk2(v[0], v[1]); w.y = pk2(v[2], v[3]); w.z = pk2(v[4], v[5]); w.w = pk2(v[6], v[7]);
                    }
                    const size_t off = hm ? (hbase + (size_t)(s0 + ai * HALF + m * 16)) * 128 + (cf & 127) : (size_t)(row0 + ai * HALF + m * 16) * ld + cf;
                    *(u32x4*)(O + off) = w;
                }
        }
    }
};
struct EpiOutProj {
    static constexpr bool PERM = false;
    const float* x; float* out; const float* mod;
    __device__ __forceinline__ void operator()(const f32x4 (&acc)[2][2][4][2], const Unit& u, int wr, int wc, int fr_, int fq) const {
        int fr = fr_; asm volatile("" : "+v"(fr));
        const int row0 = u.pm * BM + wr * 64 + fr, col0 = u.pn * BM + wc * 32 + 4 * fq;
        const float* g1 = mod + (size_t)(u.pm / 32) * 6144 + 2048;
#pragma unroll
        for (int bj = 0; bj < 2; ++bj)
#pragma unroll
            for (int n = 0; n < 2; ++n) {
                const int c = col0 + bj * HALF + n * 16; const f32x4 gv = *(const f32x4*)(g1 + c);
#pragma unroll
                for (int ai = 0; ai < 2; ++ai)
#pragma unroll
                    for (int m = 0; m < 4; ++m) { const size_t off = (size_t)(row0 + ai * HALF + m * 16) * D + c;
                        *(f32x4*)(out + off) = *(const f32x4*)(x + off) + gv * acc[ai][bj][m][n]; }
            }
    }
};
struct EpiMoE1 {
    static constexpr bool PERM = true;
    bf16* H;
    __device__ __forceinline__ void operator()(const f32x4 (&acc)[2][2][4][2], const Unit& u, int wr, int wc, int fr_, int fq) const {
        int fr = fr_; asm volatile("" : "+v"(fr));
        const int row0 = u.pm * BM + wr * 64 + fr, col0 = u.pn * HALF + wc * 32 + 8 * fq;
#pragma unroll
        for (int ai = 0; ai < 2; ++ai)
#pragma unroll
            for (int m = 0; m < 4; ++m) {
                float v[8];
#pragma unroll
                for (int e = 0; e < 4; ++e) { v[e] = silu_(acc[ai][0][m][0][e]) * acc[ai][1][m][0][e]; v[4 + e] = silu_(acc[ai][0][m][1][e]) * acc[ai][1][m][1][e]; }
                u32x4 w; w.x = pk2(v[0], v[1]); w.y = pk2(v[2], v[3]); w.z = pk2(v[4], v[5]); w.w = pk2(v[6], v[7]);
                *(u32x4*)(H + (size_t)(row0 + ai * HALF + m * 16) * FF + col0) = w;
            }
    }
};
struct EpiMoE2 {
    static constexpr bool PERM = true;
    bf16* Y; const float* gatev;
    __device__ __forceinline__ void operator()(const f32x4 (&acc)[2][2][4][2], const Unit& u, int wr, int wc, int fr_, int fq) const {
        int fr = fr_; asm volatile("" : "+v"(fr));
        const int row0 = u.pm * BM + wr * 64 + fr, col0 = u.pn * BM + wc * 32 + 8 * fq;
#pragma unroll
        for (int ai = 0; ai < 2; ++ai)
#pragma unroll
            for (int m = 0; m < 4; ++m) { const int row = row0 + ai * HALF + m * 16; const float gt = gatev[row];
#pragma unroll
                for (int bj = 0; bj < 2; ++bj) { const f32x4 a = acc[ai][bj][m][0] * gt, b = acc[ai][bj][m][1] * gt;
                    u32x4 w; w.x = pk2(a[0], a[1]); w.y = pk2(a[2], a[3]); w.z = pk2(b[0], b[1]); w.w = pk2(b[2], b[3]);
                    *(u32x4*)(Y + (size_t)row * D + col0 + bj * HALF) = w; } }
    }
};
}

__device__ __forceinline__ void transpose_item(const float* W, int ldw, int k0, int n0, bf16* dst_row0, LAS float* scr, int lane) {
#pragma unroll 8
    for (int i = 0; i < 32; ++i) { const int kk = 2 * i + (lane >> 5); scr[kk * 33 + (lane & 31)] = W[(size_t)(k0 + kk) * ldw + n0 + (lane & 31)]; }
    LDS_WAIT(); asm volatile("" ::: "memory");
    const int c = lane & 7;
#pragma unroll
    for (int j = 0; j < 4; ++j) { const int n = (lane >> 3) + 8 * j; const LAS float* s = scr + (8 * c) * 33 + n;
        u32x4 o; o.x = pk2(s[0 * 33], s[1 * 33]); o.y = pk2(s[2 * 33], s[3 * 33]); o.z = pk2(s[4 * 33], s[5 * 33]); o.w = pk2(s[6 * 33], s[7 * 33]);
        *(u32x4*)(dst_row0 + (size_t)n * 1024 + k0 + 8 * c) = o; }
    LDS_WAIT(); asm volatile("" ::: "memory");
}
__device__ __forceinline__ void phase_prologue(const Params& p, LAS unsigned char* lds) {
    const int tid = tid_opaque(), lane = tid & 63, wave = tid >> 6;
    const int gw = blockIdx.x * NWAVES + wave, NGW = gridDim.x * NWAVES;
    LAS float* scr = (LAS float*)(lds + wave * 16384);
    constexpr int I_IN = 16 * 144, I_OUT = 16 * 32, I_E = 16 * 512, I_MOD = 24 * 16;
    constexpr int NITEMS = I_IN + I_OUT + 3 * I_E + I_MOD;
    unsigned char* ws = p.ws;
    for (int it = gw; it < NITEMS; it += NGW) {
        int r = it;
        if (r < I_IN) { const int kb = r / 144, nb = r % 144; transpose_item(p.w_in, PROJ, kb * 64, nb * 32, (bf16*)(ws + WS_WIN_T) + (size_t)(nb * 32) * 1024, scr, lane); continue; } r -= I_IN;
        if (r < I_OUT) { const int kb = r / 32, nb = r % 32; transpose_item(p.w_out, D, kb * 64, nb * 32, (bf16*)(ws + WS_WOUT_T) + (size_t)(nb * 32) * 1024, scr, lane); continue; } r -= I_OUT;
        if (r < 2 * I_E) { const int up = r / I_E; r -= up * I_E; const int e = r / 512, q = r % 512, kb = q / 32, nb = q % 32, n0 = nb * 32;
            const int drow = (n0 / 128) * 256 + up * 128 + (n0 % 128);
            transpose_item((up ? p.wu : p.wg) + (size_t)e * D * FF, FF, kb * 64, n0, (bf16*)(ws + WS_WGU_T) + ((size_t)e * 2048 + drow) * 1024, scr, lane); continue; } r -= 2 * I_E;
        if (r < I_E) { const int e = r / 512, q = r % 512, kb = q / 32, nb = q % 32;
            transpose_item(p.wd + (size_t)e * FF * D, D, kb * 64, nb * 32, (bf16*)(ws + WS_WD_T) + ((size_t)e * 1024 + nb * 32) * 1024, scr, lane); continue; } r -= I_E;
        {
            const int cb = r / 16, ks = r % 16; const int col = cb * 256 + lane * 4;
            f32x4 a[5];
            float sv[5];
#pragma unroll
            for (int q = 0; q < 5; ++q) { a[q] = (f32x4){0.f, 0.f, 0.f, 0.f}; const float cv = (q < 4) ? p.c[q * D + ks * 64 + lane] : p.c_ctx[ks * 64 + lane]; sv[q] = silu_(cv); }
#pragma unroll 8
            for (int kk = 0; kk < 64; ++kk) {
                const f32x4 w = *(const f32x4*)(p.ada_w + (size_t)(ks * 64 + kk) * 6144 + col);
#pragma unroll
                for (int q = 0; q < 5; ++q) a[q] += w * __uint_as_float((unsigned)__builtin_amdgcn_readlane((int)__float_as_uint(sv[q]), kk));
            }
            float* mp = (float*)(ws + WS_MODP);
#pragma unroll
            for (int q = 0; q < 5; ++q) *(f32x4*)(mp + ((size_t)ks * 5 + q) * 6144 + col) = a[q];
        }
    }
    const int gt = blockIdx.x * NTHR + tid, NGT = gridDim.x * NTHR;
    for (int i = gt; i < 1024; i += NGT) { const float l0 = p.lb_logits[i], l1 = p.lb_logits[1024 + i]; ((float*)(ws + WS_LB))[i] = 1.0f / (1.0f + __expf(l1 - l0)); }
    for (int i = gt; i < 16 * 1024; i += NGT) { const int g = i >> 10, k = i & 1023; ((float*)(ws + WS_WGT))[i] = p.w_in[(size_t)k * PROJ + NPROJ + g]; ((float*)(ws + WS_RWT))[i] = p.router_w[k * 16 + g]; }
}

__device__ __forceinline__ void phase_u(const Params& p, LAS unsigned char* lds, int abl = 0) {
    const int tid = tid_opaque(), lane = tid & 63, wave = tid >> 6;
    unsigned char* ws = p.ws;
    LAS float* Lsh = (LAS float*)lds;
    LAS float* Lsc = Lsh + 5 * 1024;
    LAS float* Lnw = Lsc + 5 * 1024;
    LAS float* Lwg = Lnw + 1024;
    const float* modp = (const float*)(ws + WS_MODP);
    const int rpw = (R_ALL + (int)gridDim.x - 1) / (int)gridDim.x, rbeg = (int)blockIdx.x * rpw, rend = (rbeg + rpw < R_ALL) ? rbeg + rpw : R_ALL;
    for (int r = 0; r < 5; ++r) {
        bool need = false;
        if (rbeg < rend) { const int b0 = rbeg / SROW, b1 = (rend - 1) / SROW;
            for (int bb = b0; bb <= b1; ++bb) { const int lo = (rbeg > bb * SROW) ? rbeg : bb * SROW, hi = (rend < (bb + 1) * SROW) ? rend : (bb + 1) * SROW;
                if (r == 4) need = need || (lo < bb * SROW + CTX && lo < hi); else need = need || (r == bb && hi > bb * SROW + CTX && lo < hi); } }
        if (!need) continue;
        float pt[4][16];
#pragma unroll
        for (int k = 0; k < 4; ++k)
#pragma unroll
            for (int ks = 0; ks < 16; ++ks) pt[k][ks] = modp[((size_t)ks * 5 + r) * 6144 + tid + 512 * k];
#pragma unroll
        for (int k = 0; k < 4; ++k) { const int col = tid + 512 * k; float sm = p.ada_b[col];
#pragma unroll
            for (int ks = 0; ks < 16; ++ks) sm += pt[k][ks];
            if (col < 1024) Lsh[r * 1024 + col] = sm; else Lsc[r * 1024 + col - 1024] = sm; }
    }
    for (int e = blockIdx.x * NTHR + tid; e < 5 * 6144; e += gridDim.x * NTHR) { const int r = e / 6144, col = e % 6144; float s = p.ada_b[col];
        for (int ks = 0; ks < 16; ++ks) s += modp[((size_t)ks * 5 + r) * 6144 + col];
        ((float*)(ws + WS_MOD))[e] = s; }
    for (int i = tid; i < 1024; i += NTHR) Lnw[i] = p.norm1_w[i];
    for (int i = tid; i < 16 * 1024; i += NTHR) Lwg[i] = ((const float*)(ws + WS_WGT))[i];
    __syncthreads();
    constexpr int NGW = NWAVES;
    for (int row0 = rbeg + wave; row0 < rend; row0 += 4 * NGW) {
        f32x4 vv[4][4];
#pragma unroll
        for (int q = 0; q < 4; ++q) { const int row = row0 + q * NGW;
            if (row < rend) { const int b = row / SROW, s = row % SROW;
                const float* src = (s < CTX) ? p.ctx + ((size_t)b * CTX + s) * D : p.x + ((size_t)b * SEQ + (s - CTX)) * D;
#pragma unroll
                for (int j = 0; j < 4; ++j) vv[q][j] = *(const f32x4*)(src + j * 256 + lane * 4); } }
#pragma unroll
        for (int q = 0; q < 4; ++q) { const int row = row0 + q * NGW;
            if (row < rend) {
                const int b = row / SROW, s = row % SROW, r = (s < CTX) ? 4 : b;
                f32x4 v[4]; float ss = 0.f;
#pragma unroll
                for (int j = 0; j < 4; ++j) { v[j] = vv[q][j]; ss += (v[j].x * v[j].x + v[j].y * v[j].y) + (v[j].z * v[j].z + v[j].w * v[j].w); }
                const float rstd = rsqrtf(wave_sum(ss) * (1.0f / D) + EPS);
                bf16* urow = (bf16*)(ws + WS_U) + (size_t)row * D;
#pragma unroll
                for (int j = 0; j < 4; ++j) { const int c0 = j * 256 + lane * 4;
                    const f32x4 nw = *(const LAS f32x4*)(Lnw + c0), sc = *(const LAS f32x4*)(Lsc + r * 1024 + c0), sh = *(const LAS f32x4*)(Lsh + r * 1024 + c0);
                    v[j] = v[j] * rstd * nw * (1.0f + sc) + sh;
                    u32x2 w; w.x = pk2(v[j].x, v[j].y); w.y = pk2(v[j].z, v[j].w); if (abl < 2 || rstd == 123.f) *(u32x2*)(urow + c0) = w; }
                if (abl >= 1) continue;
                float pa[16];
#pragma unroll
                for (int g = 0; g < 16; ++g) { float a = 0.f;
#pragma unroll
                    for (int j = 0; j < 4; ++j) { const f32x4 w = *(const LAS f32x4*)(Lwg + g * 1024 + j * 256 + lane * 4); a += (v[j].x * w.x + v[j].y * w.y) + (v[j].z * w.z + v[j].w * w.w); }
                    pa[g] = a; if (g & 1) __builtin_amdgcn_sched_barrier(0); }
                const float mine = butterfly16(pa, lane);
                if ((lane & 3) == 0) { const int gi = lane >> 2; float gv = mine + p.ml_gate_b[gi];
                    if ((gi >> 2) & 1) gv = fminf(gv, 0.f) - log1pf(__expf(-fabsf(gv)));
                    ((float*)(ws + WS_GATES))[(size_t)row * 16 + gi] = gv; }
            } }
    }
}

__device__ __forceinline__ void conv_loadcol(const bf16* QKb, int r, int c, int ch, float (&o)[3][8]) {
#pragma unroll
    for (int i = 0; i < 3; ++i) { const int r2 = r + i - 1;
        if (c < 0 || c > 63 || r2 < 0 || r2 > 127) {
#pragma unroll
            for (int e = 0; e < 8; ++e) o[i][e] = 0.f;
        } else { const u32x4 w = *(const u32x4*)(QKb + (size_t)(r2 * 64 + c) * 1024 + ch);
            o[i][0] = bflo(w.x); o[i][1] = bfhi(w.x); o[i][2] = bflo(w.y); o[i][3] = bfhi(w.y); o[i][4] = bflo(w.z); o[i][5] = bfhi(w.z); o[i][6] = bflo(w.w); o[i][7] = bfhi(w.w); } }
}
__device__ __forceinline__ void conv_out(const float (&L)[3][8], const float (&M)[3][8], const float (&R)[3][8], const float (&wv)[9][8], const float (&bias)[8], float sc, bf16* dst) {
    float a[8];
#pragma unroll
    for (int e = 0; e < 8; ++e) { float t = bias[e];
#pragma unroll
        for (int i = 0; i < 3; ++i) t += L[i][e] * wv[i * 3][e] + M[i][e] * wv[i * 3 + 1][e] + R[i][e] * wv[i * 3 + 2][e];
        a[e] = silu_(t) * sc; }
    u32x4 o; o.x = pk2(a[0], a[1]); o.y = pk2(a[2], a[3]); o.z = pk2(a[4], a[5]); o.w = pk2(a[6], a[7]);
    *(u32x4*)dst = o;
}
__device__ __forceinline__ void phase_conv(const Params& p) {
    unsigned char* ws = p.ws;
    const bf16* QK = (const bf16*)(ws + WS_QK); bf16* QKC = (bf16*)(ws + WS_QKC);
    const int tid0 = tid_opaque();
    {
        const int lane = tid0 & 63, gw = blockIdx.x * NWAVES + (tid0 >> 6), NGW = gridDim.x * NWAVES;
        for (int item = gw; item < NB * 128 * 4; item += NGW) {
            const int half = item & 1, seg = (item >> 1) & 1, r = (item >> 2) & 127, b = item >> 9;
            const int ch = (half * 64 + lane) * 8;
            float wv[9][8], bias[8];
#pragma unroll
            for (int k = 0; k < 9; ++k) { const f32x4 w0 = *(const f32x4*)(p.conv_w + (size_t)k * 1024 + ch), w1 = *(const f32x4*)(p.conv_w + (size_t)k * 1024 + ch + 4);
                wv[k][0] = w0.x; wv[k][1] = w0.y; wv[k][2] = w0.z; wv[k][3] = w0.w; wv[k][4] = w1.x; wv[k][5] = w1.y; wv[k][6] = w1.z; wv[k][7] = w1.w; }
            { const f32x4 b0 = *(const f32x4*)(p.conv_b + ch), b1 = *(const f32x4*)(p.conv_b + ch + 4); bias[0] = b0.x; bias[1] = b0.y; bias[2] = b0.z; bias[3] = b0.w; bias[4] = b1.x; bias[5] = b1.y; bias[6] = b1.z; bias[7] = b1.w; }
            const float sc = (ch >= 512) ? 0.08838834764831845f : 1.0f;
            const bf16* QKb = QK + ((size_t)b * SROW + CTX) * 1024;
            bf16* dst = QKC + (size_t)(ch >> 9) * ((size_t)R_ALL * 512) + ((size_t)(b * 4 + ((ch >> 7) & 3)) * SROW + CTX + r * 64) * 128 + (ch & 127);
            const int c0 = seg * 32;
            float L[3][8], M[3][8], R[3][8];
            conv_loadcol(QKb, r, c0 - 1, ch, L); conv_loadcol(QKb, r, c0, ch, M);
#pragma unroll 1
            for (int c = c0; c < c0 + 32; c += 3) {
                conv_loadcol(QKb, r, c + 1, ch, R); conv_out(L, M, R, wv, bias, sc, dst + (size_t)c * 128);
                if (c + 1 < c0 + 32) { conv_loadcol(QKb, r, c + 2, ch, L); conv_out(M, R, L, wv, bias, sc, dst + (size_t)(c + 1) * 128); }
                if (c + 2 < c0 + 32) { conv_loadcol(QKb, r, c + 3, ch, M); conv_out(R, L, M, wv, bias, sc, dst + (size_t)(c + 2) * 128); }
            }
        }
    }
    for (int it = blockIdx.x * NTHR + tid0; it < NB * CTX * 128; it += gridDim.x * NTHR) {
        const int ch = (it & 127) * 8, s = (it >> 7) & (CTX - 1), b = it >> 15;
        float a[8];
#pragma unroll
        for (int e = 0; e < 8; ++e) a[e] = p.conv_b[ch + e];
#pragma unroll
        for (int j = 0; j < 3; ++j) { const int s2 = s + j - 1; if (s2 < 0 || s2 >= CTX) continue;
            const u32x4 w = *(const u32x4*)(QK + ((size_t)b * SROW + s2) * 1024 + ch); const float* cw = p.conv_w + (size_t)(3 + j) * 1024 + ch;
            a[0] += bflo(w.x) * cw[0]; a[1] += bfhi(w.x) * cw[1]; a[2] += bflo(w.y) * cw[2]; a[3] += bfhi(w.y) * cw[3];
            a[4] += bflo(w.z) * cw[4]; a[5] += bfhi(w.z) * cw[5]; a[6] += bflo(w.w) * cw[6]; a[7] += bfhi(w.w) * cw[7]; }
        const float sc = (ch >= 512) ? 0.08838834764831845f : 1.0f;
#pragma unroll
        for (int e = 0; e < 8; ++e) a[e] = silu_(a[e]) * sc;
        u32x4 o; o.x = pk2(a[0], a[1]); o.y = pk2(a[2], a[3]); o.z = pk2(a[4], a[5]); o.w = pk2(a[6], a[7]);
        *(u32x4*)(QKC + (size_t)(ch >> 9) * ((size_t)R_ALL * 512) + ((size_t)(b * 4 + ((ch >> 7) & 3)) * SROW + s) * 128 + (ch & 127)) = o;
    }
    {
        const int lane = tid0 & 63, gw = blockIdx.x * NWAVES + (tid0 >> 6), NGW = gridDim.x * NWAVES;
        for (int it = gw; it < 32 * 132; it += NGW) {
            const int chain = it / 132, ck = it % 132, dir = chain >> 4, b = (chain >> 2) & 3, h = chain & 3;
            const int n = ck * 64 + lane, s = dir ? (n < CTX ? CTX - 1 - n : CTX + (SROW - 1 - n)) : n;
            const float* gp = (const float*)(ws + WS_GATES) + ((size_t)b * SROW + s) * 16 + dir * 8 + h;
            const float li = gp[0]; float bs_ = gp[4];
#pragma unroll
            for (int o = 1; o < 64; o <<= 1) { const float t = __shfl_up(bs_, o); if (lane >= o) bs_ += t; }
            const float gg = li - bs_; float gm = gg;
#pragma unroll
            for (int o = 1; o < 64; o <<= 1) gm = fmaxf(gm, __shfl_xor(gm, o));
            ((float*)(ws + WS_SCB))[(size_t)chain * SROW + n] = bs_; ((float*)(ws + WS_SCG))[(size_t)chain * SROW + n] = gg;
            if (lane == 0) ((float*)(ws + WS_SCM))[chain * 132 + ck] = gm;
        }
    }
}

#define PSTAMP(k) do { if (PROF != 0 && OUT) { const unsigned long long t_ = __builtin_amdgcn_s_memrealtime(); if (PROF == (k)) tacc += t_ - tprev; tprev = t_; } } while (0)
namespace sc {
typedef short v4i16_t __attribute__((ext_vector_type(4)));
constexpr int PQ = 288, PK = 160;
constexpr int L_QT = 0, L_KT = 18432, L_K2T = 36864, L_V = 57344, L_P = 75776, L_O = 86016, L_ST = 104448, L_TOT = 141312, L_DVEC = 145408, L_EREF = 145920,
              L_N = 146432, L_DV = 146944, L_FL = 147200, L_END = 147456;
constexpr size_t SEG_STRIDE = 66560;

__device__ __forceinline__ int s_of(int dir, int n) { return dir ? (n < CTX ? CTX - 1 - n : CTX + (SROW - 1 - n)) : n; }
__device__ __forceinline__ bf16x8 ld8(LAS unsigned char* lds, int off) { return *(const LAS bf16x8*)(lds + off); }
__device__ __forceinline__ bf16x8 trB(LAS unsigned char* lds, int off) {
    const v4i16_t a = __builtin_amdgcn_ds_read_tr16_b64_v4i16((LAS v4i16_t*)(lds + off));
    const v4i16_t b = __builtin_amdgcn_ds_read_tr16_b64_v4i16((LAS v4i16_t*)(lds + off + 4 * PQ));
    return (bf16x8){a[0], a[1], a[2], a[3], b[0], b[1], b[2], b[3]};
}
__device__ __forceinline__ float rdlane(float v, int idx) { return __uint_as_float((unsigned)__builtin_amdgcn_readlane((int)__float_as_uint(v), idx)); }
#define SC_MFMA(a, b, c) __builtin_amdgcn_mfma_f32_16x16x32_bf16((a), (b), (c), 0, 0, 0)

template <bool ML>
__device__ __forceinline__ void pc_step(LAS unsigned char* lds, int w, int li, int g, int offA, int offB) {
    for (int ti = w; ti < 10; ti += 8) {
        const int ib = (ti >= 6) ? 3 : (ti >= 3) ? 2 : (ti >= 1) ? 1 : 0, jb = ti - (ib * (ib + 1)) / 2;
        f32x4 acc = (f32x4){0.f, 0.f, 0.f, 0.f};
#pragma unroll
        for (int s = 0; s < 4; ++s) acc = SC_MFMA(ld8(lds, offA + (16 * jb + li) * PQ + (32 * s + 8 * g) * 2), ld8(lds, offB + (16 * ib + li) * PQ + (32 * s + 8 * g) * 2), acc);
        const int i = 16 * ib + li, j0 = 16 * jb + 4 * g;
        const float v0 = (j0 + 0 <= i) ? acc[0] : 0.f, v1 = (j0 + 1 <= i) ? acc[1] : 0.f, v2 = (j0 + 2 <= i) ? acc[2] : 0.f, v3 = (j0 + 3 <= i) ? acc[3] : 0.f;
        u32x2 pw; pw.x = pk2(v0, v1); pw.y = pk2(v2, v3);
        *(LAS u32x2*)(lds + L_P + i * PK + j0 * 2) = pw;
        if (ML) { float ps = (bflo(pw.x) + bfhi(pw.x)) + (bflo(pw.y) + bfhi(pw.y)); ps += __shfl_xor(ps, 16); ps += __shfl_xor(ps, 32);
            if (g == 0) __hip_atomic_fetch_add((LAS float*)(lds + L_DV) + i, ps, __ATOMIC_RELAXED, __HIP_MEMORY_SCOPE_WORKGROUP); }
    }
}
__device__ __forceinline__ void w_step(const Params& p, LAS unsigned char* lds, int tid, int dir, int b, int nbase, int type, int h) {
#pragma unroll
    for (int q = 0; q < 2; ++q) { const int idx = tid + q * NTHR, i = idx >> 4, ch = idx & 15;
        const u32x4 val = *(const LAS u32x4*)(lds + L_O + i * PQ + ch * 16);
        const int t = s_of(dir, nbase + i) - CTX;
        *(u32x4*)((bf16*)p.out + (((size_t)(dir * 2 + type) * 16 + (b * 4 + h)) * SEQ + t) * 128 + ch * 8) = val; }
}
__device__ __forceinline__ void save_tiles(float* dst, const f32x4 (&S)[8], int w, int lane) {
#pragma unroll
    for (int t = 0; t < 8; ++t) *(f32x4*)(dst + ((size_t)(w * 8 + t) * 64 + lane) * 4) = S[t];
}

#define SC_SB __builtin_amdgcn_sched_barrier(0)
template <bool ML>
__device__ __forceinline__ void o_tiles(LAS unsigned char* lds, const bf16x8 (&bv)[2], const bf16x8 (&bs)[4], int w, int li, int g) {
#pragma unroll
    for (int it = 0; it < 4; ++it) {
        bf16x8 fp[2], fq[4]; float den = 1.f, fl = 0.f;
        fp[0] = ld8(lds, L_P + (16 * it + li) * PK + (8 * g) * 2);
        if (it >= 2) fp[1] = ld8(lds, L_P + (16 * it + li) * PK + (32 + 8 * g) * 2); else fp[1] = fp[0];
#pragma unroll
        for (int s = 0; s < 4; ++s) fq[s] = ld8(lds, L_QT + (16 * it + li) * PQ + (32 * s + 8 * g) * 2);
        if (ML) { den = *(const LAS float*)(lds + L_DV + 4 * (16 * it + li)); fl = *(const LAS float*)(lds + L_FL + 4 * (16 * it + li)); }
        SC_SB;
        f32x4 acc = (f32x4){0.f, 0.f, 0.f, 0.f};
        acc = SC_MFMA(bv[0], fp[0], acc);
        if (it >= 2) acc = SC_MFMA(bv[1], fp[1], acc);
#pragma unroll
        for (int s = 0; s < 4; ++s) acc = SC_MFMA(bs[s], fq[s], acc);
        SC_SB;
        const int i = 16 * it + li;
        if (ML) acc = acc * __builtin_amdgcn_rcpf(fmaxf(fabsf(den), fl));
        u32x2 pw; pw.x = pk2(acc[0], acc[1]); pw.y = pk2(acc[2], acc[3]); *(LAS u32x2*)(lds + L_O + i * PQ + (16 * w + 4 * g) * 2) = pw;
    }
}
__device__ __forceinline__ void s_update(LAS unsigned char* lds, f32x4 (&S)[8], const bf16x8 (&bv)[2], int li, int g) {
#pragma unroll
    for (int hp = 0; hp < 2; ++hp) {
        bf16x8 fk[4][2];
#pragma unroll
        for (int u = 0; u < 4; ++u)
#pragma unroll
            for (int s = 0; s < 2; ++s) fk[u][s] = ld8(lds, L_K2T + (16 * (4 * hp + u) + li) * PK + (32 * s + 8 * g) * 2);
        SC_SB;
#pragma unroll
        for (int s = 0; s < 2; ++s)
#pragma unroll
            for (int u = 0; u < 4; ++u) S[4 * hp + u] = SC_MFMA(fk[u][s], bv[s], S[4 * hp + u]);
        SC_SB;
    }
}

struct HgIn { unsigned lf[8], q[8], v[8]; };
template <bool OUT>
__device__ __forceinline__ void hg_load(const Params& p, HgIn& r, int dir, int b, int h, int nbase, int w, int l) {
    const unsigned char* ws = p.ws;
    const size_t sp0 = (size_t)s_of(dir, nbase + 8 * w); const long step = dir ? -256 : 256;
    const char* plf = (const char*)(ws + WS_LF) + ((size_t)((b * 2 + dir) * 4 + h) * SROW + sp0) * 256;
    const char* pv = (const char*)(ws + WS_HV) + ((size_t)(b * 4 + h) * SROW + sp0) * 256;
    const char* pq = (const char*)(ws + WS_HQ) + ((size_t)(b * 4 + h) * SROW + sp0) * 256;
#pragma unroll
    for (int t = 0; t < 8; ++t) {
        r.lf[t] = *(const unsigned*)(plf + t * step + 4 * l);
        r.v[t] = *(const unsigned*)(pv + t * step + 4 * l);
        if (OUT) r.q[t] = *(const unsigned*)(pq + t * step + 4 * l); else r.q[t] = 0u; }
}
template <bool OUT>
__device__ __forceinline__ void hg_chunk(const Params& p, LAS unsigned char* lds, int dir, int b, int h, int nbase, f32x4 (&S)[8], float& lt0, float& lt1, unsigned long long& tacc,
                                         const HgIn& cur, HgIn& pf, bool do_pf, int tid, int w, int l, int li, int g) {
        unsigned long long tprev = 0; PSTAMP(0);
        float c0 = 0.f, c1 = 0.f;
#pragma unroll
        for (int t = 0; t < 8; ++t) { c0 += h2f((unsigned short)(cur.lf[t] & 0xffffu)); c1 += h2f((unsigned short)(cur.lf[t] >> 16)); }
        *(LAS f32x2*)(lds + L_TOT + (w * 128 + 2 * l) * 4) = (f32x2){c0, c1};
        __syncthreads(); PSTAMP(1);
        float pre0 = 0.f, pre1 = 0.f, ar0 = 0.f, ar1 = 0.f, al0 = 0.f, al1 = 0.f;
#pragma unroll
        for (int w2 = 0; w2 < 8; ++w2) { const f32x2 tt = *(const LAS f32x2*)(lds + L_TOT + (w2 * 128 + 2 * l) * 4);
            if (w2 < w) { pre0 += tt.x; pre1 += tt.y; } if (w2 < 4) { ar0 += tt.x; ar1 += tt.y; } al0 += tt.x; al1 += tt.y; }
        unsigned k2a[8], k2b[8];
        const float c20 = __builtin_amdgcn_exp2f(al0 - ar0), c21 = __builtin_amdgcn_exp2f(al1 - ar1);
        float A0 = pre0, A1 = pre1;
#pragma unroll
        for (int t = 0; t < 8; ++t) { const int j = 8 * w + t;
            const float lf0 = h2f((unsigned short)(cur.lf[t] & 0xffffu)), lf1 = h2f((unsigned short)(cur.lf[t] >> 16));
            A0 += lf0; A1 += lf1;
            const float k0 = 1.0f - __builtin_amdgcn_exp2f(lf0), k1 = 1.0f - __builtin_amdgcn_exp2f(lf1);
            float kt0, kt1, kk0, kk1;
            if (OUT) { kt0 = k0 * __builtin_amdgcn_exp2f(fminf(ar0 - A0, 86.f)); kt1 = k1 * __builtin_amdgcn_exp2f(fminf(ar1 - A1, 86.f)); kk0 = kt0 * c20; kk1 = kt1 * c21; }
            else { kt0 = kt1 = 0.f; kk0 = k0 * __builtin_amdgcn_exp2f(al0 - A0); kk1 = k1 * __builtin_amdgcn_exp2f(al1 - A1); }
            if (OUT) *(LAS unsigned*)(lds + L_KT + j * PQ + 4 * l) = pk2(kt0, kt1);
            *(LAS unsigned*)(lds + L_V + j * PQ + 4 * l) = cur.v[t];
            if (OUT) { const float q0 = bflo(cur.q[t]) * __builtin_amdgcn_exp2f(fminf(A0 - ar0, 86.f)), q1 = bfhi(cur.q[t]) * __builtin_amdgcn_exp2f(fminf(A1 - ar1, 86.f));
                *(LAS unsigned*)(lds + L_QT + j * PQ + 4 * l) = pk2(q0, q1); }
            const unsigned kk = pk2(kk0, kk1);
            if (t & 1) { k2a[t >> 1] = (k2a[t >> 1] & 0xffffu) | (kk << 16); k2b[t >> 1] = (k2b[t >> 1] & 0xffffu) | (kk & 0xffff0000u); }
            else { k2a[t >> 1] = kk & 0xffffu; k2b[t >> 1] = kk >> 16; } }
        *(LAS u32x4*)(lds + L_K2T + (2 * l) * PK + 16 * w) = (u32x4){k2a[0], k2a[1], k2a[2], k2a[3]};
        *(LAS u32x4*)(lds + L_K2T + (2 * l + 1) * PK + 16 * w) = (u32x4){k2b[0], k2b[1], k2b[2], k2b[3]};
        if (w == 0) { *(LAS f32x2*)(lds + L_DVEC + 8 * l) = (f32x2){__builtin_amdgcn_exp2f(al0), __builtin_amdgcn_exp2f(al1)}; *(LAS f32x2*)(lds + L_EREF + 8 * l) = (f32x2){__builtin_amdgcn_exp2f(ar0), __builtin_amdgcn_exp2f(ar1)}; }
        lt0 += al0; lt1 += al1;
        __syncthreads(); PSTAMP(2);
        if (do_pf) hg_load<OUT>(p, pf, dir, b, h, nbase + 128, w, l);
        if (OUT) { pc_step<false>(lds, w, li, g, L_KT, L_QT); __syncthreads(); } PSTAMP(3);
        bf16x8 bv[2];
#pragma unroll
        for (int s = 0; s < 2; ++s) bv[s] = trB(lds, L_V + (32 * s + 8 * g + (li >> 2)) * PQ + (16 * w + 4 * (li & 3)) * 2);
        if (OUT) {
            f32x4 er[8];
#pragma unroll
            for (int t = 0; t < 8; ++t) er[t] = *(const LAS f32x4*)(lds + L_EREF + (16 * t + 4 * g) * 4);
            SC_SB;
#pragma unroll
            for (int t = 0; t < 8; ++t) { const f32x4 sv = S[t] * er[t];
                u32x2 pw; pw.x = pk2(sv[0], sv[1]); pw.y = pk2(sv[2], sv[3]); *(LAS u32x2*)(lds + L_ST + (16 * w + li) * PQ + (16 * t + 4 * g) * 2) = pw; }
            bf16x8 bs[4];
#pragma unroll
            for (int s = 0; s < 4; ++s) bs[s] = ld8(lds, L_ST + (16 * w + li) * PQ + (32 * s + 8 * g) * 2);
            o_tiles<false>(lds, bv, bs, w, li, g);
        }
        {   f32x4 dvv[8];
#pragma unroll
            for (int t = 0; t < 8; ++t) dvv[t] = *(const LAS f32x4*)(lds + L_DVEC + (16 * t + 4 * g) * 4);
            SC_SB;
#pragma unroll
            for (int t = 0; t < 8; ++t) S[t] = S[t] * dvv[t]; }
        s_update(lds, S, bv, li, g);
        __syncthreads(); PSTAMP(4);
        if (OUT) w_step(p, lds, tid, dir, b, nbase, 0, h);
        PSTAMP(5);
}
template <bool OUT>
__device__ __forceinline__ void hg_run(const Params& p, LAS unsigned char* lds, int dir, int b, int h, int n0, int nch, f32x4 (&S)[8], float& lt0, float& lt1, unsigned long long& tacc) {
    const int tid = tid_opaque(), w = __builtin_amdgcn_readfirstlane(tid >> 6), l = tid & 63, li = l & 15, g = l >> 4;
    HgIn A, B, C;
    hg_load<OUT>(p, A, dir, b, h, n0, w, l);
    if (nch > 1) hg_load<OUT>(p, B, dir, b, h, n0 + 64, w, l);
    for (int c = 0; c < nch; c += 3) {
        hg_chunk<OUT>(p, lds, dir, b, h, n0 + 64 * c, S, lt0, lt1, tacc, A, C, c + 2 < nch, tid, w, l, li, g);
        if (c + 1 < nch) hg_chunk<OUT>(p, lds, dir, b, h, n0 + 64 * (c + 1), S, lt0, lt1, tacc, B, A, c + 3 < nch, tid, w, l, li, g);
        if (c + 2 < nch) hg_chunk<OUT>(p, lds, dir, b, h, n0 + 64 * (c + 2), S, lt0, lt1, tacc, C, B, c + 4 < nch, tid, w, l, li, g);
    }
}

struct MlIn { unsigned q[8], k[8], v[8]; float bs, gg, gm; };
template <bool OUT>
__device__ __forceinline__ void ml_load(const Params& p, MlIn& r, int dir, int b, int h, int nbase, int w, int l) {
    const unsigned char* ws = p.ws;
    const size_t sp0 = (size_t)s_of(dir, nbase + 8 * w); const long step = dir ? -256 : 256;
    const size_t o0 = ((size_t)(b * 4 + h) * SROW + sp0) * 256;
    const char* pq = (const char*)(ws + WS_QKC) + o0; const char* pk = pq + (size_t)R_ALL * 1024; const char* pv = (const char*)(ws + WS_MV) + o0;
#pragma unroll
    for (int t = 0; t < 8; ++t) {
        r.k[t] = *(const unsigned*)(pk + t * step + 4 * l);
        r.v[t] = *(const unsigned*)(pv + t * step + 4 * l);
        if (OUT) r.q[t] = *(const unsigned*)(pq + t * step + 4 * l); else r.q[t] = 0u; }
    const int chain = (dir * 4 + b) * 4 + h;
    r.bs = ((const float*)(ws + WS_SCB))[(size_t)chain * SROW + nbase + l]; r.gg = ((const float*)(ws + WS_SCG))[(size_t)chain * SROW + nbase + l];
    r.gm = ((const float*)(ws + WS_SCM))[chain * 132 + (nbase >> 6)];
}
template <bool OUT>
__device__ __forceinline__ void ml_chunk(const Params& p, LAS unsigned char* lds, int dir, int b, int h, int nbase, f32x4 (&S)[8], float& m_prev, float& btot, unsigned long long& tacc,
                                         const MlIn& cur, MlIn& pf, bool do_pf, int tid, int w, int l, int li, int g) {
        unsigned long long tprev = 0; PSTAMP(0);
        const float bs_ = cur.bs, gg = cur.gg, gm = cur.gm;
        const float G = fmaxf(m_prev, gm), s_in = __expf(m_prev - G), eg = __expf(gg - G), b63 = rdlane(bs_, 63);
        if (w == 0 && OUT) *(LAS float*)(lds + L_FL + 4 * l) = __expf(-(bs_ + G));
        float n0v = 0.f, n1v = 0.f;
        if (OUT) { const f32x2 nn = *(const LAS f32x2*)(lds + L_N + 8 * l); n0v = nn.x * s_in; n1v = nn.y * s_in; }
        float ks0 = 0.f, ks1 = 0.f; unsigned k2a[8], k2b[8]; float qd[8];
#pragma unroll
        for (int t = 0; t < 8; ++t) { const int j = 8 * w + t; const float egj = rdlane(eg, j);
            const float kh0 = bflo(cur.k[t]) * egj, kh1 = bfhi(cur.k[t]) * egj; ks0 += kh0; ks1 += kh1;
            const unsigned kk = pk2(kh0, kh1);
            *(LAS unsigned*)(lds + L_V + j * PQ + 4 * l) = cur.v[t];
            if (OUT) { *(LAS unsigned*)(lds + L_KT + j * PQ + 4 * l) = kk; *(LAS unsigned*)(lds + L_QT + j * PQ + 4 * l) = cur.q[t];
                qd[t] = bflo(cur.q[t]) * n0v + bfhi(cur.q[t]) * n1v; } else qd[t] = 0.f;
            if (t & 1) { k2a[t >> 1] = (k2a[t >> 1] & 0xffffu) | (kk << 16); k2b[t >> 1] = (k2b[t >> 1] & 0xffffu) | (kk & 0xffff0000u); }
            else { k2a[t >> 1] = kk & 0xffffu; k2b[t >> 1] = kk >> 16; } }
        if (OUT) {
            const bool h5 = (l & 32) != 0, h4 = (l & 16) != 0, h3 = (l & 8) != 0; float r4[4], r2[2];
#pragma unroll
            for (int e = 0; e < 4; ++e) { const float keep = h5 ? qd[e + 4] : qd[e], send = h5 ? qd[e] : qd[e + 4]; r4[e] = keep + __shfl_xor(send, 32); }
#pragma unroll
            for (int e = 0; e < 2; ++e) { const float keep = h4 ? r4[e + 2] : r4[e], send = h4 ? r4[e] : r4[e + 2]; r2[e] = keep + __shfl_xor(send, 16); }
            const float keep = h3 ? r2[1] : r2[0], send = h3 ? r2[0] : r2[1];
            float r1 = keep + __shfl_xor(send, 8);
            r1 += __shfl_xor(r1, 4); r1 += __shfl_xor(r1, 2); r1 += __shfl_xor(r1, 1);
            if ((l & 7) == 0) *(LAS float*)(lds + L_DV + 4 * (8 * w + ((l >> 3) & 7))) = r1;
        }
        *(LAS u32x4*)(lds + L_K2T + (2 * l) * PK + 16 * w) = (u32x4){k2a[0], k2a[1], k2a[2], k2a[3]};
        *(LAS u32x4*)(lds + L_K2T + (2 * l + 1) * PK + 16 * w) = (u32x4){k2b[0], k2b[1], k2b[2], k2b[3]};
        *(LAS f32x2*)(lds + L_TOT + (w * 128 + 2 * l) * 4) = (f32x2){ks0, ks1};
        __syncthreads(); PSTAMP(2);
        if (tid < 128) { float s = *(const LAS float*)(lds + L_N + 4 * tid) * s_in;
#pragma unroll
            for (int w2 = 0; w2 < 8; ++w2) s += *(const LAS float*)(lds + L_TOT + (w2 * 128 + tid) * 4);
            *(LAS float*)(lds + L_N + 4 * tid) = s; }
        if (do_pf) ml_load<OUT>(p, pf, dir, b, h, nbase + 128, w, l);
        if (OUT) { pc_step<true>(lds, w, li, g, L_KT, L_QT); __syncthreads(); } PSTAMP(3);
        bf16x8 bv[2];
#pragma unroll
        for (int s = 0; s < 2; ++s) bv[s] = trB(lds, L_V + (32 * s + 8 * g + (li >> 2)) * PQ + (16 * w + 4 * (li & 3)) * 2);
#pragma unroll
        for (int t = 0; t < 8; ++t) S[t] = S[t] * s_in;
        if (OUT) {
#pragma unroll
            for (int t = 0; t < 8; ++t) { u32x2 pw; pw.x = pk2(S[t][0], S[t][1]); pw.y = pk2(S[t][2], S[t][3]); *(LAS u32x2*)(lds + L_ST + (16 * w + li) * PQ + (16 * t + 4 * g) * 2) = pw; }
            bf16x8 bs[4];
#pragma unroll
            for (int s = 0; s < 4; ++s) bs[s] = ld8(lds, L_ST + (16 * w + li) * PQ + (32 * s + 8 * g) * 2);
            o_tiles<true>(lds, bv, bs, w, li, g);
        }
        s_update(lds, S, bv, li, g);
        m_prev = b63 + G; btot += b63;
        __syncthreads(); PSTAMP(4);
        if (OUT) w_step(p, lds, tid, dir, b, nbase, 1, h);
        PSTAMP(5);
}
template <bool OUT>
__device__ __forceinline__ void ml_run(const Params& p, LAS unsigned char* lds, int dir, int b, int h, int n0, int nch, f32x4 (&S)[8], float& m_prev, float& btot, unsigned long long& tacc) {
    const int tid = tid_opaque(), w = __builtin_amdgcn_readfirstlane(tid >> 6), l = tid & 63, li = l & 15, g = l >> 4;
    MlIn A, B, C;
    ml_load<OUT>(p, A, dir, b, h, n0, w, l);
    if (nch > 1) ml_load<OUT>(p, B, dir, b, h, n0 + 64, w, l);
    for (int c = 0; c < nch; c += 3) {
        ml_chunk<OUT>(p, lds, dir, b, h, n0 + 64 * c, S, m_prev, btot, tacc, A, C, c + 2 < nch, tid, w, l, li, g);
        if (c + 1 < nch) ml_chunk<OUT>(p, lds, dir, b, h, n0 + 64 * (c + 1), S, m_prev, btot, tacc, B, A, c + 3 < nch, tid, w, l, li, g);
        if (c + 2 < nch) ml_chunk<OUT>(p, lds, dir, b, h, n0 + 64 * (c + 2), S, m_prev, btot, tacc, C, B, c + 4 < nch, tid, w, l, li, g);
    }
}

__device__ __forceinline__ void pass_a(const Params& p, LAS unsigned char* lds, int item) {
    const int tid = tid_opaque(), w = __builtin_amdgcn_readfirstlane(tid >> 6), l = tid & 63;
    const int chain = item >> 2, sa = item & 3, type = chain >> 5, dir = (chain >> 4) & 1, b = (chain >> 2) & 3, h = chain & 3;
    const int n0 = sa == 0 ? 0 : CTX + (sa - 1) * 2048, nch = sa == 0 ? 4 : 32;
    float* rec = (float*)(p.ws + WS_SEG + (size_t)item * SEG_STRIDE);
    f32x4 S[8];
#pragma unroll
    for (int t = 0; t < 8; ++t) S[t] = (f32x4){0.f, 0.f, 0.f, 0.f};
    if (type == 0) { float lt0 = 0.f, lt1 = 0.f; unsigned long long tacc = 0; hg_run<false>(p, lds, dir, b, h, n0, nch, S, lt0, lt1, tacc);
        save_tiles(rec, S, w, l); if (w == 0) *(f32x2*)(rec + 16384 + 2 * l) = (f32x2){lt0, lt1}; }
    else { float m_prev = -1.0e30f, btot = 0.f;
        if (tid < 128) *(LAS float*)(lds + L_N + 4 * tid) = 0.f;
        __syncthreads();
        unsigned long long tacc = 0; ml_run<false>(p, lds, dir, b, h, n0, nch, S, m_prev, btot, tacc);
        save_tiles(rec, S, w, l); if (tid < 128) rec[16384 + tid] = *(const LAS float*)(lds + L_N + 4 * tid);
        if (tid == 0) { rec[16384 + 128] = m_prev; rec[16384 + 129] = btot; } }
    __syncthreads();
}
__device__ __forceinline__ void pass_b(const Params& p, LAS unsigned char* lds, int item) {
    const int tid = tid_opaque(), w = __builtin_amdgcn_readfirstlane(tid >> 6), l = tid & 63, g = l >> 4;
    const int chain = item >> 2, k = item & 3, type = chain >> 5, dir = (chain >> 4) & 1, b = (chain >> 2) & 3, h = chain & 3;
    const int n0 = CTX + k * 2048;
    unsigned long long tacc = 0;
    for (int i = tid; i < 64 * PK / 4; i += NTHR) *(LAS unsigned*)(lds + L_P + 4 * i) = 0u;
    f32x4 S[8];
#pragma unroll
    for (int t = 0; t < 8; ++t) S[t] = (f32x4){0.f, 0.f, 0.f, 0.f};
    if (type == 0) {
        for (int j = 0; j <= k; ++j) { const float* rec = (const float*)(p.ws + WS_SEG + (size_t)(chain * 4 + j) * SEG_STRIDE);
#pragma unroll
            for (int t = 0; t < 8; ++t) { const f32x4 lt = *(const f32x4*)(rec + 16384 + 16 * t + 4 * g); const f32x4 u = *(const f32x4*)(rec + ((size_t)(w * 8 + t) * 64 + l) * 4);
                S[t][0] = S[t][0] * __builtin_amdgcn_exp2f(lt[0]) + u[0]; S[t][1] = S[t][1] * __builtin_amdgcn_exp2f(lt[1]) + u[1]; S[t][2] = S[t][2] * __builtin_amdgcn_exp2f(lt[2]) + u[2]; S[t][3] = S[t][3] * __builtin_amdgcn_exp2f(lt[3]) + u[3]; } }
        __syncthreads();
        float lt0 = 0.f, lt1 = 0.f; hg_run<true>(p, lds, dir, b, h, n0, 32, S, lt0, lt1, tacc);
    } else {
        float m_in = -1.0e30f, nacc = 0.f;
        for (int j = 0; j <= k; ++j) { const float* rec = (const float*)(p.ws + WS_SEG + (size_t)(chain * 4 + j) * SEG_STRIDE);
            const float m_loc = rec[16384 + 128], bj = rec[16384 + 129]; const float mn = fmaxf(bj + m_in, m_loc), sa_ = __expf(bj + m_in - mn), sb_ = __expf(m_loc - mn);
#pragma unroll
            for (int t = 0; t < 8; ++t) { const f32x4 u = *(const f32x4*)(rec + ((size_t)(w * 8 + t) * 64 + l) * 4); S[t] = S[t] * sa_ + u * sb_; }
            if (tid < 128) nacc = nacc * sa_ + rec[16384 + tid] * sb_;
            m_in = mn; }
        if (tid < 128) *(LAS float*)(lds + L_N + 4 * tid) = nacc;
        __syncthreads();
        float btot = 0.f; ml_run<true>(p, lds, dir, b, h, n0, 32, S, m_in, btot, tacc);
    }
    if (PROF != 0 && (int)blockIdx.x == PROF_BLOCK) { const unsigned long long st = __builtin_amdgcn_s_memrealtime(); while (__builtin_amdgcn_s_memrealtime() - st < tacc * 100ull) __builtin_amdgcn_s_sleep(8); }
    __syncthreads();
}
#undef SC_MFMA
#undef SC_SB
}

__device__ __forceinline__ void phase_mixprep(const Params& p) {
    unsigned char* ws = p.ws;
    const int tid = tid_opaque(), lane = tid & 63, wave = tid >> 6;
    const int gw = blockIdx.x * NWAVES + wave, NGW = gridDim.x * NWAVES;
    for (int xr = gw; xr < R_X; xr += NGW) {
        const int b = xr / SEQ, t = xr % SEQ; const size_t row = (size_t)b * SROW + CTX + t;
        const int tyh = lane >> 3;
        const size_t o2 = (((size_t)(tyh >> 2) * 16 + (b * 4 + (tyh & 3))) * SEQ + t) * 128 + (lane & 7) * 16;
        const bf16* of = (const bf16*)p.out + o2;
        const bf16* ob = (const bf16*)p.out + (size_t)2 * 16 * SEQ * 128 + o2;
        float v[16];
#pragma unroll
        for (int q = 0; q < 2; ++q) { const u32x4 a = *(const u32x4*)(of + q * 8), c = *(const u32x4*)(ob + q * 8);
            v[q * 8 + 0] = bflo(a.x) + bflo(c.x); v[q * 8 + 1] = bfhi(a.x) + bfhi(c.x); v[q * 8 + 2] = bflo(a.y) + bflo(c.y); v[q * 8 + 3] = bfhi(a.y) + bfhi(c.y);
            v[q * 8 + 4] = bflo(a.z) + bflo(c.z); v[q * 8 + 5] = bfhi(a.z) + bfhi(c.z); v[q * 8 + 6] = bflo(a.w) + bflo(c.w); v[q * 8 + 7] = bfhi(a.w) + bfhi(c.w); }
        float s = 0.f;
#pragma unroll
        for (int e = 0; e < 16; ++e) s += v[e];
        s += __shfl_xor(s, 1); s += __shfl_xor(s, 2); s += __shfl_xor(s, 4);
        const bool ml = lane >= 32;
        const float mean = ml ? s * (1.0f / 128.0f) : 0.f;
        float q2 = 0.f;
#pragma unroll
        for (int e = 0; e < 16; ++e) { v[e] -= mean; q2 += v[e] * v[e]; }
        q2 += __shfl_xor(q2, 1); q2 += __shfl_xor(q2, 2); q2 += __shfl_xor(q2, 4);
        const float rstd = rsqrtf(q2 * (1.0f / 128.0f) + EPS);
        const int c0 = (lane & 31) * 16;
        const float* nw = (ml ? p.ml_norm_w : p.hg_norm_w) + c0;
        const bf16* gt = (const bf16*)(ws + (ml ? WS_MO : WS_HG)) + row * 512 + c0;
        const u32x4 g0 = *(const u32x4*)gt, g1 = *(const u32x4*)(gt + 8);
        float g[16] = {bflo(g0.x), bfhi(g0.x), bflo(g0.y), bfhi(g0.y), bflo(g0.z), bfhi(g0.z), bflo(g0.w), bfhi(g0.w),
                       bflo(g1.x), bfhi(g1.x), bflo(g1.y), bfhi(g1.y), bflo(g1.z), bfhi(g1.z), bflo(g1.w), bfhi(g1.w)};
#pragma unroll
        for (int e = 0; e < 16; ++e) v[e] = v[e] * rstd * nw[e] * g[e];
        u32x4 o0, o1; o0.x = pk2(v[0], v[1]); o0.y = pk2(v[2], v[3]); o0.z = pk2(v[4], v[5]); o0.w = pk2(v[6], v[7]);
        o1.x = pk2(v[8], v[9]); o1.y = pk2(v[10], v[11]); o1.z = pk2(v[12], v[13]); o1.w = pk2(v[14], v[15]);
        bf16* am = (bf16*)(ws + WS_AMIX2) + (size_t)xr * 1024 + lane * 16;
        *(u32x4*)am = o0; *(u32x4*)(am + 8) = o1;
    }
}

__device__ __forceinline__ void phase_vx(const Params& p, LAS unsigned char* lds) {
    unsigned char* ws = p.ws;
    const int tid = tid_opaque(), lane = tid & 63, wave = tid >> 6;
    LAS float* Lrw = (LAS float*)lds;
    LAS float* Lnw = Lrw + 16 * 1024;
    LAS float* Lsh = Lnw + 1024;
    LAS float* Lsc = Lsh + 4096;
    const float* mod = (const float*)(ws + WS_MOD);
    for (int i = tid; i < 16 * 1024; i += NTHR) Lrw[i] = ((const float*)(ws + WS_RWT))[i];
    for (int i = tid; i < 1024; i += NTHR) Lnw[i] = p.norm2_w[i];
    for (int i = tid; i < 4096; i += NTHR) { const int b = i >> 10, c = i & 1023; Lsh[i] = mod[(size_t)b * 6144 + 3072 + c]; Lsc[i] = mod[(size_t)b * 6144 + 4096 + c]; }
    __syncthreads();
    const int gw = blockIdx.x * NWAVES + wave, NGW = gridDim.x * NWAVES;
    for (int xr0 = gw; xr0 < R_X; xr0 += 4 * NGW) {
        f32x4 vv[4][4];
#pragma unroll
        for (int q = 0; q < 4; ++q) { const int xr = xr0 + q * NGW;
            if (xr < R_X) { const float* src = p.out + (size_t)xr * D;
#pragma unroll
                for (int j = 0; j < 4; ++j) vv[q][j] = *(const f32x4*)(src + j * 256 + lane * 4); } }
#pragma unroll
        for (int q = 0; q < 4; ++q) { const int xr = xr0 + q * NGW;
            if (xr < R_X) {
                const int b = xr / SEQ, t = xr % SEQ;
                f32x4 v[4]; float ss = 0.f;
#pragma unroll
                for (int j = 0; j < 4; ++j) { v[j] = vv[q][j]; ss += (v[j].x * v[j].x + v[j].y * v[j].y) + (v[j].z * v[j].z + v[j].w * v[j].w); }
                const float rstd = rsqrtf(wave_sum(ss) * (1.0f / D) + EPS);
                bf16* vrow = (bf16*)(ws + WS_VX) + (size_t)xr * D;
#pragma unroll
                for (int j = 0; j < 4; ++j) { const int c0 = j * 256 + lane * 4;
                    const f32x4 nw = *(const LAS f32x4*)(Lnw + c0), sc = *(const LAS f32x4*)(Lsc + b * 1024 + c0), sh = *(const LAS f32x4*)(Lsh + b * 1024 + c0);
                    v[j] = v[j] * rstd * nw * (1.0f + sc) + sh;
                    u32x2 w; w.x = pk2(v[j].x, v[j].y); w.y = pk2(v[j].z, v[j].w); *(u32x2*)(vrow + c0) = w; }
                float pa[16];
#pragma unroll
                for (int g = 0; g < 16; ++g) { float a = 0.f;
#pragma unroll
                    for (int j = 0; j < 4; ++j) { const f32x4 w = *(const LAS f32x4*)(Lrw + g * 1024 + j * 256 + lane * 4); a += (v[j].x * w.x + v[j].y * w.y) + (v[j].z * w.z + v[j].w * w.w); }
                    pa[g] = a; if (g & 1) __builtin_amdgcn_sched_barrier(0); }
                const float mine = butterfly16(pa, lane);
                float mx = mine;
                mx = fmaxf(mx, __shfl_xor(mx, 4)); mx = fmaxf(mx, __shfl_xor(mx, 8)); mx = fmaxf(mx, __shfl_xor(mx, 16)); mx = fmaxf(mx, __shfl_xor(mx, 32));
                const float ex = __expf(mine - mx);
                float sm = ex; sm += __shfl_xor(sm, 4); sm += __shfl_xor(sm, 8); sm += __shfl_xor(sm, 16); sm += __shfl_xor(sm, 32);
                if ((lane & 3) == 0) ((float*)(ws + WS_AFF))[((size_t)b * 16 + (lane >> 2)) * SEQ + t] = ex / sm;
            } }
    }
}

__device__ __forceinline__ void phase_topk(const Params& p, LAS unsigned char* lds) {
    unsigned char* ws = p.ws;
    const int tid = tid_opaque(), lane = tid & 63, w = __builtin_amdgcn_readfirstlane(tid >> 6);
    LAS int* wc = (LAS int*)lds;
    for (int item = blockIdx.x; item < 256; item += gridDim.x) {
        const int be = item >> 2, qtr = item & 3, b = be >> 4, e = be & 15;
        const float* aff = (const float*)(ws + WS_AFF) + (size_t)be * SEQ + tid * 16;
        unsigned u[16];
#pragma unroll
        for (int q = 0; q < 4; ++q) { const f32x4 v = *(const f32x4*)(aff + 4 * q); u[4 * q] = __float_as_uint(v.x); u[4 * q + 1] = __float_as_uint(v.y); u[4 * q + 2] = __float_as_uint(v.z); u[4 * q + 3] = __float_as_uint(v.w); }
        unsigned T = 0u; int par = 0;
        for (int bit = 30; bit >= -1; --bit) {
            const unsigned cand = (bit >= 0) ? (T | (1u << bit)) : (T + 1u);
            int c = 0;
#pragma unroll
            for (int i = 0; i < 16; ++i) c += (int)__popcll(__ballot(u[i] >= cand));
            if (lane == 0) wc[par * 8 + w] = c;
            __syncthreads();
            int tot = 0;
#pragma unroll
            for (int w2 = 0; w2 < 8; ++w2) tot += wc[par * 8 + w2];
            if (bit >= 0) { if (tot >= CAP) T = cand; } else wc[32] = tot;
            par ^= 1;
        }
        int ngt = 0, neq = 0;
#pragma unroll
        for (int i = 0; i < 16; ++i) { ngt += (u[i] > T) ? 1 : 0; neq += (u[i] == T) ? 1 : 0; }
        int pk = (ngt << 16) | neq, inc = pk;
#pragma unroll
        for (int o = 1; o < 64; o <<= 1) { const int t = __shfl_up(inc, o); if (lane >= o) inc += t; }
        if (lane == 63) wc[16 + w] = inc;
        __syncthreads();
        const int cgt = wc[32];
        int base = inc - pk;
#pragma unroll
        for (int w2 = 0; w2 < 8; ++w2) if (w2 < w) base += wc[16 + w2];
        int gtb = base >> 16, eqb = base & 0xffff; const int need_eq = CAP - cgt;
        if ((tid >> 7) == qtr) {
            int sl[16];
#pragma unroll
            for (int i = 0; i < 16; ++i) { int s_ = -1;
                if (u[i] > T) { s_ = gtb; ++gtb; } else if (u[i] == T) { if (eqb < need_eq) s_ = cgt + eqb; ++eqb; }
                sl[i] = s_;
                if (s_ >= 0) { const int mrow = (e * NB + b) * CAP + s_; ((int*)(ws + WS_ROWMAP))[mrow] = b * SEQ + tid * 16 + i; ((float*)(ws + WS_GATEV))[mrow] = __uint_as_float(u[i]); } }
            int* so = (int*)(ws + WS_SLOT) + (size_t)be * SEQ + tid * 16;
#pragma unroll
            for (int q = 0; q < 4; ++q) *(int4*)(so + 4 * q) = make_int4(sl[4 * q], sl[4 * q + 1], sl[4 * q + 2], sl[4 * q + 3]);
        }
        __syncthreads();
    }
}

__device__ __forceinline__ void phase_final(const Params& p) {
    unsigned char* ws = p.ws;
    const int tid = tid_opaque(), lane = tid & 63, wave = tid >> 6;
    const int gw = blockIdx.x * NWAVES + wave, NGW = gridDim.x * NWAVES;
    const float* mod = (const float*)(ws + WS_MOD);
    for (int blk = gw; blk < R_X / 16; blk += NGW) {
        const int xr0 = blk * 16, b = xr0 / SEQ, t0 = xr0 % SEQ;
        const int4 sl4 = *(const int4*)((const int*)(ws + WS_SLOT) + ((size_t)b * 16 + (lane & 15)) * SEQ + t0 + 4 * (lane >> 4));
#pragma unroll 1
        for (int rq = 0; rq < 4; ++rq)
#pragma unroll 1
            for (int rr = 0; rr < 4; ++rr) {
                const int xr = xr0 + rq * 4 + rr; const int myv = (rr == 0) ? sl4.x : (rr == 1) ? sl4.y : (rr == 2) ? sl4.z : sl4.w;
                float* row = p.out + (size_t)xr * D;
                f32x4 acc[4];
#pragma unroll
                for (int j = 0; j < 4; ++j) acc[j] = (f32x4){0.f, 0.f, 0.f, 0.f};
                for (int e = 0; e < 16; ++e) { const int sl = __shfl(myv, e + 16 * rq); if (sl < 0) continue;
                    const bf16* y = (const bf16*)(ws + WS_Y) + ((size_t)(e * NB + b) * CAP + sl) * D;
#pragma unroll
                    for (int j = 0; j < 4; ++j) { const u32x2 wv = *(const u32x2*)(y + j * 256 + lane * 4); acc[j].x += bflo(wv.x); acc[j].y += bfhi(wv.x); acc[j].z += bflo(wv.y); acc[j].w += bfhi(wv.y); } }
                f32x4 v[4]; float ss = 0.f;
#pragma unroll
                for (int j = 0; j < 4; ++j) { const int c0 = j * 256 + lane * 4; const f32x4 g2 = *(const f32x4*)(mod + (size_t)b * 6144 + 5120 + c0);
                    v[j] = *(const f32x4*)(row + c0) + g2 * acc[j]; ss += (v[j].x * v[j].x + v[j].y * v[j].y) + (v[j].z * v[j].z + v[j].w * v[j].w); }
                const float rstd = rsqrtf(wave_sum(ss) * (1.0f / D) + EPS);
#pragma unroll
                for (int j = 0; j < 4; ++j) { const int c0 = j * 256 + lane * 4; const f32x4 fw = *(const f32x4*)(p.final_w + c0); *(f32x4*)(row + c0) = v[j] * rstd * fw; }
            }
    }
}

#define XB_TMO      128
#define XB_XCNT(j)  (256  + 64 * (j))
#define XB_XSUB(j)  (1280 + 64 * (j))
#define XB_XGEN(j)  (2304 + 64 * (j))
#define XB_TOP      3328
#define XB_TOPGEN   3392
#define XCD_BAR_WORDS 3456
#define XB_SPIN_CAP (1u << 20)
__device__ __forceinline__ unsigned xb_ld(unsigned* p)              { return __hip_atomic_load(p, __ATOMIC_RELAXED, __HIP_MEMORY_SCOPE_AGENT); }
__device__ __forceinline__ unsigned xb_add(unsigned* p, unsigned v) { return __hip_atomic_fetch_add(p, v, __ATOMIC_RELAXED, __HIP_MEMORY_SCOPE_AGENT); }
__device__ __forceinline__ unsigned xb_xcc_id() { return (unsigned)__builtin_amdgcn_s_getreg((3 << 11) | 20) & 0xFu; }
#define XB_SPIN(cond, bar) do { unsigned _sp = 0; while (cond) { __builtin_amdgcn_s_sleep(1); \
    if ((++_sp & 255u) == 0u) { if (xb_ld(&(bar)[XB_TMO])) break; if (_sp > XB_SPIN_CAP) { atomicAdd(&(bar)[XB_TMO], 1u); break; } } } } while (0)
struct XcdBarrier { unsigned* bar; unsigned x; volatile LAS unsigned* st; };
__device__ __forceinline__ XcdBarrier xcd_barrier_post(unsigned* bar, volatile LAS unsigned* st) {
    XcdBarrier b; b.bar = bar; b.x = xb_xcc_id(); b.st = st;
    if (threadIdx.x == 0) (void)xb_add(&bar[XB_XCNT(b.x)], 1u);
    return b;
}
__device__ __forceinline__ void xcd_barrier_complete(unsigned* bar, unsigned x, unsigned& nloc, unsigned& nx) {
    const unsigned G = gridDim.x * gridDim.y * gridDim.z;
    unsigned sum, cnt, mine, sp = 0u;
    for (;;) {
        sum = 0u; cnt = 0u; mine = 0u;
#pragma unroll
        for (unsigned j = 0; j < 16; ++j) { const unsigned c = xb_ld(&bar[XB_XCNT(j)]); sum += c; cnt += (c > 0u) ? 1u : 0u; mine = (j == x) ? c : mine; }
        if (sum == G) break;
        __builtin_amdgcn_s_sleep(1);
        if ((++sp & 255u) == 0u) { if (xb_ld(&bar[XB_TMO])) break; if (sp > XB_SPIN_CAP) { atomicAdd(&bar[XB_TMO], 1u); break; } }
    }
    nloc = mine > 0u ? mine : 1u; nx = cnt > 0u ? cnt : 1u;
}
__device__ __forceinline__ void xcd_barrier(const XcdBarrier& b) {
    asm volatile("s_waitcnt vmcnt(0)" ::: "memory");
    __syncthreads();
    if (threadIdx.x == 0) {
        unsigned* bar = b.bar;
        __builtin_amdgcn_s_waitcnt(0);
        unsigned nloc = b.st[0], nx = b.st[1];
        if (nloc == 0u) { xcd_barrier_complete(bar, b.x, nloc, nx); b.st[0] = nloc; b.st[1] = nx; }
        const unsigned old = xb_add(&bar[XB_XSUB(b.x)], 1u);
        const unsigned gen = old / nloc;
        if (old + 1u == (gen + 1u) * nloc) {
            __builtin_amdgcn_fence(__ATOMIC_RELEASE, "agent");
            asm volatile("s_waitcnt vmcnt(0)" ::: "memory");
            const unsigned og = xb_add(&bar[XB_TOP], 1u);
            const unsigned tg = og / nx;
            if (og + 1u == (tg + 1u) * nx) xb_add(&bar[XB_TOPGEN], 1u);
            else XB_SPIN(xb_ld(&bar[XB_TOPGEN]) == tg, bar);
            __builtin_amdgcn_fence(__ATOMIC_ACQUIRE, "agent");
            xb_add(&bar[XB_XGEN(b.x)], 1u);
            asm volatile("s_waitcnt vmcnt(0)" ::: "memory");
        } else {
            XB_SPIN(xb_ld(&bar[XB_XGEN(b.x)]) == gen, bar);
            __builtin_amdgcn_fence(__ATOMIC_ACQUIRE, "agent");
            asm volatile("s_waitcnt vmcnt(0)" ::: "memory");
        }
    }
    __syncthreads();
}

constexpr int MISC_OFF = LDS_BYTES - 256;
constexpr int CW_BAR = 4096;
constexpr size_t CTL_ZERO_BYTES = 65536;
constexpr unsigned REPEAT_MASK = 0x0u;
constexpr int PB_FILTER = 0;
constexpr int U_ABL = 0;

__global__ void __launch_bounds__(NTHR, 2) mega_fwd(Params p) {
    extern __shared__ __attribute__((aligned(16))) unsigned char lds_raw[];
    LAS unsigned char* lds = (LAS unsigned char*)lds_raw;
    for (int u = threadIdx.x; u < 64; u += NTHR) ((LAS unsigned*)(lds + MISC_OFF))[u] = 0u;
    __syncthreads();
    XcdBarrier bar = xcd_barrier_post((unsigned*)(p.ws + WS_CTL) + CW_BAR, (volatile LAS unsigned*)(lds + MISC_OFF) + 8);
#define GRID_BAR() xcd_barrier(bar)
#define PHASE(k, ...) for (int rep_ = 0; rep_ <= (int)((REPEAT_MASK >> (k)) & 1u); ++rep_) { __VA_ARGS__; GRID_BAR(); }
    PHASE(0, phase_prologue(p, lds))
    PHASE(1, phase_u(p, lds, rep_ == 1 ? U_ABL : 0))
    PHASE(2, { pg8::Gemm g{(const bf16*)(p.ws + WS_U), (const bf16*)(p.ws + WS_WIN_T), D, nullptr}; pg8::StaticOrder S; S.init(R_ALL, NPROJ, gridDim.x, blockIdx.x);
        pg8::EpiInProj E{p.ws, (const float*)(p.ws + WS_LB)};
        pg8::gemm_phase<pg8::EpiInProj, pg8::StaticOrder, true, false>(lds, g, S, E); })
    PHASE(3, phase_conv(p))
    PHASE(4, for (int item = blockIdx.x; item < 256; item += gridDim.x) { if (rep_ == 1 && PB_FILTER != 0 && ((item >> 7) + 1) != PB_FILTER) continue; sc::pass_a(p, lds, item); })
    PHASE(5, for (int item = blockIdx.x; item < 256; item += gridDim.x) { if (rep_ == 1 && PB_FILTER != 0 && ((item >> 7) + 1) != PB_FILTER) continue; sc::pass_b(p, lds, item); })
    PHASE(6, phase_mixprep(p))
    PHASE(7, { pg8::Gemm g{(const bf16*)(p.ws + WS_AMIX2), (const bf16*)(p.ws + WS_WOUT_T), D, nullptr}; pg8::StaticOrder S; S.init(R_X, D, gridDim.x, blockIdx.x);
        pg8::EpiOutProj E{p.x, p.out, (const float*)(p.ws + WS_MOD)};
        pg8::gemm_phase<pg8::EpiOutProj, pg8::StaticOrder, true, false>(lds, g, S, E); })
    PHASE(8, phase_vx(p, lds))
    PHASE(9, phase_topk(p, lds))
    PHASE(10, for (int w = blockIdx.x; w < 256; w += gridDim.x) {
        const int xcd = w & 7, idx = w >> 3, e = xcd * 2 + (idx >> 4), pm = e * 16 + (idx & 15);
        {   pg8::Gemm g{(const bf16*)(p.ws + WS_VX), (const bf16*)(p.ws + WS_WGU_T), D, (const int*)(p.ws + WS_ROWMAP)};
            pg8::PanelOrder S{pm, 8, (size_t)e * 2048 * 1024 * 2}; pg8::EpiMoE1 E{(bf16*)(p.ws + WS_H)};
            pg8::gemm_phase<pg8::EpiMoE1, pg8::PanelOrder, true, true>(lds, g, S, E); }
        VM_WAIT(); __syncthreads();
        if (threadIdx.x == 0) { __builtin_amdgcn_fence(__ATOMIC_ACQUIRE, "agent"); VM_WAIT(); }
        __syncthreads();
        {   pg8::Gemm g{(const bf16*)(p.ws + WS_H), (const bf16*)(p.ws + WS_WD_T), FF, nullptr};
            pg8::PanelOrder S{pm, 4, (size_t)e * 1024 * 1024 * 2}; pg8::EpiMoE2 E{(bf16*)(p.ws + WS_Y), (const float*)(p.ws + WS_GATEV)};
            pg8::gemm_phase<pg8::EpiMoE2, pg8::PanelOrder, true, false>(lds, g, S, E); }
    })
    phase_final(p);
}

extern "C" void kernel_launch(void* const* d_in, const int* in_sizes, int n_in, void* d_out, int out_size, void* d_ws, size_t ws_size, hipStream_t stream) {
    static int grid = 0;
    if (grid == 0) {
        if (n_in != 21 || out_size != R_X * D || ws_size < WS_END) { fprintf(stderr, "kernel_launch: unexpected shapes: n_in %d out %d ws %zu\n", n_in, out_size, ws_size); grid = -1; return; }
        int dev = 0, cus = 0, per_cu = 0;
        if (hipGetDevice(&dev) != hipSuccess || hipDeviceGetAttribute(&cus, hipDeviceAttributeMultiprocessorCount, dev) != hipSuccess) { grid = -1; return; }
        if (hipFuncSetAttribute((const void*)mega_fwd, hipFuncAttributeMaxDynamicSharedMemorySize, LDS_BYTES) != hipSuccess) { fprintf(stderr, "kernel_launch: hipFuncSetAttribute failed\n"); grid = -1; return; }
        if (hipOccupancyMaxActiveBlocksPerMultiprocessor(&per_cu, (const void*)mega_fwd, NTHR, LDS_BYTES) != hipSuccess || per_cu < 1) { fprintf(stderr, "kernel_launch: occupancy query says %d blocks/CU; nothing launched\n", per_cu); (void)hipGetLastError(); grid = -1; return; }
        grid = cus;
    }
    if (grid < 0) return;
    (void)hipMemsetAsync((char*)d_ws + WS_CTL, 0, CTL_ZERO_BYTES, stream);
    Params p{};
    const float** pp = (const float**)&p;
    for (int i = 0; i < 21; ++i) pp[i] = (const float*)d_in[i];
    p.out = (float*)d_out; p.ws = (unsigned char*)d_ws;
    hipLaunchKernelGGL(mega_fwd, dim3(grid), dim3(NTHR), LDS_BYTES, stream, p);
}
```

```cpp
#include <hip/hip_runtime.h>
#include <cstdio>
#include <cstdint>

#define GAS __attribute__((address_space(1)))
#define LAS __attribute__((address_space(3)))
typedef unsigned short bf16;
typedef float f32x4 __attribute__((ext_vector_type(4)));
typedef float f32x2 __attribute__((ext_vector_type(2)));
typedef unsigned u32x4 __attribute__((ext_vector_type(4)));
typedef unsigned u32x2 __attribute__((ext_vector_type(2)));
typedef short bf16x8 __attribute__((ext_vector_type(8)));
typedef __bf16 bf16x2_t __attribute__((ext_vector_type(2)));
typedef _Float16 f16x2_t __attribute__((ext_vector_type(2)));

constexpr int D = 1024, NB = 4, SEQ = 8192, CTX = 256, SROW = SEQ + CTX, R_ALL = NB * SROW, R_X = NB * SEQ;
constexpr int PROJ = 4624, NPROJ = 4608;
constexpr int NE = 16, CAP = 1024, FF = 1024, R_MOE = NE * NB * CAP;
constexpr float EPS = 1e-6f;
constexpr int NTHR = 512, NWAVES = 8;
constexpr int LDS_BYTES = 155648;
constexpr int OFP = 8192 + 16;
constexpr int PROF = 0, PROF_BLOCK = 0;

constexpr size_t MiB = 1u << 20;
constexpr size_t WS_CTL = 0;
constexpr size_t WS_MODP = 1 * MiB;
constexpr size_t WS_MOD = 3 * MiB;
constexpr size_t WS_LB = WS_MOD + 128 * 1024;
constexpr size_t WS_WGT = WS_LB + 4096;
constexpr size_t WS_RWT = WS_WGT + 65536;
constexpr size_t WS_WIN_T = 4 * MiB;
constexpr size_t WS_WOUT_T = 13 * MiB;
constexpr size_t WS_GATES = 15 * MiB;
constexpr size_t WS_WGU_T = 18 * MiB;
constexpr size_t WS_WD_T = 82 * MiB;
constexpr size_t WS_U = 114 * MiB;
constexpr size_t WS_HQ = 180 * MiB;
constexpr size_t WS_HV = 213 * MiB;
constexpr size_t WS_HG = 246 * MiB;
constexpr size_t WS_LF = 279 * MiB;
constexpr size_t WS_QK = 345 * MiB;
constexpr size_t WS_MV = 411 * MiB;
constexpr size_t WS_MO = 444 * MiB;
constexpr size_t WS_DELTA = 436 * MiB;
constexpr size_t WS_AFF = 507 * MiB;
constexpr size_t WS_ROWMAP = 509 * MiB;
constexpr size_t WS_GATEV = WS_ROWMAP + 262144;
constexpr size_t WS_SLOT = 510 * MiB;
constexpr size_t WS_SEG = 477 * MiB;
constexpr size_t WS_SCB = WS_SEG + 512 * 66560;
constexpr size_t WS_SCG = WS_SCB + 32 * 8448 * 4;
constexpr size_t WS_SCM = WS_SCG + 32 * 8448 * 4;
constexpr size_t WS_END = 512 * MiB;
constexpr size_t WS_QKC = WS_U;
constexpr size_t WS_OF = WS_QK;
static_assert(WS_SCM + 32 * 132 * 4 <= 512 * MiB, "scan scalars inside the workspace");
static_assert((size_t)32 * 8208 * 256 <= 66 * MiB, "OF fits the pre-conv q|k region");
constexpr size_t WS_VX = WS_U;
constexpr size_t WS_H = WS_HQ;
constexpr size_t WS_Y = 308 * MiB;

struct Params {
    const float *x, *c, *ctx, *c_ctx, *ada_w, *ada_b, *norm1_w, *w_in, *conv_w, *conv_b, *lb_logits, *ml_gate_b, *hg_norm_w, *ml_norm_w, *w_out, *norm2_w,
        *router_w, *wg, *wu, *wd, *final_w;
    float* out; unsigned char* ws;
};

__device__ __forceinline__ unsigned pk2(float lo, float hi) { f32x2 v = {lo, hi}; bf16x2_t b = __builtin_convertvector(v, bf16x2_t); return __builtin_bit_cast(unsigned, b); }
__device__ __forceinline__ unsigned pkh2(float lo, float hi) { f32x2 v = {lo, hi}; f16x2_t b = __builtin_convertvector(v, f16x2_t); return __builtin_bit_cast(unsigned, b); }
__device__ __forceinline__ float bf2f(unsigned short b) { return __uint_as_float((unsigned)b << 16); }
__device__ __forceinline__ float bflo(unsigned w) { return __uint_as_float(w << 16); }
__device__ __forceinline__ float bfhi(unsigned w) { return __uint_as_float(w & 0xffff0000u); }
__device__ __forceinline__ float h2f(unsigned short h) { return (float)__builtin_bit_cast(_Float16, h); }
__device__ __forceinline__ float sigmoid_(float x) { return __builtin_amdgcn_rcpf(1.0f + __expf(-x)); }
__device__ __forceinline__ float silu_(float x) { return x * sigmoid_(x); }
__device__ __forceinline__ float wave_sum(float v) {
#pragma unroll
    for (int o = 1; o < 64; o <<= 1) v += __shfl_xor(v, o);
    return v;
}
__device__ __forceinline__ int tid_opaque() { int t = threadIdx.x; asm volatile("" : "+v"(t)); return t; }
__device__ __forceinline__ float butterfly16(const float (&a)[16], int lane) {
    const bool h5 = (lane & 32) != 0, h4 = (lane & 16) != 0, h3 = (lane & 8) != 0, h2 = (lane & 4) != 0;
    float b8[8], b4[4], b2[2];
#pragma unroll
    for (int e = 0; e < 8; ++e) { const float keep = h5 ? a[e + 8] : a[e], send = h5 ? a[e] : a[e + 8]; b8[e] = keep + __shfl_xor(send, 32); }
#pragma unroll
    for (int e = 0; e < 4; ++e) { const float keep = h4 ? b8[e + 4] : b8[e], send = h4 ? b8[e] : b8[e + 4]; b4[e] = keep + __shfl_xor(send, 16); }
#pragma unroll
    for (int e = 0; e < 2; ++e) { const float keep = h3 ? b4[e + 2] : b4[e], send = h3 ? b4[e] : b4[e + 2]; b2[e] = keep + __shfl_xor(send, 8); }
    const float keep = h2 ? b2[1] : b2[0], send = h2 ? b2[0] : b2[1];
    float r = keep + __shfl_xor(send, 4);
    r += __shfl_xor(r, 2); r += __shfl_xor(r, 1);
    return r;
}
#define LDS_WAIT() asm volatile("s_waitcnt lgkmcnt(0)" ::: "memory")
#define VM_WAIT() asm volatile("s_waitcnt vmcnt(0)" ::: "memory")

namespace pg8 {
constexpr int BM = 256, BK = 64, HALF = 128, HTB = HALF * BK * 2, STAGE_BYTES = 8 * HTB, NXCD = 8, WGM = 8;
__host__ __device__ __forceinline__ int lds_byte(int r, int c) { const int st = (r >> 4) * 2 + (c >> 5), rr = r & 15, cc = c & 31, ob = rr * 64 + cc * 2; return st * 1024 + (ob ^ (((ob >> 9) & 1) << 5)); }
__host__ __device__ __forceinline__ void stage_rc(int b, int& R, int& C) { const int st = b / 1024, sb = b % 1024, swz = sb ^ (((sb >> 9) & 1) << 5); R = (st >> 1) * 16 + swz / 64; C = (st & 1) * 32 + (swz % 64) / 2; }
__host__ __device__ __forceinline__ int perm32(int rho) { const int n = rho >> 4, i = rho & 15; return 8 * (i >> 2) + 4 * n + (i & 3); }

struct Unit { int pm, pn; size_t boff; };
struct Gemm { const bf16* A; const bf16* Bt; int K; const int* rowmap; };

struct StaticOrder {
    int nM, nN, nwg, G, c;
    __device__ void init(int M, int N, int G_, int c_) { nM = M / BM; nN = N / BM; nwg = nM * nN; G = G_; c = c_; }
    __device__ bool next(int i, Unit& u) const {
        const long L = (long)i * G + c; if (L >= nwg) return false;
        int wgid = (int)L; { const int q = nwg / NXCD, r = nwg % NXCD, xcd = wgid % NXCD, off = wgid / NXCD; wgid = (xcd < r ? xcd * (q + 1) : r * (q + 1) + (xcd - r) * q) + off; }
        const int nig = WGM * nN, gid = wgid / nig, fm = gid * WGM, gsz = (nM - fm) < WGM ? (nM - fm) : WGM;
        u.pm = fm + ((wgid % nig) % gsz); u.pn = (wgid % nig) / gsz; u.boff = 0; return true;
    }
};
struct PanelOrder {
    int pm, npn; size_t boff;
    __device__ bool next(int i, Unit& u) const { if (i >= npn) return false; u.pm = pm; u.pn = i; u.boff = boff; return true; }
};

template <class Epi, class Sched, bool ALIGN_EPI, int AMODE>
__device__ __forceinline__ void gemm_phase(LAS unsigned char* lds, const Gemm g, const Sched& S, const Epi& E) {
    const int tid = tid_opaque(), wid = __builtin_amdgcn_readfirstlane(tid >> 6), lane = tid & 63, wr = wid >> 2, wc = wid & 3, fr = lane & 15, fq = lane >> 4;
    const int K = g.K, nt = K / BK;
    Unit cur, nxt; int ui = 0;
    if (!S.next(0, cur)) return;
    const size_t kstep = (size_t)(BK * 2);
    const size_t hstep = (size_t)HALF * K * 2;
    const size_t tstep = 2 * hstep;
    unsigned voffA[2][2], voffB[2];
#pragma unroll
    for (int i = 0; i < 2; ++i) { int R, C; stage_rc(tid * 16 + i * 8192, R, C); const int Rb = Epi::PERM ? ((R & ~31) + perm32(R & 31)) : R;
        voffB[i] = (unsigned)(Rb * K + C) * 2u;
#pragma unroll
        for (int h = 0; h < 2; ++h) {
            if (AMODE == 1) voffA[h][i] = (unsigned)g.rowmap[cur.pm * BM + h * HALF + R] * (unsigned)(K * 2) + (unsigned)C * 2u;
            else if (AMODE == 2) voffA[h][i] = (unsigned)((h * HALF + R) * 128 + C) * 2u;
            else voffA[h][i] = (unsigned)(R * K + C) * 2u + (unsigned)(h * hstep);
        } }
    const unsigned ldsw = (unsigned)wid * 1024u;
    const int aoff = lds_byte(wr * 64 + fr, fq * 8), boff = lds_byte(wc * 32 + fr, fq * 8);
#define PG8_SA(b, h) (((b) * 2 + (h)) * HTB)
#define PG8_SB(b, h) ((4 + (b) * 2 + (h)) * HTB)
#define PG8_STAGE_A(bufoff, gbase, h) do { _Pragma("unroll") for (int _i = 0; _i < 2; ++_i) \
        __builtin_amdgcn_global_load_lds((const unsigned*)((const char*)(gbase) + voffA[h][_i]), (LAS unsigned*)(lds + (bufoff) + ldsw + _i * 8192), 16, 0, 0); } while (0)
#define PG8_STAGE_B(bufoff, gbase) do { _Pragma("unroll") for (int _i = 0; _i < 2; ++_i) \
        __builtin_amdgcn_global_load_lds((const unsigned*)((const char*)(gbase) + voffB[_i]), (LAS unsigned*)(lds + (bufoff) + ldsw + _i * 8192), 16, 0, 0); } while (0)
#define PG8_LDA(dst, b, h) do { _Pragma("unroll") for (int m = 0; m < 4; ++m) _Pragma("unroll") for (int k = 0; k < 2; ++k) dst[m][k] = *(const LAS bf16x8*)(lds + PG8_SA(b, h) + aoff + m * 2048 + k * 1024); } while (0)
#define PG8_LDB(dst, b, h) do { _Pragma("unroll") for (int n = 0; n < 2; ++n) _Pragma("unroll") for (int k = 0; k < 2; ++k) dst[n][k] = *(const LAS bf16x8*)(lds + PG8_SB(b, h) + boff + n * 2048 + k * 1024); } while (0)
#define PG8_MMA(ai, bj, At, Bt) do { __builtin_amdgcn_s_setprio(1); _Pragma("unroll") for (int m = 0; m < 4; ++m) _Pragma("unroll") for (int n = 0; n < 2; ++n) _Pragma("unroll") for (int k = 0; k < 2; ++k) \
        acc[ai][bj][m][n] = __builtin_amdgcn_mfma_f32_16x16x32_bf16(Bt[n][k], At[m][k], acc[ai][bj][m][n], 0, 0, 0); __builtin_amdgcn_s_setprio(0); } while (0)
#define PG8_WAIT_V(n) asm volatile("s_waitcnt vmcnt(" #n ")" ::: "memory")
#define PG8_WAIT_L(n) asm volatile("s_waitcnt lgkmcnt(" #n ")" ::: "memory")
#define PG8_BAR __builtin_amdgcn_s_barrier()
#define PG8_SCHED __builtin_amdgcn_sched_barrier(0)
    f32x4 acc[2][2][4][2];
#pragma unroll
    for (int a = 0; a < 2; ++a)
#pragma unroll
        for (int b = 0; b < 2; ++b)
#pragma unroll
            for (int m = 0; m < 4; ++m)
#pragma unroll
                for (int n = 0; n < 2; ++n) acc[a][b][m][n] = (f32x4){0.f, 0.f, 0.f, 0.f};
    bf16x8 At[4][2], B0[2][2], B1[2][2];
#define PG8_ABASE(pm_) (AMODE == 1 ? (const char*)g.A : AMODE == 2 ? (const char*)g.A + ((size_t)((pm_) / 32) * 4 * OFP + (size_t)((pm_) % 32) * BM) * 256 : (const char*)g.A + (size_t)(pm_) * tstep)
#define PG8_AOFF(kt_) (AMODE == 2 ? (size_t)((kt_) >> 3) * ((size_t)16 * OFP * 256) + (size_t)(((kt_) >> 1) & 3) * ((size_t)OFP * 256) + (size_t)((kt_) & 1) * 128 : (size_t)(kt_) * kstep)
    const char* cA = PG8_ABASE(cur.pm);
    const char* cB = (const char*)g.Bt + cur.boff + (size_t)cur.pn * tstep;
    if (AMODE == 1) VM_WAIT();
    PG8_STAGE_B(PG8_SB(0, 0), cB); PG8_STAGE_B(PG8_SB(0, 1), cB + hstep); PG8_STAGE_A(PG8_SA(0, 0), cA, 0); PG8_STAGE_A(PG8_SA(0, 1), cA, 1);
    if (wr == 1) PG8_BAR;
    PG8_WAIT_V(2); PG8_BAR;
    PG8_STAGE_B(PG8_SB(1, 0), cB + kstep); PG8_STAGE_A(PG8_SA(1, 0), cA + PG8_AOFF(1), 0); PG8_STAGE_B(PG8_SB(1, 1), cB + hstep + kstep);
    PG8_WAIT_V(6); PG8_BAR;
    for (;;) {
        const bool has_next = S.next(ui + 1, nxt);
        const char* nA = has_next ? PG8_ABASE(nxt.pm) : cA;
        const char* nB = has_next ? (const char*)g.Bt + nxt.boff + (size_t)nxt.pn * tstep : cB;
        for (int t = 0; t < nt; t += 2) {
            const bool last = (t == nt - 2);
            const char* a1 = cA + PG8_AOFF(t + 1);
            const char* a2 = last ? nA : cA + PG8_AOFF(t + 2); const char* b2 = last ? nB : cB + (size_t)(t + 2) * kstep;
            const char* a3 = last ? nA + PG8_AOFF(1) : cA + PG8_AOFF(t + 3); const char* b3 = b2 + kstep;
            PG8_LDB(B0, 0, 0); PG8_LDB(B1, 0, 1); PG8_SCHED; PG8_LDA(At, 0, 0); PG8_STAGE_A(PG8_SA(1, 1), a1, 1);
            PG8_WAIT_V(8); PG8_WAIT_L(0); PG8_BAR; PG8_MMA(0, 0, At, B0); PG8_MMA(0, 1, At, B1); PG8_BAR; PG8_SCHED;
            PG8_LDA(At, 0, 1); PG8_STAGE_B(PG8_SB(0, 0), b2); PG8_STAGE_B(PG8_SB(0, 1), b2 + hstep); PG8_STAGE_A(PG8_SA(0, 0), a2, 0);
            PG8_WAIT_V(8); PG8_WAIT_L(0); PG8_BAR; PG8_MMA(1, 0, At, B0); PG8_MMA(1, 1, At, B1); PG8_BAR; PG8_SCHED;
            PG8_LDB(B0, 1, 0); PG8_LDB(B1, 1, 1); PG8_SCHED; PG8_LDA(At, 1, 0); PG8_STAGE_A(PG8_SA(0, 1), a2, 1);
            PG8_WAIT_V(8); PG8_WAIT_L(0); PG8_BAR; PG8_MMA(0, 0, At, B0); PG8_MMA(0, 1, At, B1); PG8_BAR; PG8_SCHED;
            PG8_LDA(At, 1, 1); PG8_STAGE_B(PG8_SB(1, 0), b3); PG8_STAGE_B(PG8_SB(1, 1), b3 + hstep); PG8_STAGE_A(PG8_SA(1, 0), a3, 0);
            PG8_WAIT_V(8); PG8_WAIT_L(0); PG8_BAR; PG8_MMA(1, 0, At, B0); PG8_MMA(1, 1, At, B1); PG8_BAR; PG8_SCHED;
        }
        if constexpr (ALIGN_EPI) { if (wr == 0) PG8_BAR; }
        E(acc, cur, wr, wc, fr, fq);
        if (!has_next) break;
#pragma unroll
        for (int a = 0; a < 2; ++a)
#pragma unroll
            for (int b = 0; b < 2; ++b)
#pragma unroll
                for (int m = 0; m < 4; ++m)
#pragma unroll
                    for (int n = 0; n < 2; ++n) acc[a][b][m][n] = (f32x4){0.f, 0.f, 0.f, 0.f};
        cur = nxt; cA = nA; cB = nB; ++ui;
        if constexpr (ALIGN_EPI) { if (wr == 1) PG8_BAR; }
    }
    PG8_WAIT_V(0);
    if constexpr (!ALIGN_EPI) { if (wr == 0) PG8_BAR; }
    PG8_BAR;
#undef PG8_SA
#undef PG8_SB
#undef PG8_ABASE
#undef PG8_AOFF
#undef PG8_STAGE_A
#undef PG8_STAGE_B
#undef PG8_LDA
#undef PG8_LDB
#undef PG8_MMA
#undef PG8_WAIT_V
#undef PG8_WAIT_L
#undef PG8_BAR
#undef PG8_SCHED
}

struct EpiInProj {
    static constexpr bool PERM = true;
    unsigned char* ws; const float* lb;
    __device__ __forceinline__ void operator()(const f32x4 (&acc)[2][2][4][2], const Unit& u, int wr, int wc, int fr_, int fq) const {
        int fr = fr_; asm volatile("" : "+v"(fr));
        const int pn = u.pn; size_t base; int ld, colbase, act, hm;
        if (pn < 2) { base = WS_HQ; ld = 512; colbase = pn * 256; act = 1; hm = 1; }
        else if (pn < 4) { base = WS_HV; ld = 512; colbase = (pn - 2) * 256; act = 0; hm = 1; }
        else if (pn < 6) { base = WS_HG; ld = 512; colbase = (pn - 4) * 256; act = 1; hm = 0; }
        else if (pn < 10) { base = WS_LF; ld = 1024; colbase = (pn - 6) * 256; act = 3; hm = 2; }
        else if (pn < 14) { base = WS_QK; ld = 1024; colbase = (pn - 10) * 256; act = 0; hm = 0; }
        else if (pn < 16) { base = WS_MV; ld = 512; colbase = (pn - 14) * 256; act = 0; hm = 1; }
        else { base = WS_MO; ld = 512; colbase = (pn - 16) * 256; act = 2; hm = 0; }
        bf16* O = (bf16*)(ws + base);
        const int bb = u.pm / 33, s0 = (u.pm % 33) * BM + wr * 64 + fr;
        const int row0 = u.pm * BM + wr * 64 + fr, col0 = colbase + wc * 32 + 8 * fq;
#pragma unroll
        for (int bj = 0; bj < 2; ++bj) {
            float lbv[8];
            const int cf = col0 + bj * HALF;
            if (act == 3) {
#pragma unroll
                for (int e = 0; e < 8; ++e) lbv[e] = lb[cf + e];
            }
            const size_t hbase = (hm == 2) ? ((size_t)((bb * 2 + (cf >> 9)) * 4 + ((cf >> 7) & 3)) * SROW) : ((size_t)(bb * 4 + (cf >> 7)) * SROW);
#pragma unroll
            for (int ai = 0; ai < 2; ++ai)
#pragma unroll
                for (int m = 0; m < 4; ++m) {
                    float v[8];
#pragma unroll
                    for (int e = 0; e < 4; ++e) { v[e] = acc[ai][bj][m][0][e]; v[4 + e] = acc[ai][bj][m][1][e]; }
                    u32x4 w;
                    if (act == 3) {
#pragma unroll
                        for (int e = 0; e < 8; ++e) v[e] = __log2f(lbv[e] + (1.0f - lbv[e]) * sigmoid_(v[e]));
                        w.x = pkh2(v[0], v[1]); w.y = pkh2(v[2], v[3]); w.z = pkh2(v[4], v[5]); w.w = pkh2(v[6], v[7]);
                    } else {
                        if (act == 1) {
#pragma unroll
                            for (int e = 0; e < 8; ++e) v[e] = silu_(v[e]);
                        } else if (act == 2) {
#pragma unroll
                            for (int e = 0; e < 8; ++e) v[e] = sigmoid_(v[e]);
                        }
                        w.x = pk2(v[0], v[1]); w.y = pk2(v[2], v[3]); w.z = pk2(v[4], v[5]); w.w = pk2(v[6], v[7]);
                    }
                    const size_t off = hm ? (hbase + (size_t)(s0 + ai * HALF + m * 16)) * 128 + (cf & 127) : (size_t)(row0 + ai * HALF + m * 16) * ld + cf;
                    *(u32x4*)(O + off) = w;
                }
        }
    }
};
struct EpiOutProj {
    static constexpr bool PERM = true;
    bf16* delta; const float* mod;
    __device__ __forceinline__ void operator()(const f32x4 (&acc)[2][2][4][2], const Unit& u, int wr, int wc, int fr_, int fq) const {
        int fr = fr_; asm volatile("" : "+v"(fr));
        const int row0 = u.pm * BM + wr * 64 + fr, col0 = u.pn * BM + wc * 32 + 8 * fq;
        const float* g1 = mod + (size_t)(u.pm / 32) * 6144 + 2048;
#pragma unroll
        for (int bj = 0; bj < 2; ++bj) { const int c = col0 + bj * HALF; const f32x4 g0 = *(const f32x4*)(g1 + c), g4 = *(const f32x4*)(g1 + c + 4);
#pragma unroll
            for (int ai = 0; ai < 2; ++ai)
#pragma unroll
                for (int m = 0; m < 4; ++m) { const f32x4 a = acc[ai][bj][m][0] * g0, b = acc[ai][bj][m][1] * g4;
                    u32x4 w; w.x = pk2(a[0], a[1]); w.y = pk2(a[2], a[3]); w.z = pk2(b[0], b[1]); w.w = pk2(b[2], b[3]);
                    *(u32x4*)(delta + (size_t)(row0 + ai * HALF + m * 16) * D + c) = w; } }
    }
};
struct EpiMoE1 {
    static constexpr bool PERM = true;
    bf16* H;
    __device__ __forceinline__ void operator()(const f32x4 (&acc)[2][2][4][2], const Unit& u, int wr, int wc, int fr_, int fq) const {
        int fr = fr_; asm volatile("" : "+v"(fr));
        const int row0 = u.pm * BM + wr * 64 + fr, col0 = u.pn * HALF + wc * 32 + 8 * fq;
#pragma unroll
        for (int ai = 0; ai < 2; ++ai)
#pragma unroll
            for (int m = 0; m < 4; ++m) {
                float v[8];
#pragma unroll
                for (int e = 0; e < 4; ++e) { v[e] = silu_(acc[ai][0][m][0][e]) * acc[ai][1][m][0][e]; v[4 + e] = silu_(acc[ai][0][m][1][e]) * acc[ai][1][m][1][e]; }
                u32x4 w; w.x = pk2(v[0], v[1]); w.y = pk2(v[2], v[3]); w.z = pk2(v[4], v[5]); w.w = pk2(v[6], v[7]);
                *(u32x4*)(H + (size_t)(row0 + ai * HALF + m * 16) * FF + col0) = w;
            }
    }
};
struct EpiMoE2 {
    static constexpr bool PERM = true;
    bf16* Y; const float* gatev;
    __device__ __forceinline__ void operator()(const f32x4 (&acc)[2][2][4][2], const Unit& u, int wr, int wc, int fr_, int fq) const {
        int fr = fr_; asm volatile("" : "+v"(fr));
        const int row0 = u.pm * BM + wr * 64 + fr, col0 = u.pn * BM + wc * 32 + 8 * fq;
#pragma unroll
        for (int ai = 0; ai < 2; ++ai)
#pragma unroll
            for (int m = 0; m < 4; ++m) { const int row = row0 + ai * HALF + m * 16; const float gt = gatev[row];
#pragma unroll
                for (int bj = 0; bj < 2; ++bj) { const f32x4 a = acc[ai][bj][m][0] * gt, b = acc[ai][bj][m][1] * gt;
                    u32x4 w; w.x = pk2(a[0], a[1]); w.y = pk2(a[2], a[3]); w.z = pk2(b[0], b[1]); w.w = pk2(b[2], b[3]);
                    *(u32x4*)(Y + (size_t)row * D + col0 + bj * HALF) = w; } }
    }
};
}

__device__ __forceinline__ void transpose_item(const float* W, int ldw, int k0, int n0, bf16* dst_row0, LAS float* scr, int lane) {
#pragma unroll 8
    for (int i = 0; i < 32; ++i) { const int kk = 2 * i + (lane >> 5); scr[kk * 33 + (lane & 31)] = W[(size_t)(k0 + kk) * ldw + n0 + (lane & 31)]; }
    LDS_WAIT(); asm volatile("" ::: "memory");
    const int c = lane & 7;
#pragma unroll
    for (int j = 0; j < 4; ++j) { const int n = (lane >> 3) + 8 * j; const LAS float* s = scr + (8 * c) * 33 + n;
        u32x4 o; o.x = pk2(s[0 * 33], s[1 * 33]); o.y = pk2(s[2 * 33], s[3 * 33]); o.z = pk2(s[4 * 33], s[5 * 33]); o.w = pk2(s[6 * 33], s[7 * 33]);
        *(u32x4*)(dst_row0 + (size_t)n * 1024 + k0 + 8 * c) = o; }
    LDS_WAIT(); asm volatile("" ::: "memory");
}
__device__ __forceinline__ void phase_prologue(const Params& p, LAS unsigned char* lds) {
    const int tid = tid_opaque(), lane = tid & 63, wave = tid >> 6;
    const int gw = blockIdx.x * NWAVES + wave, NGW = gridDim.x * NWAVES;
    LAS float* scr = (LAS float*)(lds + wave * 16384);
    constexpr int I_IN = 16 * 144, I_OUT = 16 * 32, I_E = 16 * 512, I_MOD = 24 * 16;
    constexpr int NITEMS = I_IN + I_OUT + 3 * I_E + I_MOD;
    unsigned char* ws = p.ws;
    for (int it = gw; it < NITEMS; it += NGW) {
        int r = it;
        if (r < I_IN) { const int kb = r / 144, nb = r % 144; transpose_item(p.w_in, PROJ, kb * 64, nb * 32, (bf16*)(ws + WS_WIN_T) + (size_t)(nb * 32) * 1024, scr, lane); continue; } r -= I_IN;
        if (r < I_OUT) { const int kb = r / 32, nb = r % 32; transpose_item(p.w_out, D, kb * 64, nb * 32, (bf16*)(ws + WS_WOUT_T) + (size_t)(nb * 32) * 1024, scr, lane); continue; } r -= I_OUT;
        if (r < 2 * I_E) { const int up = r / I_E; r -= up * I_E; const int e = r / 512, q = r % 512, kb = q / 32, nb = q % 32, n0 = nb * 32;
            const int drow = (n0 / 128) * 256 + up * 128 + (n0 % 128);
            transpose_item((up ? p.wu : p.wg) + (size_t)e * D * FF, FF, kb * 64, n0, (bf16*)(ws + WS_WGU_T) + ((size_t)e * 2048 + drow) * 1024, scr, lane); continue; } r -= 2 * I_E;
        if (r < I_E) { const int e = r / 512, q = r % 512, kb = q / 32, nb = q % 32;
            transpose_item(p.wd + (size_t)e * FF * D, D, kb * 64, nb * 32, (bf16*)(ws + WS_WD_T) + ((size_t)e * 1024 + nb * 32) * 1024, scr, lane); continue; } r -= I_E;
        {
            const int cb = r / 16, ks = r % 16; const int col = cb * 256 + lane * 4;
            f32x4 a[5];
            float sv[5];
#pragma unroll
            for (int q = 0; q < 5; ++q) { a[q] = (f32x4){0.f, 0.f, 0.f, 0.f}; const float cv = (q < 4) ? p.c[q * D + ks * 64 + lane] : p.c_ctx[ks * 64 + lane]; sv[q] = silu_(cv); }
#pragma unroll 8
            for (int kk = 0; kk < 64; ++kk) {
                const f32x4 w = *(const f32x4*)(p.ada_w + (size_t)(ks * 64 + kk) * 6144 + col);
#pragma unroll
                for (int q = 0; q < 5; ++q) a[q] += w * __uint_as_float((unsigned)__builtin_amdgcn_readlane((int)__float_as_uint(sv[q]), kk));
            }
            float* mp = (float*)(ws + WS_MODP);
#pragma unroll
            for (int q = 0; q < 5; ++q) *(f32x4*)(mp + ((size_t)ks * 5 + q) * 6144 + col) = a[q];
        }
    }
    const int gt = blockIdx.x * NTHR + tid, NGT = gridDim.x * NTHR;
    for (int i = gt; i < 1024; i += NGT) { const float l0 = p.lb_logits[i], l1 = p.lb_logits[1024 + i]; ((float*)(ws + WS_LB))[i] = 1.0f / (1.0f + __expf(l1 - l0)); }
    for (int i = gt; i < 16 * 1024; i += NGT) { const int g = i >> 10, k = i & 1023; ((float*)(ws + WS_WGT))[i] = p.w_in[(size_t)k * PROJ + NPROJ + g]; ((float*)(ws + WS_RWT))[i] = p.router_w[k * 16 + g]; }
}

__device__ __forceinline__ void phase_u(const Params& p, LAS unsigned char* lds, int abl = 0) {
    const int tid = tid_opaque(), lane = tid & 63, wave = tid >> 6;
    unsigned char* ws = p.ws;
    LAS float* Lsh = (LAS float*)lds;
    LAS float* Lsc = Lsh + 5 * 1024;
    LAS float* Lnw = Lsc + 5 * 1024;
    LAS float* Lwg = Lnw + 1024;
    const float* modp = (const float*)(ws + WS_MODP);
    const int rpw = (R_ALL + (int)gridDim.x - 1) / (int)gridDim.x, rbeg = (int)blockIdx.x * rpw, rend = (rbeg + rpw < R_ALL) ? rbeg + rpw : R_ALL;
    for (int r = 0; r < 5; ++r) {
        bool need = false;
        if (rbeg < rend) { const int b0 = rbeg / SROW, b1 = (rend - 1) / SROW;
            for (int bb = b0; bb <= b1; ++bb) { const int lo = (rbeg > bb * SROW) ? rbeg : bb * SROW, hi = (rend < (bb + 1) * SROW) ? rend : (bb + 1) * SROW;
                if (r == 4) need = need || (lo < bb * SROW + CTX && lo < hi); else need = need || (r == bb && hi > bb * SROW + CTX && lo < hi); } }
        if (!need) continue;
        float pt[4][16];
#pragma unroll
        for (int k = 0; k < 4; ++k)
#pragma unroll
            for (int ks = 0; ks < 16; ++ks) pt[k][ks] = modp[((size_t)ks * 5 + r) * 6144 + tid + 512 * k];
#pragma unroll
        for (int k = 0; k < 4; ++k) { const int col = tid + 512 * k; float sm = p.ada_b[col];
#pragma unroll
            for (int ks = 0; ks < 16; ++ks) sm += pt[k][ks];
            if (col < 1024) Lsh[r * 1024 + col] = sm; else Lsc[r * 1024 + col - 1024] = sm; }
    }
    for (int e = blockIdx.x * NTHR + tid; e < 5 * 6144; e += gridDim.x * NTHR) { const int r = e / 6144, col = e % 6144; float s = p.ada_b[col];
        for (int ks = 0; ks < 16; ++ks) s += modp[((size_t)ks * 5 + r) * 6144 + col];
        ((float*)(ws + WS_MOD))[e] = s; }
    for (int i = tid; i < 1024; i += NTHR) Lnw[i] = p.norm1_w[i];
    for (int i = tid; i < 16 * 1024; i += NTHR) Lwg[i] = ((const float*)(ws + WS_WGT))[i];
    __syncthreads();
    constexpr int NGW = NWAVES;
    for (int row0 = rbeg + wave; row0 < rend; row0 += 4 * NGW) {
        f32x4 vv[4][4];
#pragma unroll
        for (int q = 0; q < 4; ++q) { const int row = row0 + q * NGW;
            if (row < rend) { const int b = row / SROW, s = row % SROW;
                const float* src = (s < CTX) ? p.ctx + ((size_t)b * CTX + s) * D : p.x + ((size_t)b * SEQ + (s - CTX)) * D;
#pragma unroll
                for (int j = 0; j < 4; ++j) vv[q][j] = *(const f32x4*)(src + j * 256 + lane * 4); } }
#pragma unroll
        for (int q = 0; q < 4; ++q) { const int row = row0 + q * NGW;
            if (row < rend) {
                const int b = row / SROW, s = row % SROW, r = (s < CTX) ? 4 : b;
                f32x4 v[4]; float ss = 0.f;
#pragma unroll
                for (int j = 0; j < 4; ++j) { v[j] = vv[q][j]; ss += (v[j].x * v[j].x + v[j].y * v[j].y) + (v[j].z * v[j].z + v[j].w * v[j].w); }
                const float rstd = rsqrtf(wave_sum(ss) * (1.0f / D) + EPS);
                bf16* urow = (bf16*)(ws + WS_U) + (size_t)row * D;
#pragma unroll
                for (int j = 0; j < 4; ++j) { const int c0 = j * 256 + lane * 4;
                    const f32x4 nw = *(const LAS f32x4*)(Lnw + c0), sc = *(const LAS f32x4*)(Lsc + r * 1024 + c0), sh = *(const LAS f32x4*)(Lsh + r * 1024 + c0);
                    v[j] = v[j] * rstd * nw * (1.0f + sc) + sh;
                    u32x2 w; w.x = pk2(v[j].x, v[j].y); w.y = pk2(v[j].z, v[j].w); if (abl < 2 || rstd == 123.f) *(u32x2*)(urow + c0) = w; }
                if (abl >= 1) continue;
                float pa[16];
#pragma unroll
                for (int g = 0; g < 16; ++g) { float a = 0.f;
#pragma unroll
                    for (int j = 0; j < 4; ++j) { const f32x4 w = *(const LAS f32x4*)(Lwg + g * 1024 + j * 256 + lane * 4); a += (v[j].x * w.x + v[j].y * w.y) + (v[j].z * w.z + v[j].w * w.w); }
                    pa[g] = a; if (g & 1) __builtin_amdgcn_sched_barrier(0); }
                const float mine = butterfly16(pa, lane);
                if ((lane & 3) == 0) { const int gi = lane >> 2; float gv = mine + p.ml_gate_b[gi];
                    if ((gi >> 2) & 1) gv = fminf(gv, 0.f) - log1pf(__expf(-fabsf(gv)));
                    ((float*)(ws + WS_GATES))[(size_t)row * 16 + gi] = gv; }
            } }
    }
}

__device__ __forceinline__ void conv_loadcol(const bf16* QKb, int r, int c, int ch, float (&o)[3][8]) {
#pragma unroll
    for (int i = 0; i < 3; ++i) { const int r2 = r + i - 1;
        if (c < 0 || c > 63 || r2 < 0 || r2 > 127) {
#pragma unroll
            for (int e = 0; e < 8; ++e) o[i][e] = 0.f;
        } else { const u32x4 w = *(const u32x4*)(QKb + (size_t)(r2 * 64 + c) * 1024 + ch);
            o[i][0] = bflo(w.x); o[i][1] = bfhi(w.x); o[i][2] = bflo(w.y); o[i][3] = bfhi(w.y); o[i][4] = bflo(w.z); o[i][5] = bfhi(w.z); o[i][6] = bflo(w.w); o[i][7] = bfhi(w.w); } }
}
__device__ __forceinline__ void conv_out(const float (&L)[3][8], const float (&M)[3][8], const float (&R)[3][8], const float (&wv)[9][8], const float (&bias)[8], float sc, bf16* dst) {
    float a[8];
#pragma unroll
    for (int e = 0; e < 8; ++e) { float t = bias[e];
#pragma unroll
        for (int i = 0; i < 3; ++i) t += L[i][e] * wv[i * 3][e] + M[i][e] * wv[i * 3 + 1][e] + R[i][e] * wv[i * 3 + 2][e];
        a[e] = silu_(t) * sc; }
    u32x4 o; o.x = pk2(a[0], a[1]); o.y = pk2(a[2], a[3]); o.z = pk2(a[4], a[5]); o.w = pk2(a[6], a[7]);
    *(u32x4*)dst = o;
}
__device__ __forceinline__ void phase_conv(const Params& p) {
    unsigned char* ws = p.ws;
    const bf16* QK = (const bf16*)(ws + WS_QK); bf16* QKC = (bf16*)(ws + WS_QKC);
    const int tid0 = tid_opaque();
    {
        const int lane = tid0 & 63, gw = blockIdx.x * NWAVES + (tid0 >> 6), NGW = gridDim.x * NWAVES;
        for (int item = gw; item < NB * 128 * 4; item += NGW) {
            const int half = item & 1, seg = (item >> 1) & 1, r = (item >> 2) & 127, b = item >> 9;
            const int ch = (half * 64 + lane) * 8;
            float wv[9][8], bias[8];
#pragma unroll
            for (int k = 0; k < 9; ++k) { const f32x4 w0 = *(const f32x4*)(p.conv_w + (size_t)k * 1024 + ch), w1 = *(const f32x4*)(p.conv_w + (size_t)k * 1024 + ch + 4);
                wv[k][0] = w0.x; wv[k][1] = w0.y; wv[k][2] = w0.z; wv[k][3] = w0.w; wv[k][4] = w1.x; wv[k][5] = w1.y; wv[k][6] = w1.z; wv[k][7] = w1.w; }
            { const f32x4 b0 = *(const f32x4*)(p.conv_b + ch), b1 = *(const f32x4*)(p.conv_b + ch + 4); bias[0] = b0.x; bias[1] = b0.y; bias[2] = b0.z; bias[3] = b0.w; bias[4] = b1.x; bias[5] = b1.y; bias[6] = b1.z; bias[7] = b1.w; }
            const float sc = (ch >= 512) ? 0.08838834764831845f : 1.0f;
            const bf16* QKb = QK + ((size_t)b * SROW + CTX) * 1024;
            bf16* dst = QKC + (size_t)(ch >> 9) * ((size_t)R_ALL * 512) + ((size_t)(b * 4 + ((ch >> 7) & 3)) * SROW + CTX + r * 64) * 128 + (ch & 127);
            const int c0 = seg * 32;
            float L[3][8], M[3][8], R[3][8];
            conv_loadcol(QKb, r, c0 - 1, ch, L); conv_loadcol(QKb, r, c0, ch, M);
#pragma unroll 1
            for (int c = c0; c < c0 + 32; c += 3) {
                conv_loadcol(QKb, r, c + 1, ch, R); conv_out(L, M, R, wv, bias, sc, dst + (size_t)c * 128);
                if (c + 1 < c0 + 32) { conv_loadcol(QKb, r, c + 2, ch, L); conv_out(M, R, L, wv, bias, sc, dst + (size_t)(c + 1) * 128); }
                if (c + 2 < c0 + 32) { conv_loadcol(QKb, r, c + 3, ch, M); conv_out(R, L, M, wv, bias, sc, dst + (size_t)(c + 2) * 128); }
            }
        }
    }
    for (int it = blockIdx.x * NTHR + tid0; it < NB * CTX * 128; it += gridDim.x * NTHR) {
        const int ch = (it & 127) * 8, s = (it >> 7) & (CTX - 1), b = it >> 15;
        float a[8];
#pragma unroll
        for (int e = 0; e < 8; ++e) a[e] = p.conv_b[ch + e];
#pragma unroll
        for (int j = 0; j < 3; ++j) { const int s2 = s + j - 1; if (s2 < 0 || s2 >= CTX) continue;
            const u32x4 w = *(const u32x4*)(QK + ((size_t)b * SROW + s2) * 1024 + ch); const float* cw = p.conv_w + (size_t)(3 + j) * 1024 + ch;
            a[0] += bflo(w.x) * cw[0]; a[1] += bfhi(w.x) * cw[1]; a[2] += bflo(w.y) * cw[2]; a[3] += bfhi(w.y) * cw[3];
            a[4] += bflo(w.z) * cw[4]; a[5] += bfhi(w.z) * cw[5]; a[6] += bflo(w.w) * cw[6]; a[7] += bfhi(w.w) * cw[7]; }
        const float sc = (ch >= 512) ? 0.08838834764831845f : 1.0f;
#pragma unroll
        for (int e = 0; e < 8; ++e) a[e] = silu_(a[e]) * sc;
        u32x4 o; o.x = pk2(a[0], a[1]); o.y = pk2(a[2], a[3]); o.z = pk2(a[4], a[5]); o.w = pk2(a[6], a[7]);
        *(u32x4*)(QKC + (size_t)(ch >> 9) * ((size_t)R_ALL * 512) + ((size_t)(b * 4 + ((ch >> 7) & 3)) * SROW + s) * 128 + (ch & 127)) = o;
    }
    {
        const int lane = tid0 & 63, gw = blockIdx.x * NWAVES + (tid0 >> 6), NGW = gridDim.x * NWAVES;
        for (int it = gw; it < 32 * 132; it += NGW) {
            const int chain = it / 132, ck = it % 132, dir = chain >> 4, b = (chain >> 2) & 3, h = chain & 3;
            const int n = ck * 64 + lane, s = dir ? (n < CTX ? CTX - 1 - n : CTX + (SROW - 1 - n)) : n;
            const float* gp = (const float*)(ws + WS_GATES) + ((size_t)b * SROW + s) * 16 + dir * 8 + h;
            const float li = gp[0]; float bs_ = gp[4];
#pragma unroll
            for (int o = 1; o < 64; o <<= 1) { const float t = __shfl_up(bs_, o); if (lane >= o) bs_ += t; }
            const float gg = li - bs_; float gm = gg;
#pragma unroll
            for (int o = 1; o < 64; o <<= 1) gm = fmaxf(gm, __shfl_xor(gm, o));
            ((float*)(ws + WS_SCB))[(size_t)chain * SROW + n] = bs_; ((float*)(ws + WS_SCG))[(size_t)chain * SROW + n] = gg;
            if (lane == 0) ((float*)(ws + WS_SCM))[chain * 132 + ck] = gm;
        }
    }
}

#define PSTAMP(k) do { if (PROF != 0 && OUT) { const unsigned long long t_ = __builtin_amdgcn_s_memrealtime(); if (PROF == (k)) tacc += t_ - tprev; tprev = t_; } } while (0)
namespace sc {
typedef short v4i16_t __attribute__((ext_vector_type(4)));
constexpr int PQ = 288, PK = 160;
constexpr int L_QT = 0, L_KT = 18432, L_K2T = 36864, L_V = 57344, L_P = 75776, L_O = 86016, L_ST = 104448, L_TOT = 141312, L_DVEC = 145408, L_EREF = 145920,
              L_N = 146432, L_DV = 146944, L_FL = 147200, L_NW = 147456, L_END = 147968;
constexpr size_t SEG_STRIDE = 66560;

__device__ __forceinline__ int s_of(int dir, int n) { return dir ? (n < CTX ? CTX - 1 - n : CTX + (SROW - 1 - n)) : n; }
__device__ __forceinline__ bf16x8 ld8(LAS unsigned char* lds, int off) { return *(const LAS bf16x8*)(lds + off); }
__device__ __forceinline__ bf16x8 trB(LAS unsigned char* lds, int off) {
    const v4i16_t a = __builtin_amdgcn_ds_read_tr16_b64_v4i16((LAS v4i16_t*)(lds + off));
    const v4i16_t b = __builtin_amdgcn_ds_read_tr16_b64_v4i16((LAS v4i16_t*)(lds + off + 4 * PQ));
    return (bf16x8){a[0], a[1], a[2], a[3], b[0], b[1], b[2], b[3]};
}
__device__ __forceinline__ float rdlane(float v, int idx) { return __uint_as_float((unsigned)__builtin_amdgcn_readlane((int)__float_as_uint(v), idx)); }
#define SC_MFMA(a, b, c) __builtin_amdgcn_mfma_f32_16x16x32_bf16((a), (b), (c), 0, 0, 0)

template <bool ML>
__device__ __forceinline__ void pc_step(LAS unsigned char* lds, int w, int li, int g, int offA, int offB) {
    for (int ti = w; ti < 10; ti += 8) {
        const int ib = (ti >= 6) ? 3 : (ti >= 3) ? 2 : (ti >= 1) ? 1 : 0, jb = ti - (ib * (ib + 1)) / 2;
        f32x4 acc = (f32x4){0.f, 0.f, 0.f, 0.f};
#pragma unroll
        for (int s = 0; s < 4; ++s) acc = SC_MFMA(ld8(lds, offA + (16 * jb + li) * PQ + (32 * s + 8 * g) * 2), ld8(lds, offB + (16 * ib + li) * PQ + (32 * s + 8 * g) * 2), acc);
        const int i = 16 * ib + li, j0 = 16 * jb + 4 * g;
        const float v0 = (j0 + 0 <= i) ? acc[0] : 0.f, v1 = (j0 + 1 <= i) ? acc[1] : 0.f, v2 = (j0 + 2 <= i) ? acc[2] : 0.f, v3 = (j0 + 3 <= i) ? acc[3] : 0.f;
        u32x2 pw; pw.x = pk2(v0, v1); pw.y = pk2(v2, v3);
        *(LAS u32x2*)(lds + L_P + i * PK + j0 * 2) = pw;
        if (ML) { float ps = (bflo(pw.x) + bfhi(pw.x)) + (bflo(pw.y) + bfhi(pw.y)); ps += __shfl_xor(ps, 16); ps += __shfl_xor(ps, 32);
            if (g == 0) __hip_atomic_fetch_add((LAS float*)(lds + L_DV) + i, ps, __ATOMIC_RELAXED, __HIP_MEMORY_SCOPE_WORKGROUP); }
    }
}
__device__ __forceinline__ void w_step(const Params& p, LAS unsigned char* lds, int tid, int dir, int b, int nbase, int type, int h) {
#pragma unroll
    for (int q = 0; q < 2; ++q) { const int idx = tid + q * NTHR, i = idx >> 4, ch = idx & 15;
        const u32x4 val = *(const LAS u32x4*)(lds + L_O + i * PQ + ch * 16);
        const int t = s_of(dir, nbase + i) - CTX;
        *(u32x4*)((bf16*)(p.ws + WS_OF) + (((size_t)(type * 16 + b * 4 + h)) * OFP + t) * 128 + ch * 8) = val; }
}
struct MixPf { u32x4 of0, of1, g0, g1; };
__device__ __forceinline__ void mix_prefetch(const Params& p, MixPf& m, int tid, int b, int h, int type, int nbase) {
    const int i = tid >> 3, part = tid & 7, t = s_of(1, nbase + i) - CTX;
    const bf16* of = (const bf16*)(p.ws + WS_OF) + (((size_t)(type * 16 + b * 4 + h)) * OFP + t) * 128 + part * 16;
    m.of0 = *(const u32x4*)of; m.of1 = *(const u32x4*)(of + 8);
}
__device__ __forceinline__ void mix_prefetch_gate(const Params& p, MixPf& m, int tid, int b, int h, int type, int nbase) {
    const int i = tid >> 3, part = tid & 7, t = s_of(1, nbase + i) - CTX;
    const bf16* gt = (const bf16*)(p.ws + (type ? WS_MO : WS_HG)) + ((size_t)b * SROW + CTX + t) * 512 + h * 128 + part * 16;
    m.g0 = *(const u32x4*)gt; m.g1 = *(const u32x4*)(gt + 8);
}
__device__ __forceinline__ void w2_step(const Params& p, LAS unsigned char* lds, const MixPf& m, int tid, int b, int h, int type, int nbase) {
    const int i = tid >> 3, part = tid & 7, t = s_of(1, nbase + i) - CTX;
    const u32x4 o0 = *(const LAS u32x4*)(lds + L_O + i * PQ + part * 32), o1 = *(const LAS u32x4*)(lds + L_O + i * PQ + part * 32 + 16);
#define W2_V(k_) ((k_) < 8 ? (((k_) & 1) ? bfhi(o0[(k_) >> 1]) + bfhi(m.of0[(k_) >> 1]) : bflo(o0[(k_) >> 1]) + bflo(m.of0[(k_) >> 1])) \
                           : (((k_) & 1) ? bfhi(o1[((k_) - 8) >> 1]) + bfhi(m.of1[((k_) - 8) >> 1]) : bflo(o1[((k_) - 8) >> 1]) + bflo(m.of1[((k_) - 8) >> 1])))
#define W2_G(k_) ((k_) < 8 ? (((k_) & 1) ? bfhi(m.g0[(k_) >> 1]) : bflo(m.g0[(k_) >> 1])) : (((k_) & 1) ? bfhi(m.g1[((k_) - 8) >> 1]) : bflo(m.g1[((k_) - 8) >> 1])))
    float sm = 0.f;
#pragma unroll
    for (int e = 0; e < 16; ++e) sm += W2_V(e);
    sm += __shfl_xor(sm, 1); sm += __shfl_xor(sm, 2); sm += __shfl_xor(sm, 4);
    const float mean = type ? sm * (1.0f / 128.0f) : 0.f;
    float q2 = 0.f;
#pragma unroll
    for (int e = 0; e < 16; ++e) { const float d = W2_V(e) - mean; q2 += d * d; }
    q2 += __shfl_xor(q2, 1); q2 += __shfl_xor(q2, 2); q2 += __shfl_xor(q2, 4);
    const float rstd = rsqrtf(q2 * (1.0f / 128.0f) + EPS);
    bf16* dst = (bf16*)(p.ws + WS_OF) + (((size_t)(type * 16 + b * 4 + h)) * OFP + t) * 128 + part * 16;
#pragma unroll
    for (int hq = 0; hq < 2; ++hq) { unsigned wd[4];
#pragma unroll
        for (int q = 0; q < 2; ++q) { const f32x4 nw = *(const LAS f32x4*)(lds + L_NW + (part * 16 + hq * 8 + q * 4) * 4);
            float r[4];
#pragma unroll
            for (int e = 0; e < 4; ++e) { const int k = hq * 8 + q * 4 + e; r[e] = (W2_V(k) - mean) * rstd * nw[e] * W2_G(k); }
            wd[q * 2] = pk2(r[0], r[1]); wd[q * 2 + 1] = pk2(r[2], r[3]); }
        *(u32x4*)(dst + hq * 8) = (u32x4){wd[0], wd[1], wd[2], wd[3]}; }
#undef W2_V
#undef W2_G
}
__device__ __forceinline__ void save_tiles(float* dst, const f32x4 (&S)[8], int w, int lane) {
#pragma unroll
    for (int t = 0; t < 8; ++t) *(f32x4*)(dst + ((size_t)(w * 8 + t) * 64 + lane) * 4) = S[t];
}

#define SC_SB __builtin_amdgcn_sched_barrier(0)
template <bool ML>
__device__ __forceinline__ void o_tiles(LAS unsigned char* lds, const bf16x8 (&bv)[2], const bf16x8 (&bs)[4], int w, int li, int g) {
#pragma unroll
    for (int it = 0; it < 4; ++it) {
        bf16x8 fp[2], fq[2]; float den = 1.f, fl = 0.f;
        fp[0] = ld8(lds, L_P + (16 * it + li) * PK + (8 * g) * 2);
        if (it >= 2) fp[1] = ld8(lds, L_P + (16 * it + li) * PK + (32 + 8 * g) * 2); else fp[1] = fp[0];
#pragma unroll
        for (int s = 0; s < 2; ++s) fq[s] = ld8(lds, L_QT + (16 * it + li) * PQ + (32 * s + 8 * g) * 2);
        if (ML) { den = *(const LAS float*)(lds + L_DV + 4 * (16 * it + li)); fl = *(const LAS float*)(lds + L_FL + 4 * (16 * it + li)); }
        SC_SB;
        f32x4 acc = (f32x4){0.f, 0.f, 0.f, 0.f};
        acc = SC_MFMA(bv[0], fp[0], acc);
        if (it >= 2) acc = SC_MFMA(bv[1], fp[1], acc);
        acc = SC_MFMA(bs[0], fq[0], acc); acc = SC_MFMA(bs[1], fq[1], acc);
#pragma unroll
        for (int s = 0; s < 2; ++s) fq[s] = ld8(lds, L_QT + (16 * it + li) * PQ + (32 * (s + 2) + 8 * g) * 2);
        SC_SB;
        acc = SC_MFMA(bs[2], fq[0], acc); acc = SC_MFMA(bs[3], fq[1], acc);
        SC_SB;
        const int i = 16 * it + li;
        if (ML) acc = acc * __builtin_amdgcn_rcpf(fmaxf(fabsf(den), fl));
        u32x2 pw; pw.x = pk2(acc[0], acc[1]); pw.y = pk2(acc[2], acc[3]); *(LAS u32x2*)(lds + L_O + i * PQ + (16 * w + 4 * g) * 2) = pw;
    }
}
__device__ __forceinline__ void s_update(LAS unsigned char* lds, f32x4 (&S)[8], const bf16x8 (&bv)[2], int li, int g) {
#pragma unroll
    for (int hp = 0; hp < 2; ++hp) {
        bf16x8 fk[4][2];
#pragma unroll
        for (int u = 0; u < 4; ++u)
#pragma unroll
            for (int s = 0; s < 2; ++s) fk[u][s] = ld8(lds, L_K2T + (16 * (4 * hp + u) + li) * PK + (32 * s + 8 * g) * 2);
        SC_SB;
#pragma unroll
        for (int s = 0; s < 2; ++s)
#pragma unroll
            for (int u = 0; u < 4; ++u) S[4 * hp + u] = SC_MFMA(fk[u][s], bv[s], S[4 * hp + u]);
        SC_SB;
    }
}

struct HgIn { unsigned lf[8], q[8], v[8]; };
template <bool OUT>
__device__ __forceinline__ void hg_load(const Params& p, HgIn& r, int dir, int b, int h, int nbase, int w, int l) {
    const unsigned char* ws = p.ws;
    const size_t sp0 = (size_t)s_of(dir, nbase + 8 * w); const long step = dir ? -256 : 256;
    const char* plf = (const char*)(ws + WS_LF) + ((size_t)((b * 2 + dir) * 4 + h) * SROW + sp0) * 256;
    const char* pv = (const char*)(ws + WS_HV) + ((size_t)(b * 4 + h) * SROW + sp0) * 256;
    const char* pq = (const char*)(ws + WS_HQ) + ((size_t)(b * 4 + h) * SROW + sp0) * 256;
#pragma unroll
    for (int t = 0; t < 8; ++t) {
        r.lf[t] = *(const unsigned*)(plf + t * step + 4 * l);
        r.v[t] = *(const unsigned*)(pv + t * step + 4 * l);
        if (OUT) r.q[t] = *(const unsigned*)(pq + t * step + 4 * l); else r.q[t] = 0u; }
}
template <bool OUT, bool FUSE>
__device__ __forceinline__ void hg_chunk(const Params& p, LAS unsigned char* lds, int dir, int b, int h, int nbase, f32x4 (&S)[8], float& lt0, float& lt1, unsigned long long& tacc,
                                         const HgIn& cur, HgIn& pf, bool do_pf, int tid, int w, int l, int li, int g) {
        unsigned long long tprev = 0; PSTAMP(0);
        float c0 = 0.f, c1 = 0.f;
#pragma unroll
        for (int t = 0; t < 8; ++t) { c0 += h2f((unsigned short)(cur.lf[t] & 0xffffu)); c1 += h2f((unsigned short)(cur.lf[t] >> 16)); }
        *(LAS f32x2*)(lds + L_TOT + (w * 128 + 2 * l) * 4) = (f32x2){c0, c1};
        __syncthreads(); PSTAMP(1);
        float pre0 = 0.f, pre1 = 0.f, ar0 = 0.f, ar1 = 0.f, al0 = 0.f, al1 = 0.f;
#pragma unroll
        for (int w2 = 0; w2 < 8; ++w2) { const f32x2 tt = *(const LAS f32x2*)(lds + L_TOT + (w2 * 128 + 2 * l) * 4);
            if (w2 < w) { pre0 += tt.x; pre1 += tt.y; } if (w2 < 4) { ar0 += tt.x; ar1 += tt.y; } al0 += tt.x; al1 += tt.y; }
        unsigned k2a[8], k2b[8];
        const float c20 = __builtin_amdgcn_exp2f(al0 - ar0), c21 = __builtin_amdgcn_exp2f(al1 - ar1);
        float A0 = pre0, A1 = pre1;
#pragma unroll
        for (int t = 0; t < 8; ++t) { const int j = 8 * w + t;
            const float lf0 = h2f((unsigned short)(cur.lf[t] & 0xffffu)), lf1 = h2f((unsigned short)(cur.lf[t] >> 16));
            A0 += lf0; A1 += lf1;
            const float k0 = 1.0f - __builtin_amdgcn_exp2f(lf0), k1 = 1.0f - __builtin_amdgcn_exp2f(lf1);
            float kt0, kt1, kk0, kk1;
            if (OUT) { kt0 = k0 * __builtin_amdgcn_exp2f(fminf(ar0 - A0, 86.f)); kt1 = k1 * __builtin_amdgcn_exp2f(fminf(ar1 - A1, 86.f)); kk0 = kt0 * c20; kk1 = kt1 * c21; }
            else { kt0 = kt1 = 0.f; kk0 = k0 * __builtin_amdgcn_exp2f(al0 - A0); kk1 = k1 * __builtin_amdgcn_exp2f(al1 - A1); }
            if (OUT) *(LAS unsigned*)(lds + L_KT + j * PQ + 4 * l) = pk2(kt0, kt1);
            *(LAS unsigned*)(lds + L_V + j * PQ + 4 * l) = cur.v[t];
            if (OUT) { const float q0 = bflo(cur.q[t]) * __builtin_amdgcn_exp2f(fminf(A0 - ar0, 86.f)), q1 = bfhi(cur.q[t]) * __builtin_amdgcn_exp2f(fminf(A1 - ar1, 86.f));
                *(LAS unsigned*)(lds + L_QT + j * PQ + 4 * l) = pk2(q0, q1); }
            const unsigned kk = pk2(kk0, kk1);
            if (t & 1) { k2a[t >> 1] = (k2a[t >> 1] & 0xffffu) | (kk << 16); k2b[t >> 1] = (k2b[t >> 1] & 0xffffu) | (kk & 0xffff0000u); }
            else { k2a[t >> 1] = kk & 0xffffu; k2b[t >> 1] = kk >> 16; } }
        *(LAS u32x4*)(lds + L_K2T + (2 * l) * PK + 16 * w) = (u32x4){k2a[0], k2a[1], k2a[2], k2a[3]};
        *(LAS u32x4*)(lds + L_K2T + (2 * l + 1) * PK + 16 * w) = (u32x4){k2b[0], k2b[1], k2b[2], k2b[3]};
        if (w == 0) { *(LAS f32x2*)(lds + L_DVEC + 8 * l) = (f32x2){__builtin_amdgcn_exp2f(al0), __builtin_amdgcn_exp2f(al1)}; *(LAS f32x2*)(lds + L_EREF + 8 * l) = (f32x2){__builtin_amdgcn_exp2f(ar0), __builtin_amdgcn_exp2f(ar1)}; }
        lt0 += al0; lt1 += al1;
        __syncthreads(); PSTAMP(2);
        if (do_pf) hg_load<OUT>(p, pf, dir, b, h, nbase + 64, w, l);
        if (OUT) { pc_step<false>(lds, w, li, g, L_KT, L_QT); __syncthreads(); } PSTAMP(3);
        MixPf mpf; if (FUSE) mix_prefetch(p, mpf, tid, b, h, 0, nbase);
        bf16x8 bv[2];
#pragma unroll
        for (int s = 0; s < 2; ++s) bv[s] = trB(lds, L_V + (32 * s + 8 * g + (li >> 2)) * PQ + (16 * w + 4 * (li & 3)) * 2);
        if (OUT) {
#pragma unroll
            for (int hp = 0; hp < 2; ++hp) {
                f32x4 er[4];
#pragma unroll
                for (int t = 0; t < 4; ++t) er[t] = *(const LAS f32x4*)(lds + L_EREF + (16 * (4 * hp + t) + 4 * g) * 4);
                SC_SB;
#pragma unroll
                for (int t = 0; t < 4; ++t) { const f32x4 sv = S[4 * hp + t] * er[t];
                    u32x2 pw; pw.x = pk2(sv[0], sv[1]); pw.y = pk2(sv[2], sv[3]); *(LAS u32x2*)(lds + L_ST + (16 * w + li) * PQ + (16 * (4 * hp + t) + 4 * g) * 2) = pw; }
            }
            bf16x8 bs[4];
#pragma unroll
            for (int s = 0; s < 4; ++s) bs[s] = ld8(lds, L_ST + (16 * w + li) * PQ + (32 * s + 8 * g) * 2);
            o_tiles<false>(lds, bv, bs, w, li, g);
        }
        if (FUSE) mix_prefetch_gate(p, mpf, tid, b, h, 0, nbase);
#pragma unroll
        for (int hp = 0; hp < 2; ++hp) { f32x4 dvv[4];
#pragma unroll
            for (int t = 0; t < 4; ++t) dvv[t] = *(const LAS f32x4*)(lds + L_DVEC + (16 * (4 * hp + t) + 4 * g) * 4);
            SC_SB;
#pragma unroll
            for (int t = 0; t < 4; ++t) S[4 * hp + t] = S[4 * hp + t] * dvv[t]; }
        s_update(lds, S, bv, li, g);
        __syncthreads(); PSTAMP(4);
        if (FUSE) w2_step(p, lds, mpf, tid, b, h, 0, nbase); else if (OUT) w_step(p, lds, tid, dir, b, nbase, 0, h);
        PSTAMP(5);
}
template <bool OUT, bool FUSE>
__device__ __forceinline__ void hg_run(const Params& p, LAS unsigned char* lds, int dir, int b, int h, int n0, int nch, f32x4 (&S)[8], float& lt0, float& lt1, unsigned long long& tacc) {
    const int tid = tid_opaque(), w = __builtin_amdgcn_readfirstlane(tid >> 6), l = tid & 63, li = l & 15, g = l >> 4;
    HgIn A, B;
    hg_load<OUT>(p, A, dir, b, h, n0, w, l);
    for (int c = 0; c < nch; c += 2) {
        hg_chunk<OUT, FUSE>(p, lds, dir, b, h, n0 + 64 * c, S, lt0, lt1, tacc, A, B, c + 1 < nch, tid, w, l, li, g);
        if (c + 1 < nch) hg_chunk<OUT, FUSE>(p, lds, dir, b, h, n0 + 64 * (c + 1), S, lt0, lt1, tacc, B, A, c + 2 < nch, tid, w, l, li, g);
    }
}

struct MlIn { unsigned q[8], k[8], v[8]; float bs, gg, gm; };
template <bool OUT>
__device__ __forceinline__ void ml_load(const Params& p, MlIn& r, int dir, int b, int h, int nbase, int w, int l) {
    const unsigned char* ws = p.ws;
    const size_t sp0 = (size_t)s_of(dir, nbase + 8 * w); const long step = dir ? -256 : 256;
    const size_t o0 = ((size_t)(b * 4 + h) * SROW + sp0) * 256;
    const char* pq = (const char*)(ws + WS_QKC) + o0; const char* pk = pq + (size_t)R_ALL * 1024; const char* pv = (const char*)(ws + WS_MV) + o0;
#pragma unroll
    for (int t = 0; t < 8; ++t) {
        r.k[t] = *(const unsigned*)(pk + t * step + 4 * l);
        r.v[t] = *(const unsigned*)(pv + t * step + 4 * l);
        if (OUT) r.q[t] = *(const unsigned*)(pq + t * step + 4 * l); else r.q[t] = 0u; }
    const int chain = (dir * 4 + b) * 4 + h;
    r.bs = ((const float*)(ws + WS_SCB))[(size_t)chain * SROW + nbase + l]; r.gg = ((const float*)(ws + WS_SCG))[(size_t)chain * SROW + nbase + l];
    r.gm = ((const float*)(ws + WS_SCM))[chain * 132 + (nbase >> 6)];
}
template <bool OUT, bool FUSE>
__device__ __forceinline__ void ml_chunk(const Params& p, LAS unsigned char* lds, int dir, int b, int h, int nbase, f32x4 (&S)[8], float& m_prev, float& btot, unsigned long long& tacc,
                                         const MlIn& cur, MlIn& pf, bool do_pf, int tid, int w, int l, int li, int g) {
        unsigned long long tprev = 0; PSTAMP(0);
        const float bs_ = cur.bs, gg = cur.gg, gm = cur.gm;
        const float G = fmaxf(m_prev, gm), s_in = __expf(m_prev - G), eg = __expf(gg - G), b63 = rdlane(bs_, 63);
        if (w == 0 && OUT) *(LAS float*)(lds + L_FL + 4 * l) = __expf(-(bs_ + G));
        float n0v = 0.f, n1v = 0.f;
        if (OUT) { const f32x2 nn = *(const LAS f32x2*)(lds + L_N + 8 * l); n0v = nn.x * s_in; n1v = nn.y * s_in; }
        float ks0 = 0.f, ks1 = 0.f; unsigned k2a[8], k2b[8]; float qd[8];
#pragma unroll
        for (int t = 0; t < 8; ++t) { const int j = 8 * w + t; const float egj = rdlane(eg, j);
            const float kh0 = bflo(cur.k[t]) * egj, kh1 = bfhi(cur.k[t]) * egj; ks0 += kh0; ks1 += kh1;
            const unsigned kk = pk2(kh0, kh1);
            *(LAS unsigned*)(lds + L_V + j * PQ + 4 * l) = cur.v[t];
            if (OUT) { *(LAS unsigned*)(lds + L_KT + j * PQ + 4 * l) = kk; *(LAS unsigned*)(lds + L_QT + j * PQ + 4 * l) = cur.q[t];
                qd[t] = bflo(cur.q[t]) * n0v + bfhi(cur.q[t]) * n1v; } else qd[t] = 0.f;
            if (t & 1) { k2a[t >> 1] = (k2a[t >> 1] & 0xffffu) | (kk << 16); k2b[t >> 1] = (k2b[t >> 1] & 0xffffu) | (kk & 0xffff0000u); }
            else { k2a[t >> 1] = kk & 0xffffu; k2b[t >> 1] = kk >> 16; } }
        if (OUT) {
            const bool h5 = (l & 32) != 0, h4 = (l & 16) != 0, h3 = (l & 8) != 0; float r4[4], r2[2];
#pragma unroll
            for (int e = 0; e < 4; ++e) { const float keep = h5 ? qd[e + 4] : qd[e], send = h5 ? qd[e] : qd[e + 4]; r4[e] = keep + __shfl_xor(send, 32); }
#pragma unroll
            for (int e = 0; e < 2; ++e) { const float keep = h4 ? r4[e + 2] : r4[e], send = h4 ? r4[e] : r4[e + 2]; r2[e] = keep + __shfl_xor(send, 16); }
            const float keep = h3 ? r2[1] : r2[0], send = h3 ? r2[0] : r2[1];
            float r1 = keep + __shfl_xor(send, 8);
            r1 += __shfl_xor(r1, 4); r1 += __shfl_xor(r1, 2); r1 += __shfl_xor(r1, 1);
            if ((l & 7) == 0) *(LAS float*)(lds + L_DV + 4 * (8 * w + ((l >> 3) & 7))) = r1;
        }
        *(LAS u32x4*)(lds + L_K2T + (2 * l) * PK + 16 * w) = (u32x4){k2a[0], k2a[1], k2a[2], k2a[3]};
        *(LAS u32x4*)(lds + L_K2T + (2 * l + 1) * PK + 16 * w) = (u32x4){k2b[0], k2b[1], k2b[2], k2b[3]};
        *(LAS f32x2*)(lds + L_TOT + (w * 128 + 2 * l) * 4) = (f32x2){ks0, ks1};
        __syncthreads(); PSTAMP(2);
        if (tid < 128) { float s = *(const LAS float*)(lds + L_N + 4 * tid) * s_in;
#pragma unroll
            for (int w2 = 0; w2 < 8; ++w2) s += *(const LAS float*)(lds + L_TOT + (w2 * 128 + tid) * 4);
            *(LAS float*)(lds + L_N + 4 * tid) = s; }
        if (do_pf) ml_load<OUT>(p, pf, dir, b, h, nbase + 64, w, l);
        if (OUT) { pc_step<true>(lds, w, li, g, L_KT, L_QT); __syncthreads(); } PSTAMP(3);
        MixPf mpf; if (FUSE) mix_prefetch(p, mpf, tid, b, h, 1, nbase);
        bf16x8 bv[2];
#pragma unroll
        for (int s = 0; s < 2; ++s) bv[s] = trB(lds, L_V + (32 * s + 8 * g + (li >> 2)) * PQ + (16 * w + 4 * (li & 3)) * 2);
#pragma unroll
        for (int t = 0; t < 8; ++t) S[t] = S[t] * s_in;
        if (OUT) {
#pragma unroll
            for (int t = 0; t < 8; ++t) { u32x2 pw; pw.x = pk2(S[t][0], S[t][1]); pw.y = pk2(S[t][2], S[t][3]); *(LAS u32x2*)(lds + L_ST + (16 * w + li) * PQ + (16 * t + 4 * g) * 2) = pw; }
            bf16x8 bs[4];
#pragma unroll
            for (int s = 0; s < 4; ++s) bs[s] = ld8(lds, L_ST + (16 * w + li) * PQ + (32 * s + 8 * g) * 2);
            o_tiles<true>(lds, bv, bs, w, li, g);
        }
        if (FUSE) mix_prefetch_gate(p, mpf, tid, b, h, 1, nbase);
        s_update(lds, S, bv, li, g);
        m_prev = b63 + G; btot += b63;
        __syncthreads(); PSTAMP(4);
        if (FUSE) w2_step(p, lds, mpf, tid, b, h, 1, nbase); else if (OUT) w_step(p, lds, tid, dir, b, nbase, 1, h);
        PSTAMP(5);
}
template <bool OUT, bool FUSE>
__device__ __forceinline__ void ml_run(const Params& p, LAS unsigned char* lds, int dir, int b, int h, int n0, int nch, f32x4 (&S)[8], float& m_prev, float& btot, unsigned long long& tacc) {
    const int tid = tid_opaque(), w = __builtin_amdgcn_readfirstlane(tid >> 6), l = tid & 63, li = l & 15, g = l >> 4;
    MlIn A, B;
    ml_load<OUT>(p, A, dir, b, h, n0, w, l);
    for (int c = 0; c < nch; c += 2) {
        ml_chunk<OUT, FUSE>(p, lds, dir, b, h, n0 + 64 * c, S, m_prev, btot, tacc, A, B, c + 1 < nch, tid, w, l, li, g);
        if (c + 1 < nch) ml_chunk<OUT, FUSE>(p, lds, dir, b, h, n0 + 64 * (c + 1), S, m_prev, btot, tacc, B, A, c + 2 < nch, tid, w, l, li, g);
    }
}

__device__ __forceinline__ void pass_a(const Params& p, LAS unsigned char* lds, int item) {
    const int tid = tid_opaque(), w = __builtin_amdgcn_readfirstlane(tid >> 6), l = tid & 63;
    const int chain = item & 63, sa = item >> 6, type = chain >> 5, dir = (chain >> 4) & 1, b = (chain >> 2) & 3, h = chain & 3;
    const int n0 = sa == 0 ? 0 : CTX + (sa - 1) * 1024, nch = sa == 0 ? 4 : 16;
    float* rec = (float*)(p.ws + WS_SEG + (size_t)(chain * 8 + sa) * SEG_STRIDE);
    f32x4 S[8];
#pragma unroll
    for (int t = 0; t < 8; ++t) S[t] = (f32x4){0.f, 0.f, 0.f, 0.f};
    if (type == 0) { float lt0 = 0.f, lt1 = 0.f; unsigned long long tacc = 0; hg_run<false, false>(p, lds, dir, b, h, n0, nch, S, lt0, lt1, tacc);
        save_tiles(rec, S, w, l); if (w == 0) *(f32x2*)(rec + 16384 + 2 * l) = (f32x2){lt0, lt1}; }
    else { float m_prev = -1.0e30f, btot = 0.f;
        if (tid < 128) *(LAS float*)(lds + L_N + 4 * tid) = 0.f;
        __syncthreads();
        unsigned long long tacc = 0; ml_run<false, false>(p, lds, dir, b, h, n0, nch, S, m_prev, btot, tacc);
        save_tiles(rec, S, w, l); if (tid < 128) rec[16384 + tid] = *(const LAS float*)(lds + L_N + 4 * tid);
        if (tid == 0) { rec[16384 + 128] = m_prev; rec[16384 + 129] = btot; } }
    __syncthreads();
}
template <int DIR>
__device__ __forceinline__ void pass_b(const Params& p, LAS unsigned char* lds, int item) {
    const int tid = tid_opaque(), w = __builtin_amdgcn_readfirstlane(tid >> 6), l = tid & 63, g = l >> 4;
    const int k = item & 7, h = (item >> 3) & 3, b = (item >> 5) & 3, type = item >> 7, dir = DIR, chain = type * 32 + dir * 16 + b * 4 + h;
    const int n0 = CTX + k * 1024;
    unsigned long long tacc = 0;
    for (int i = tid; i < 64 * PK / 4; i += NTHR) *(LAS unsigned*)(lds + L_P + 4 * i) = 0u;
    if (DIR == 1 && tid < 128) *(LAS float*)(lds + L_NW + 4 * tid) = (type ? p.ml_norm_w : p.hg_norm_w)[h * 128 + tid];
    f32x4 S[8];
#pragma unroll
    for (int t = 0; t < 8; ++t) S[t] = (f32x4){0.f, 0.f, 0.f, 0.f};
    const float* rec0 = (const float*)(p.ws + WS_SEG + (size_t)(chain * 8) * SEG_STRIDE);
    for (int i = tid; i < (k + 1) * 130; i += NTHR) { const int j = i / 130, c = i % 130; *(LAS float*)(lds + L_TOT + (j * 132 + c) * 4) = rec0[(size_t)j * (SEG_STRIDE / 4) + 16384 + c]; }
    __syncthreads();
    float m_in = -1.0e30f, nacc = 0.f;
#define PB_LOAD(U_, j_, hp_) do { const float* r_ = rec0 + (size_t)(j_) * (SEG_STRIDE / 4); _Pragma("unroll") for (int t = 0; t < 4; ++t) U_[t] = *(const f32x4*)(r_ + ((size_t)(w * 8 + 4 * (hp_) + t) * 64 + l) * 4); } while (0)
#define PB_COMBINE(U_, j_, hp_) do { \
        if (type == 0) { _Pragma("unroll") for (int t = 0; t < 4; ++t) { const f32x4 lt = *(const LAS f32x4*)(lds + L_TOT + ((j_) * 132 + 16 * (4 * (hp_) + t) + 4 * g) * 4); \
            f32x4& s_ = S[4 * (hp_) + t]; \
            s_[0] = s_[0] * __builtin_amdgcn_exp2f(lt[0]) + U_[t][0]; s_[1] = s_[1] * __builtin_amdgcn_exp2f(lt[1]) + U_[t][1]; \
            s_[2] = s_[2] * __builtin_amdgcn_exp2f(lt[2]) + U_[t][2]; s_[3] = s_[3] * __builtin_amdgcn_exp2f(lt[3]) + U_[t][3]; } } \
        else { const float m_loc = *(const LAS float*)(lds + L_TOT + ((j_) * 132 + 128) * 4), bj = *(const LAS float*)(lds + L_TOT + ((j_) * 132 + 129) * 4); \
            const float mn = fmaxf(bj + m_h, m_loc), sa_ = __expf(bj + m_h - mn), sb_ = __expf(m_loc - mn); \
            _Pragma("unroll") for (int t = 0; t < 4; ++t) S[4 * (hp_) + t] = S[4 * (hp_) + t] * sa_ + U_[t] * sb_; \
            if ((hp_) == 0 && tid < 128) nacc = nacc * sa_ + *(const LAS float*)(lds + L_TOT + ((j_) * 132 + tid) * 4) * sb_; \
            m_h = mn; } } while (0)
#pragma unroll
    for (int hp = 0; hp < 2; ++hp) {
        f32x4 ua[4], ub[4]; float m_h = -1.0e30f;
        PB_LOAD(ua, 0, hp);
        for (int j = 0; j <= k; j += 2) {
            if (j + 1 <= k) PB_LOAD(ub, j + 1, hp);
            PB_COMBINE(ua, j, hp);
            if (j + 1 <= k) { if (j + 2 <= k) PB_LOAD(ua, j + 2, hp); PB_COMBINE(ub, j + 1, hp); }
        }
        m_in = m_h;
    }
#undef PB_COMBINE
#undef PB_LOAD
    if (type == 1 && tid < 128) *(LAS float*)(lds + L_N + 4 * tid) = nacc;
    __syncthreads();
    if (type == 0) { float lt0 = 0.f, lt1 = 0.f; hg_run<true, DIR == 1>(p, lds, dir, b, h, n0, 16, S, lt0, lt1, tacc); }
    else { float btot = 0.f; ml_run<true, DIR == 1>(p, lds, dir, b, h, n0, 16, S, m_in, btot, tacc); }
    if (PROF != 0 && (int)blockIdx.x == PROF_BLOCK) { const unsigned long long st = __builtin_amdgcn_s_memrealtime(); while (__builtin_amdgcn_s_memrealtime() - st < tacc * 100ull) __builtin_amdgcn_s_sleep(8); }
    __syncthreads();
}
#undef SC_MFMA
#undef SC_SB
}

__device__ __forceinline__ void phase_vx(const Params& p, LAS unsigned char* lds) {
    unsigned char* ws = p.ws;
    const int tid = tid_opaque(), lane = tid & 63, wave = tid >> 6;
    LAS float* Lrw = (LAS float*)lds;
    LAS float* Lnw = Lrw + 16 * 1024;
    LAS float* Lsh = Lnw + 1024;
    LAS float* Lsc = Lsh + 4096;
    const float* mod = (const float*)(ws + WS_MOD);
    for (int i = tid; i < 16 * 1024; i += NTHR) Lrw[i] = ((const float*)(ws + WS_RWT))[i];
    for (int i = tid; i < 1024; i += NTHR) Lnw[i] = p.norm2_w[i];
    for (int i = tid; i < 4096; i += NTHR) { const int b = i >> 10, c = i & 1023; Lsh[i] = mod[(size_t)b * 6144 + 3072 + c]; Lsc[i] = mod[(size_t)b * 6144 + 4096 + c]; }
    __syncthreads();
    const int gw = blockIdx.x * NWAVES + wave, NGW = gridDim.x * NWAVES;
    for (int xr0 = gw; xr0 < R_X; xr0 += 4 * NGW) {
        f32x4 vv[4][4];
#pragma unroll
        for (int q = 0; q < 4; ++q) { const int xr = xr0 + q * NGW;
            if (xr < R_X) { const float* src = p.x + (size_t)xr * D; const bf16* dl = (const bf16*)(ws + WS_DELTA) + (size_t)xr * D;
#pragma unroll
                for (int j = 0; j < 4; ++j) { const u32x2 dw = *(const u32x2*)(dl + j * 256 + lane * 4); vv[q][j] = *(const f32x4*)(src + j * 256 + lane * 4) + (f32x4){bflo(dw.x), bfhi(dw.x), bflo(dw.y), bfhi(dw.y)}; } } }
#pragma unroll
        for (int q = 0; q < 4; ++q) { const int xr = xr0 + q * NGW;
            if (xr < R_X) {
                const int b = xr / SEQ, t = xr % SEQ;
                f32x4 v[4]; float ss = 0.f;
#pragma unroll
                for (int j = 0; j < 4; ++j) { v[j] = vv[q][j]; ss += (v[j].x * v[j].x + v[j].y * v[j].y) + (v[j].z * v[j].z + v[j].w * v[j].w); }
                const float rstd = rsqrtf(wave_sum(ss) * (1.0f / D) + EPS);
                bf16* vrow = (bf16*)(ws + WS_VX) + (size_t)xr * D;
#pragma unroll
                for (int j = 0; j < 4; ++j) { const int c0 = j * 256 + lane * 4;
                    const f32x4 nw = *(const LAS f32x4*)(Lnw + c0), sc = *(const LAS f32x4*)(Lsc + b * 1024 + c0), sh = *(const LAS f32x4*)(Lsh + b * 1024 + c0);
                    v[j] = v[j] * rstd * nw * (1.0f + sc) + sh;
                    u32x2 w; w.x = pk2(v[j].x, v[j].y); w.y = pk2(v[j].z, v[j].w); *(u32x2*)(vrow + c0) = w; }
                float pa[16];
#pragma unroll
                for (int g = 0; g < 16; ++g) { float a = 0.f;
#pragma unroll
                    for (int j = 0; j < 4; ++j) { const f32x4 w = *(const LAS f32x4*)(Lrw + g * 1024 + j * 256 + lane * 4); a += (v[j].x * w.x + v[j].y * w.y) + (v[j].z * w.z + v[j].w * w.w); }
                    pa[g] = a; if (g & 1) __builtin_amdgcn_sched_barrier(0); }
                const float mine = butterfly16(pa, lane);
                float mx = mine;
                mx = fmaxf(mx, __shfl_xor(mx, 4)); mx = fmaxf(mx, __shfl_xor(mx, 8)); mx = fmaxf(mx, __shfl_xor(mx, 16)); mx = fmaxf(mx, __shfl_xor(mx, 32));
                const float ex = __expf(mine - mx);
                float sm = ex; sm += __shfl_xor(sm, 4); sm += __shfl_xor(sm, 8); sm += __shfl_xor(sm, 16); sm += __shfl_xor(sm, 32);
                if ((lane & 3) == 0) ((float*)(ws + WS_AFF))[((size_t)b * 16 + (lane >> 2)) * SEQ + t] = ex / sm;
            } }
    }
}

__device__ __forceinline__ void phase_topk(const Params& p, LAS unsigned char* lds) {
    unsigned char* ws = p.ws;
    const int tid = tid_opaque(), lane = tid & 63, w = __builtin_amdgcn_readfirstlane(tid >> 6);
    LAS int* wc = (LAS int*)lds;
    for (int item = blockIdx.x; item < 256; item += gridDim.x) {
        const int be = item >> 2, qtr = item & 3, b = be >> 4, e = be & 15;
        const float* aff = (const float*)(ws + WS_AFF) + (size_t)be * SEQ + tid * 16;
        unsigned u[16];
#pragma unroll
        for (int q = 0; q < 4; ++q) { const f32x4 v = *(const f32x4*)(aff + 4 * q); u[4 * q] = __float_as_uint(v.x); u[4 * q + 1] = __float_as_uint(v.y); u[4 * q + 2] = __float_as_uint(v.z); u[4 * q + 3] = __float_as_uint(v.w); }
        unsigned T = 0u; int par = 0;
        for (int bit = 30; bit >= -1; --bit) {
            const unsigned cand = (bit >= 0) ? (T | (1u << bit)) : (T + 1u);
            int c = 0;
#pragma unroll
            for (int i = 0; i < 16; ++i) c += (int)__popcll(__ballot(u[i] >= cand));
            if (lane == 0) wc[par * 8 + w] = c;
            __syncthreads();
            int tot = 0;
#pragma unroll
            for (int w2 = 0; w2 < 8; ++w2) tot += wc[par * 8 + w2];
            if (bit >= 0) { if (tot >= CAP) T = cand; } else wc[32] = tot;
            par ^= 1;
        }
        int ngt = 0, neq = 0;
#pragma unroll
        for (int i = 0; i < 16; ++i) { ngt += (u[i] > T) ? 1 : 0; neq += (u[i] == T) ? 1 : 0; }
        int pk = (ngt << 16) | neq, inc = pk;
#pragma unroll
        for (int o = 1; o < 64; o <<= 1) { const int t = __shfl_up(inc, o); if (lane >= o) inc += t; }
        if (lane == 63) wc[16 + w] = inc;
        __syncthreads();
        const int cgt = wc[32];
        int base = inc - pk;
#pragma unroll
        for (int w2 = 0; w2 < 8; ++w2) if (w2 < w) base += wc[16 + w2];
        int gtb = base >> 16, eqb = base & 0xffff; const int need_eq = CAP - cgt;
        if ((tid >> 7) == qtr) {
            int sl[16];
#pragma unroll
            for (int i = 0; i < 16; ++i) { int s_ = -1;
                if (u[i] > T) { s_ = gtb; ++gtb; } else if (u[i] == T) { if (eqb < need_eq) s_ = cgt + eqb; ++eqb; }
                sl[i] = s_;
                if (s_ >= 0) { const int mrow = (e * NB + b) * CAP + s_; ((int*)(ws + WS_ROWMAP))[mrow] = b * SEQ + tid * 16 + i; ((float*)(ws + WS_GATEV))[mrow] = __uint_as_float(u[i]); } }
            int* so = (int*)(ws + WS_SLOT) + (size_t)be * SEQ + tid * 16;
#pragma unroll
            for (int q = 0; q < 4; ++q) *(int4*)(so + 4 * q) = make_int4(sl[4 * q], sl[4 * q + 1], sl[4 * q + 2], sl[4 * q + 3]);
        }
        __syncthreads();
    }
}

__device__ __forceinline__ void phase_final(const Params& p) {
    unsigned char* ws = p.ws;
    const int tid = tid_opaque(), lane = tid & 63, wave = tid >> 6;
    const int gw = blockIdx.x * NWAVES + wave, NGW = gridDim.x * NWAVES;
    const float* mod = (const float*)(ws + WS_MOD);
    for (int blk = gw; blk < R_X / 16; blk += NGW) {
        const int xr0 = blk * 16, b = xr0 / SEQ, t0 = xr0 % SEQ;
        const int4 sl4 = *(const int4*)((const int*)(ws + WS_SLOT) + ((size_t)b * 16 + (lane & 15)) * SEQ + t0 + 4 * (lane >> 4));
#pragma unroll 1
        for (int rq = 0; rq < 4; ++rq)
#pragma unroll 1
            for (int rr = 0; rr < 4; ++rr) {
                const int xr = xr0 + rq * 4 + rr; const int myv = (rr == 0) ? sl4.x : (rr == 1) ? sl4.y : (rr == 2) ? sl4.z : sl4.w;
                float* row = p.out + (size_t)xr * D;
                f32x4 acc[4];
#pragma unroll
                for (int j = 0; j < 4; ++j) acc[j] = (f32x4){0.f, 0.f, 0.f, 0.f};
                for (int e = 0; e < 16; ++e) { const int sl = __shfl(myv, e + 16 * rq); if (sl < 0) continue;
                    const bf16* y = (const bf16*)(ws + WS_Y) + ((size_t)(e * NB + b) * CAP + sl) * D;
#pragma unroll
                    for (int j = 0; j < 4; ++j) { const u32x2 wv = *(const u32x2*)(y + j * 256 + lane * 4); acc[j].x += bflo(wv.x); acc[j].y += bfhi(wv.x); acc[j].z += bflo(wv.y); acc[j].w += bfhi(wv.y); } }
                f32x4 v[4]; float ss = 0.f;
#pragma unroll
                for (int j = 0; j < 4; ++j) { const int c0 = j * 256 + lane * 4; const f32x4 g2 = *(const f32x4*)(mod + (size_t)b * 6144 + 5120 + c0);
                    const u32x2 dw = *(const u32x2*)((const bf16*)(ws + WS_DELTA) + (size_t)xr * D + c0);
                    v[j] = *(const f32x4*)(p.x + (size_t)xr * D + c0) + (f32x4){bflo(dw.x), bfhi(dw.x), bflo(dw.y), bfhi(dw.y)} + g2 * acc[j]; ss += (v[j].x * v[j].x + v[j].y * v[j].y) + (v[j].z * v[j].z + v[j].w * v[j].w); }
                const float rstd = rsqrtf(wave_sum(ss) * (1.0f / D) + EPS);
#pragma unroll
                for (int j = 0; j < 4; ++j) { const int c0 = j * 256 + lane * 4; const f32x4 fw = *(const f32x4*)(p.final_w + c0); *(f32x4*)(row + c0) = v[j] * rstd * fw; }
            }
    }
}

#define XB_TMO      128
#define XB_XCNT(j)  (256  + 64 * (j))
#define XB_XSUB(j)  (1280 + 64 * (j))
#define XB_XGEN(j)  (2304 + 64 * (j))
#define XB_TOP      3328
#define XB_TOPGEN   3392
#define XCD_BAR_WORDS 3456
#define XB_SPIN_CAP (1u << 20)
__device__ __forceinline__ unsigned xb_ld(unsigned* p)              { return __hip_atomic_load(p, __ATOMIC_RELAXED, __HIP_MEMORY_SCOPE_AGENT); }
__device__ __forceinline__ unsigned xb_add(unsigned* p, unsigned v) { return __hip_atomic_fetch_add(p, v, __ATOMIC_RELAXED, __HIP_MEMORY_SCOPE_AGENT); }
__device__ __forceinline__ unsigned xb_xcc_id() { return (unsigned)__builtin_amdgcn_s_getreg((3 << 11) | 20) & 0xFu; }
#define XB_SPIN(cond, bar) do { unsigned _sp = 0; while (cond) { __builtin_amdgcn_s_sleep(1); \
    if ((++_sp & 255u) == 0u) { if (xb_ld(&(bar)[XB_TMO])) break; if (_sp > XB_SPIN_CAP) { atomicAdd(&(bar)[XB_TMO], 1u); break; } } } } while (0)
struct XcdBarrier { unsigned* bar; unsigned x; volatile LAS unsigned* st; };
__device__ __forceinline__ XcdBarrier xcd_barrier_post(unsigned* bar, volatile LAS unsigned* st) {
    XcdBarrier b; b.bar = bar; b.x = xb_xcc_id(); b.st = st;
    if (threadIdx.x == 0) (void)xb_add(&bar[XB_XCNT(b.x)], 1u);
    return b;
}
__device__ __forceinline__ void xcd_barrier_complete(unsigned* bar, unsigned x, unsigned& nloc, unsigned& nx) {
    const unsigned G = gridDim.x * gridDim.y * gridDim.z;
    unsigned sum, cnt, mine, sp = 0u;
    for (;;) {
        sum = 0u; cnt = 0u; mine = 0u;
#pragma unroll
        for (unsigned j = 0; j < 16; ++j) { const unsigned c = xb_ld(&bar[XB_XCNT(j)]); sum += c; cnt += (c > 0u) ? 1u : 0u; mine = (j == x) ? c : mine; }
        if (sum == G) break;
        __builtin_amdgcn_s_sleep(1);
        if ((++sp & 255u) == 0u) { if (xb_ld(&bar[XB_TMO])) break; if (sp > XB_SPIN_CAP) { atomicAdd(&bar[XB_TMO], 1u); break; } }
    }
    nloc = mine > 0u ? mine : 1u; nx = cnt > 0u ? cnt : 1u;
}
__device__ __forceinline__ void xcd_barrier(const XcdBarrier& b) {
    asm volatile("s_waitcnt vmcnt(0)" ::: "memory");
    __syncthreads();
    if (threadIdx.x == 0) {
        unsigned* bar = b.bar;
        __builtin_amdgcn_s_waitcnt(0);
        unsigned nloc = b.st[0], nx = b.st[1];
        if (nloc == 0u) { xcd_barrier_complete(bar, b.x, nloc, nx); b.st[0] = nloc; b.st[1] = nx; }
        const unsigned old = xb_add(&bar[XB_XSUB(b.x)], 1u);
        const unsigned gen = old / nloc;
        if (old + 1u == (gen + 1u) * nloc) {
            __builtin_amdgcn_fence(__ATOMIC_RELEASE, "agent");
            asm volatile("s_waitcnt vmcnt(0)" ::: "memory");
            const unsigned og = xb_add(&bar[XB_TOP], 1u);
            const unsigned tg = og / nx;
            if (og + 1u == (tg + 1u) * nx) xb_add(&bar[XB_TOPGEN], 1u);
            else XB_SPIN(xb_ld(&bar[XB_TOPGEN]) == tg, bar);
            __builtin_amdgcn_fence(__ATOMIC_ACQUIRE, "agent");
            xb_add(&bar[XB_XGEN(b.x)], 1u);
            asm volatile("s_waitcnt vmcnt(0)" ::: "memory");
        } else {
            XB_SPIN(xb_ld(&bar[XB_XGEN(b.x)]) == gen, bar);
            __builtin_amdgcn_fence(__ATOMIC_ACQUIRE, "agent");
            asm volatile("s_waitcnt vmcnt(0)" ::: "memory");
        }
    }
    __syncthreads();
}

constexpr int MISC_OFF = LDS_BYTES - 256;
constexpr int CW_BAR = 4096;
constexpr size_t CTL_ZERO_BYTES = 65536;
constexpr unsigned REPEAT_MASK = 0x0u;
constexpr int PB_FILTER = 0;
constexpr int U_ABL = 0;

__global__ void __launch_bounds__(NTHR, 2) mega_fwd(Params p) {
    extern __shared__ __attribute__((aligned(16))) unsigned char lds_raw[];
    LAS unsigned char* lds = (LAS unsigned char*)lds_raw;
    for (int u = threadIdx.x; u < 64; u += NTHR) ((LAS unsigned*)(lds + MISC_OFF))[u] = 0u;
    __syncthreads();
    XcdBarrier bar = xcd_barrier_post((unsigned*)(p.ws + WS_CTL) + CW_BAR, (volatile LAS unsigned*)(lds + MISC_OFF) + 8);
#define GRID_BAR() xcd_barrier(bar)
#define PHASE(k, ...) for (int rep_ = 0; rep_ <= (int)((REPEAT_MASK >> (k)) & 1u); ++rep_) { __VA_ARGS__; GRID_BAR(); }
    PHASE(0, phase_prologue(p, lds))
    PHASE(1, phase_u(p, lds, rep_ == 1 ? U_ABL : 0))
    PHASE(2, { pg8::Gemm g{(const bf16*)(p.ws + WS_U), (const bf16*)(p.ws + WS_WIN_T), D, nullptr}; pg8::StaticOrder S; S.init(R_ALL, NPROJ, gridDim.x, blockIdx.x);
        pg8::EpiInProj E{p.ws, (const float*)(p.ws + WS_LB)};
        pg8::gemm_phase<pg8::EpiInProj, pg8::StaticOrder, true, 0>(lds, g, S, E); })
    PHASE(3, phase_conv(p))
    PHASE(4, for (int item = blockIdx.x; item < 512; item += gridDim.x) sc::pass_a(p, lds, item))
    PHASE(5, for (int item = blockIdx.x; item < 256; item += gridDim.x) sc::pass_b<0>(p, lds, item))
    PHASE(6, for (int item = blockIdx.x; item < 256; item += gridDim.x) sc::pass_b<1>(p, lds, item))
    PHASE(7, { pg8::Gemm g{(const bf16*)(p.ws + WS_OF), (const bf16*)(p.ws + WS_WOUT_T), D, nullptr}; pg8::StaticOrder S; S.init(R_X, D, gridDim.x, blockIdx.x);
        pg8::EpiOutProj E{(bf16*)(p.ws + WS_DELTA), (const float*)(p.ws + WS_MOD)};
        pg8::gemm_phase<pg8::EpiOutProj, pg8::StaticOrder, true, 2>(lds, g, S, E); })
    PHASE(8, phase_vx(p, lds))
    PHASE(9, phase_topk(p, lds))
    PHASE(10, for (int w = blockIdx.x; w < 256; w += gridDim.x) {
        const int xcd = w & 7, idx = w >> 3, e = xcd * 2 + (idx >> 4), pm = e * 16 + (idx & 15);
        {   pg8::Gemm g{(const bf16*)(p.ws + WS_VX), (const bf16*)(p.ws + WS_WGU_T), D, (const int*)(p.ws + WS_ROWMAP)};
            pg8::PanelOrder S{pm, 8, (size_t)e * 2048 * 1024 * 2}; pg8::EpiMoE1 E{(bf16*)(p.ws + WS_H)};
            pg8::gemm_phase<pg8::EpiMoE1, pg8::PanelOrder, true, 1>(lds, g, S, E); }
        VM_WAIT(); __syncthreads();
        if (threadIdx.x == 0) { __builtin_amdgcn_fence(__ATOMIC_ACQUIRE, "agent"); VM_WAIT(); }
        __syncthreads();
        {   pg8::Gemm g{(const bf16*)(p.ws + WS_H), (const bf16*)(p.ws + WS_WD_T), FF, nullptr};
            pg8::PanelOrder S{pm, 4, (size_t)e * 1024 * 1024 * 2}; pg8::EpiMoE2 E{(bf16*)(p.ws + WS_Y), (const float*)(p.ws + WS_GATEV)};
            pg8::gemm_phase<pg8::EpiMoE2, pg8::PanelOrder, true, 0>(lds, g, S, E); }
    })
    phase_final(p);
}

extern "C" void kernel_launch(void* const* d_in, const int* in_sizes, int n_in, void* d_out, int out_size, void* d_ws, size_t ws_size, hipStream_t stream) {
    static int grid = 0;
    if (grid == 0) {
        if (n_in != 21 || out_size != R_X * D || ws_size < WS_END) { fprintf(stderr, "kernel_launch: unexpected shapes: n_in %d out %d ws %zu\n", n_in, out_size, ws_size); grid = -1; return; }
        int dev = 0, cus = 0, per_cu = 0;
        if (hipGetDevice(&dev) != hipSuccess || hipDeviceGetAttribute(&cus, hipDeviceAttributeMultiprocessorCount, dev) != hipSuccess) { grid = -1; return; }
        if (hipFuncSetAttribute((const void*)mega_fwd, hipFuncAttributeMaxDynamicSharedMemorySize, LDS_BYTES) != hipSuccess) { fprintf(stderr, "kernel_launch: hipFuncSetAttribute failed\n"); grid = -1; return; }
        if (hipOccupancyMaxActiveBlocksPerMultiprocessor(&per_cu, (const void*)mega_fwd, NTHR, LDS_BYTES) != hipSuccess || per_cu < 1) { fprintf(stderr, "kernel_launch: occupancy query says %d blocks/CU; nothing launched\n", per_cu); (void)hipGetLastError(); grid = -1; return; }
        grid = cus;
    }
    if (grid < 0) return;
    (void)hipMemsetAsync((char*)d_ws + WS_CTL, 0, CTL_ZERO_BYTES, stream);
    Params p{};
    const float** pp = (const float**)&p;
    for (int i = 0; i < 21; ++i) pp[i] = (const float*)d_in[i];
    p.out = (float*)d_out; p.ws = (unsigned char*)d_ws;
    hipLaunchKernelGGL(mega_fwd, dim3(grid), dim3(NTHR), LDS_BYTES, stream, p);
}
```
